# Optimizing an MI355X kernel written in HIP

```python
import jax, jax.numpy as jnp
from jax import lax
import numpy as np

D_MODEL = 2048
BATCH = 8
SEQ = 4096
DEPTH = 1
DEC_BATCH = 4
DEC_SEQ = 2048
PAST_LEN = 128

HEAD_DIM = 128
A_Q_HEADS = 8
A_KV_HEADS = 2
A_GROUP = A_Q_HEADS // A_KV_HEADS
WINDOW = 128
BLK = WINDOW
N_BUCKETS = 32
MAX_DISTANCE = 128
B_HEADS = 8
GRID_W = 64
NA_KH = 8
NA_KW = 16
NA_QCB = NA_KW
NA_REG = 2 * NA_KW
D_FF = 4 * D_MODEL
EPS = 1e-6
NEG = -1e30

A_Q_W = A_Q_HEADS * HEAD_DIM
A_KV_W = A_KV_HEADS * HEAD_DIM
B_W = B_HEADS * HEAD_DIM
IN_SPLITS = (A_Q_W, A_KV_W, A_KV_W, B_W, B_W, B_W, D_MODEL, D_MODEL)
IN_WIDTH = A_Q_W + 2 * A_KV_W + 3 * B_W + 2 * D_MODEL

kernel_name = "hybrid_window_gqa_neighbourhood_encoder"


def rmsnorm(x, g):
    xf = x.astype(jnp.float32)
    y = xf * lax.rsqrt(jnp.mean(xf * xf, axis=-1, keepdims=True) + EPS) * g.astype(jnp.float32)
    return y.astype(x.dtype)


def t5_bucket(rel):
    nb = N_BUCKETS // 2
    max_exact = nb // 2
    ret = (rel > 0).astype(np.int32) * nb
    n = np.abs(rel).astype(np.int32)
    nf = np.maximum(n, max_exact).astype(np.float32)
    large = max_exact + (np.log(nf / max_exact) / np.log(MAX_DISTANCE / max_exact) * (nb - max_exact)).astype(np.int32)
    large = np.minimum(large, nb - 1)
    return ret + np.where(n < max_exact, n, large)


def window_attention(q, k, v, q_gain, k_gain, t5_table, sink):
    b, L = q.shape[0], q.shape[1]
    nb = L // BLK
    q = rmsnorm(q, q_gain) * (HEAD_DIM ** -0.5)
    k = rmsnorm(k, k_gain)
    qb = q.reshape(b, nb, BLK, A_KV_HEADS, A_GROUP, HEAD_DIM)

    def band(t):
        tp = jnp.pad(t, ((0, 0), (BLK, BLK), (0, 0), (0, 0))).reshape(b, nb + 2, BLK, A_KV_HEADS, HEAD_DIM)
        return jnp.concatenate([tp[:, :-2], tp[:, 1:-1], tp[:, 2:]], axis=2)

    kb, vb = band(k), band(v)
    s = jnp.einsum('bnqhgd,bnkhd->bnhgqk', qb, kb).astype(jnp.float32)
    rel = np.arange(3 * BLK)[None, :] - BLK - np.arange(BLK)[:, None]
    bias = t5_table[t5_bucket(rel)].astype(jnp.float32)
    bias = jnp.transpose(bias, (2, 0, 1)).reshape(A_KV_HEADS, A_GROUP, BLK, 3 * BLK)
    kpos = np.arange(nb)[:, None] * BLK - BLK + np.arange(3 * BLK)[None, :]
    mask = (np.abs(rel) <= WINDOW)[None] & ((kpos >= 0) & (kpos < L))[:, None, :]
    s = jnp.where(mask[None, :, None, None], s + bias[None, None], NEG)
    sk = sink.astype(jnp.float32).reshape(1, 1, A_KV_HEADS, A_GROUP, 1, 1)
    m = jnp.maximum(jnp.max(s, axis=-1, keepdims=True), sk)
    p = jnp.exp(s - m)
    denom = jnp.sum(p, axis=-1, keepdims=True) + jnp.exp(sk - m)
    o = jnp.einsum('bnhgqk,bnkhd->bnqhgd', (p / denom).astype(v.dtype), vb)
    return o.reshape(b, L, A_Q_W)


def neighbourhood_attention(q, k, v, q_gain, k_gain, rpb):
    b, L = q.shape[0], q.shape[1]
    rows = L // GRID_W
    kh = min(NA_KH, rows)
    ncb = GRID_W // NA_QCB
    q = rmsnorm(q, q_gain) * (HEAD_DIM ** -0.5)
    k = rmsnorm(k, k_gain)
    qg = q.reshape(b, rows, GRID_W, B_HEADS, HEAD_DIM)
    kg = k.reshape(b, rows, GRID_W, B_HEADS, HEAD_DIM)
    vg = v.reshape(b, rows, GRID_W, B_HEADS, HEAD_DIM)
    reg_start = np.clip(np.arange(ncb) * NA_QCB - NA_KW // 2, 0, GRID_W - NA_REG)
    col_idx = reg_start[:, None] + np.arange(NA_REG)[None, :]
    qc = np.arange(GRID_W).reshape(ncb, NA_QCB)
    start_c = np.clip(qc - NA_KW // 2, 0, GRID_W - NA_KW)
    kc = col_idx[:, None, :]
    col_mask = (kc >= start_c[:, :, None]) & (kc < start_c[:, :, None] + NA_KW)
    dcc = np.clip(kc - qc[:, :, None], -(NA_KW - 1), NA_KW - 1) + (NA_KW - 1)

    def row_fn(r):
        rs = jnp.clip(r - kh // 2, 0, rows - kh)
        kr = lax.dynamic_slice_in_dim(kg, rs, kh, axis=1)[:, :, col_idx]
        vr = lax.dynamic_slice_in_dim(vg, rs, kh, axis=1)[:, :, col_idx]
        qr = lax.dynamic_index_in_dim(qg, r, axis=1, keepdims=False).reshape(b, ncb, NA_QCB, B_HEADS, HEAD_DIM)
        s = jnp.einsum('bcqhd,brckhd->bhcqrk', qr, kr).astype(jnp.float32)
        dr = rs + jnp.arange(kh) - r + (NA_KH - 1)
        bias = rpb[:, dr][:, :, dcc].astype(jnp.float32)
        bias = jnp.transpose(bias, (0, 2, 3, 1, 4))
        s = jnp.where(col_mask[None, None, :, :, None, :], s + bias[None], NEG)
        p = jax.nn.softmax(s.reshape(b, B_HEADS, ncb, NA_QCB, kh * NA_REG), axis=-1).reshape(s.shape)
        o = jnp.einsum('bhcqrk,brckhd->bcqhd', p.astype(v.dtype), vr)
        return o.reshape(b, GRID_W, B_W)

    out = lax.map(row_fn, jnp.arange(rows))
    return jnp.transpose(out, (1, 0, 2, 3)).reshape(b, L, B_W)


def trunk(x, norm_mix_g, w_in, q_norm_a, k_norm_a, t5_bias, sink_a, q_norm_b, k_norm_b, rpb_b,
          w_br_a, w_br_b, w_out, norm_mlp_g, w_up, w_down):
    b, L = x.shape[0], x.shape[1]
    offs = list(np.cumsum(IN_SPLITS)[:-1])
    for l in range(DEPTH):
        h = rmsnorm(x, norm_mix_g[l])
        proj = h @ w_in[l]
        qa, ka, va, qb, kb, vb, ga, gb = jnp.split(proj, offs, axis=-1)
        ya = window_attention(qa.reshape(b, L, A_Q_HEADS, HEAD_DIM),
                              ka.reshape(b, L, A_KV_HEADS, HEAD_DIM),
                              va.reshape(b, L, A_KV_HEADS, HEAD_DIM),
                              q_norm_a[l], k_norm_a[l], t5_bias, sink_a[l]) @ w_br_a[l]
        yb = neighbourhood_attention(qb.reshape(b, L, B_HEADS, HEAD_DIM),
                                     kb.reshape(b, L, B_HEADS, HEAD_DIM),
                                     vb.reshape(b, L, B_HEADS, HEAD_DIM),
                                     q_norm_b[l], k_norm_b[l], rpb_b[l]) @ w_br_b[l]
        merged = jax.nn.sigmoid(ga) * ya + jax.nn.sigmoid(gb) * yb
        x = x + merged @ w_out[l]
        h = rmsnorm(x, norm_mlp_g[l])
        x = x + jnp.square(jax.nn.relu(h @ w_up[l])) @ w_down[l]
    return x


def setup_inputs(seed: int = 0) -> dict:
    key = jax.random.key(seed)
    ks = jax.random.split(key, 20)
    f = jnp.float32
    n = lambda k, shape, s: jax.random.normal(k, shape, f) * s
    return {
        "x_prompt": n(ks[0], (BATCH, SEQ, D_MODEL), 1.0),
        "x_sample": n(ks[1], (DEC_BATCH, DEC_SEQ, D_MODEL), 1.0),
        "norm_mix_g": 1.0 + n(ks[2], (DEPTH, D_MODEL), 0.1),
        "w_in": n(ks[3], (DEPTH, D_MODEL, IN_WIDTH), D_MODEL ** -0.5),
        "q_norm_a": 1.0 + n(ks[4], (DEPTH, HEAD_DIM), 0.1),
        "k_norm_a": 1.0 + n(ks[5], (DEPTH, HEAD_DIM), 0.1),
        "t5_bias": n(ks[6], (N_BUCKETS, A_Q_HEADS), 0.5),
        "sink_a": n(ks[7], (DEPTH, A_Q_HEADS), 1.0),
        "q_norm_b": 1.0 + n(ks[8], (DEPTH, HEAD_DIM), 0.1),
        "k_norm_b": 1.0 + n(ks[9], (DEPTH, HEAD_DIM), 0.1),
        "rpb_b": n(ks[10], (DEPTH, B_HEADS, 2 * NA_KH - 1, 2 * NA_KW - 1), 0.5),
        "w_br_a": n(ks[11], (DEPTH, A_Q_W, D_MODEL), A_Q_W ** -0.5),
        "w_br_b": n(ks[12], (DEPTH, B_W, D_MODEL), B_W ** -0.5),
        "w_out": n(ks[13], (DEPTH, D_MODEL, D_MODEL), D_MODEL ** -0.5),
        "norm_mlp_g": 1.0 + n(ks[14], (DEPTH, D_MODEL), 0.1),
        "w_up": n(ks[15], (DEPTH, D_MODEL, D_FF), D_MODEL ** -0.5),
        "w_down": n(ks[16], (DEPTH, D_FF, D_MODEL), D_FF ** -0.5),
    }


def reference(x_prompt, x_sample, norm_mix_g, w_in, q_norm_a, k_norm_a, t5_bias, sink_a, q_norm_b, k_norm_b,
              rpb_b, w_br_a, w_br_b, w_out, norm_mlp_g, w_up, w_down):
    y_prompt = trunk(x_prompt, norm_mix_g, w_in, q_norm_a, k_norm_a, t5_bias, sink_a, q_norm_b, k_norm_b,
                     rpb_b, w_br_a, w_br_b, w_out, norm_mlp_g, w_up, w_down)
    y_sample = trunk(x_sample, norm_mix_g, w_in, q_norm_a, k_norm_a, t5_bias, sink_a, q_norm_b, k_norm_b,
                     rpb_b, w_br_a, w_br_b, w_out, norm_mlp_g, w_up, w_down)
    return (y_prompt, y_sample)
```

```cpp
#include <hip/hip_runtime.h>
#include <hip/hip_cooperative_groups.h>
#include <cstdio>
#include <cstdint>
namespace cg = cooperative_groups;
#define MK_N_LAUNCHES 1
namespace pg8 {
#define PG8_LAS __attribute__((address_space(3)))
typedef unsigned short bf16_t;
typedef short bf16x8 __attribute__((ext_vector_type(8)));
typedef float f32x4 __attribute__((ext_vector_type(4)));
typedef unsigned u32x4 __attribute__((ext_vector_type(4)));
constexpr int BM = 256, BK = 64, HALF = 128, HTB = HALF * BK * 2  , STAGE_BYTES = 8 * HTB, NXCD = 8, WGM = 8;

__host__ __device__ __forceinline__ int lds_byte(int r, int c) { const int st = (r >> 4) * 2 + (c >> 5), rr = r & 15, cc = c & 31, ob = rr * 64 + cc * 2; return st * 1024 + (ob ^ (((ob >> 9) & 1) << 5)); }
__host__ __device__ __forceinline__ void stage_rc(int b, int& R, int& C) { const int st = b / 1024, sb = b % 1024, swz = sb ^ (((sb >> 9) & 1) << 5); R = (st >> 1) * 16 + swz / 64; C = (st & 1) * 32 + (swz % 64) / 2; }
__host__ __device__ __forceinline__ int perm32(int rho) { const int n = rho >> 4, i = rho & 15; return 8 * (i >> 2) + 4 * n + (i & 3); }

struct Unit { int pm, pn; };
struct Gemm { const bf16_t* A; const bf16_t* Bt; int M, N, K; };

struct StaticOrder {
    int nM, nN, nwg, G, c;
    __host__ __device__ void init(int M, int N, int G_, int c_) { nM = M / BM; nN = N / BM; nwg = nM * nN; G = G_; c = c_; }
    __host__ __device__ bool next(int i, Unit& u) const {
        const long L = (long)i * G + c; if (L >= nwg) return false;
        int wgid = (int)L; { const int q = nwg / NXCD, r = nwg % NXCD, xcd = wgid % NXCD, off = wgid / NXCD; wgid = (xcd < r ? xcd * (q + 1) : r * (q + 1) + (xcd - r) * q) + off; }
        const int nig = WGM * nN, gid = wgid / nig, fm = gid * WGM, gsz = (nM - fm) < WGM ? (nM - fm) : WGM;
        u.pm = fm + ((wgid % nig) % gsz); u.pn = (wgid % nig) / gsz; return true;
    }
    __device__ __forceinline__ void a_ready(const Unit&) const {}
    __device__ __forceinline__ void done(const Unit&) const {}
};

__device__ __forceinline__ unsigned cvt_pk_bf16(float lo, float hi) { unsigned r; asm volatile("s_nop 0\n\tv_cvt_pk_bf16_f32 %0, %1, %2" : "=v"(r) : "v"(lo), "v"(hi)); return r; }
typedef float f32x2 __attribute__((ext_vector_type(2)));
typedef unsigned u32x2 __attribute__((ext_vector_type(2)));
__device__ __forceinline__ float bf_lo(unsigned w) { return __uint_as_float(w << 16); }
__device__ __forceinline__ float bf_hi(unsigned w) { return __uint_as_float(w & 0xffff0000u); }
__device__ __forceinline__ u32x4 pack8(const f32x4 v0, const f32x4 v1) { u32x4 w; w.x = cvt_pk_bf16(v0[0], v0[1]); w.y = cvt_pk_bf16(v0[2], v0[3]); w.z = cvt_pk_bf16(v1[0], v1[1]); w.w = cvt_pk_bf16(v1[2], v1[3]); return w; }
__device__ __forceinline__ float sigmoidf_(float x) { return __builtin_amdgcn_rcpf(1.0f + __builtin_amdgcn_exp2f(-1.44269504089f * x)); }
constexpr int QKV_LD = 4608, GATE_LD = 4096, DM = 2048, FFD = 8192, NHS = 36, NPROMPT_ROWS = 32768;

struct EpiProj {
    static constexpr bool PERM = true, AFTER_DRAIN = false, MID = false;
    bf16_t* QKV; bf16_t* GATES; float* SS;
    __device__ __forceinline__ void operator()(const f32x4 (&acc)[2][2][4][2], const Unit& u, int wr, int wc, int fr, int fq) const {
        const int row0 = u.pm * BM + wr * 64 + fr;
        if (u.pn < 18) {
            const int col0 = u.pn * BM + wc * 32 + 8 * fq;
#pragma unroll
            for (int ai = 0; ai < 2; ++ai)
#pragma unroll
                for (int m = 0; m < 4; ++m) { const int row = row0 + ai * HALF + m * 16; bf16_t* rowp = QKV + (size_t)row * QKV_LD + col0;
#pragma unroll
                    for (int bj = 0; bj < 2; ++bj) { const f32x4 v0 = acc[ai][bj][m][0], v1 = acc[ai][bj][m][1];
                        float s = (v0[0] * v0[0] + v0[1] * v0[1]) + (v0[2] * v0[2] + v0[3] * v0[3]) + (v1[0] * v1[0] + v1[1] * v1[1]) + (v1[2] * v1[2] + v1[3] * v1[3]);
                        s += __shfl_xor(s, 16); s += __shfl_xor(s, 32);
                        if (fq == 0) SS[((size_t)row * NHS + u.pn * 2 + bj) * 4 + wc] = s;
                        *(u32x4*)(rowp + bj * HALF) = pack8(v0, v1); } }
        } else {
            const int col0 = (u.pn - 18) * BM + wc * 32 + 8 * fq;
#pragma unroll
            for (int ai = 0; ai < 2; ++ai)
#pragma unroll
                for (int m = 0; m < 4; ++m) { const int row = row0 + ai * HALF + m * 16; bf16_t* rowp = GATES + (size_t)row * GATE_LD + col0;
#pragma unroll
                    for (int bj = 0; bj < 2; ++bj) { f32x4 v0 = acc[ai][bj][m][0], v1 = acc[ai][bj][m][1];
#pragma unroll
                        for (int j = 0; j < 4; ++j) { v0[j] = sigmoidf_(v0[j]); v1[j] = sigmoidf_(v1[j]); }
                        *(u32x4*)(rowp + bj * HALF) = pack8(v0, v1); } }
        }
    }
};

struct EpiMerge {
    static constexpr bool PERM = true, AFTER_DRAIN = false, MID = true;
    const bf16_t* GATES; bf16_t* OUT;
    __device__ __forceinline__ void mid(f32x4 (&acc)[2][2][4][2], const Unit& u, int wr, int wc, int fr, int fq) const {
        const int row0 = u.pm * BM + wr * 64 + fr, col0 = u.pn * BM + wc * 32 + 8 * fq;
        const bf16_t* gp0 = GATES + (size_t)row0 * GATE_LD + col0;
        asm volatile("" : "+v"(gp0));
#pragma unroll
        for (int ai = 0; ai < 2; ++ai)
#pragma unroll
            for (int m = 0; m < 4; ++m)
#pragma unroll
                for (int bj = 0; bj < 2; ++bj) { const bf16_t* gp = gp0 + (size_t)(ai * HALF + m * 16) * GATE_LD + bj * HALF;
                    const u32x4 a = *(const u32x4*)gp, b = *(const u32x4*)(gp + DM);
                    f32x4& c0 = acc[ai][bj][m][0]; f32x4& c1 = acc[ai][bj][m][1];
                    c0[0] *= bf_lo(a.x) * __builtin_amdgcn_rcpf(bf_lo(b.x)); c0[1] *= bf_hi(a.x) * __builtin_amdgcn_rcpf(bf_hi(b.x));
                    c0[2] *= bf_lo(a.y) * __builtin_amdgcn_rcpf(bf_lo(b.y)); c0[3] *= bf_hi(a.y) * __builtin_amdgcn_rcpf(bf_hi(b.y));
                    c1[0] *= bf_lo(a.z) * __builtin_amdgcn_rcpf(bf_lo(b.z)); c1[1] *= bf_hi(a.z) * __builtin_amdgcn_rcpf(bf_hi(b.z));
                    c1[2] *= bf_lo(a.w) * __builtin_amdgcn_rcpf(bf_lo(b.w)); c1[3] *= bf_hi(a.w) * __builtin_amdgcn_rcpf(bf_hi(b.w));
                    asm volatile("" ::: "memory"); }
    }
    __device__ __forceinline__ void operator()(const f32x4 (&acc)[2][2][4][2], const Unit& u, int wr, int wc, int fr, int fq) const {
        const int row0 = u.pm * BM + wr * 64 + fr, col0 = u.pn * BM + wc * 32 + 8 * fq;
#pragma unroll
        for (int ai = 0; ai < 2; ++ai)
#pragma unroll
            for (int m = 0; m < 4; ++m) { const size_t row = (size_t)(row0 + ai * HALF + m * 16); const bf16_t* gp = GATES + row * GATE_LD + DM + col0; bf16_t* op = OUT + row * DM + col0;
#pragma unroll
                for (int bj = 0; bj < 2; ++bj) { const u32x4 b = *(const u32x4*)(gp + bj * HALF);
                    f32x4 v0 = acc[ai][bj][m][0], v1 = acc[ai][bj][m][1];
                    v0[0] *= bf_lo(b.x); v0[1] *= bf_hi(b.x); v0[2] *= bf_lo(b.y); v0[3] *= bf_hi(b.y);
                    v1[0] *= bf_lo(b.z); v1[1] *= bf_hi(b.z); v1[2] *= bf_lo(b.w); v1[3] *= bf_hi(b.w);
                    *(u32x4*)(op + bj * HALF) = pack8(v0, v1); }
                asm volatile("" ::: "memory"); }
    }
};

struct EpiOut1 {
    static constexpr bool PERM = true, AFTER_DRAIN = false, MID = false;
    const float* xp; const float* xs; float* OUT; bf16_t* X1B; float* SS2;
    __device__ __forceinline__ void operator()(const f32x4 (&acc)[2][2][4][2], const Unit& u, int wr, int wc, int fr, int fq) const {
        const int row0 = u.pm * BM + wr * 64 + fr, col0 = u.pn * BM + wc * 32 + 8 * fq;
        const float* xb = (u.pm * BM < NPROMPT_ROWS) ? xp : xs - (size_t)NPROMPT_ROWS * DM;
#pragma unroll
        for (int ai = 0; ai < 2; ++ai)
#pragma unroll
            for (int m = 0; m < 4; ++m) { const size_t row = (size_t)(row0 + ai * HALF + m * 16); const float* xr = xb + row * DM + col0; float* op = OUT + row * DM + col0; bf16_t* bp = X1B + row * DM + col0;
                float s = 0.f;
#pragma unroll
                for (int bj = 0; bj < 2; ++bj) { const f32x4 v0 = acc[ai][bj][m][0] + *(const f32x4*)(xr + bj * HALF), v1 = acc[ai][bj][m][1] + *(const f32x4*)(xr + bj * HALF + 4);
                    s += (v0[0] * v0[0] + v0[1] * v0[1]) + (v0[2] * v0[2] + v0[3] * v0[3]) + (v1[0] * v1[0] + v1[1] * v1[1]) + (v1[2] * v1[2] + v1[3] * v1[3]);
                    *(f32x4*)(op + bj * HALF) = v0; *(f32x4*)(op + bj * HALF + 4) = v1; *(u32x4*)(bp + bj * HALF) = pack8(v0, v1); }
                s += __shfl_xor(s, 16); s += __shfl_xor(s, 32);
                if (fq == 0) SS2[row * 32 + u.pn * 4 + wc] = s;
                asm volatile("" ::: "memory"); }
    }
};

struct EpiUp {
    static constexpr bool PERM = true, AFTER_DRAIN = false, MID = false;
    const float* RSTD2; bf16_t* U;
    __device__ __forceinline__ void operator()(const f32x4 (&acc)[2][2][4][2], const Unit& u, int wr, int wc, int fr, int fq) const {
        const int row0 = u.pm * BM + wr * 64 + fr, col0 = u.pn * BM + wc * 32 + 8 * fq;
#pragma unroll
        for (int ai = 0; ai < 2; ++ai)
#pragma unroll
            for (int m = 0; m < 4; ++m) { const size_t row = (size_t)(row0 + ai * HALF + m * 16); const float rs = RSTD2[row]; bf16_t* op = U + row * FFD + col0;
#pragma unroll
                for (int bj = 0; bj < 2; ++bj) { f32x4 v0 = acc[ai][bj][m][0] * rs, v1 = acc[ai][bj][m][1] * rs;
#pragma unroll
                    for (int j = 0; j < 4; ++j) { const float a = fmaxf(v0[j], 0.f), b = fmaxf(v1[j], 0.f); v0[j] = a * a; v1[j] = b * b; }
                    *(u32x4*)(op + bj * HALF) = pack8(v0, v1); } }
    }
};

struct EpiDown {
    static constexpr bool PERM = true, AFTER_DRAIN = false, MID = false;
    float* OUT;
    __device__ __forceinline__ void operator()(const f32x4 (&acc)[2][2][4][2], const Unit& u, int wr, int wc, int fr, int fq) const {
        const int row0 = u.pm * BM + wr * 64 + fr, col0 = u.pn * BM + wc * 32 + 8 * fq;
#pragma unroll
        for (int ai = 0; ai < 2; ++ai)
#pragma unroll
            for (int m = 0; m < 4; ++m) { float* op = OUT + (size_t)(row0 + ai * HALF + m * 16) * DM + col0;
#pragma unroll
                for (int bj = 0; bj < 2; ++bj) { const f32x4 v0 = acc[ai][bj][m][0] + *(const f32x4*)(op + bj * HALF), v1 = acc[ai][bj][m][1] + *(const f32x4*)(op + bj * HALF + 4);
                    *(f32x4*)(op + bj * HALF) = v0; *(f32x4*)(op + bj * HALF + 4) = v1; }
                asm volatile("" ::: "memory"); }
    }
};

template <class Epi, class Sched, bool ALIGN_EPI = false, bool SP2 = false>
__device__ __forceinline__ void gemm_phase(PG8_LAS unsigned char* lds, const Gemm g, const Sched& S, const Epi& E) {
    const int tid = threadIdx.x, wid = __builtin_amdgcn_readfirstlane(tid >> 6), lane = tid & 63, wr = wid >> 2, wc = wid & 3, fr = lane & 15, fq = lane >> 4;
    const int K = g.K, nt = K / BK;
    unsigned voffA[2], voffB[2];
#pragma unroll
    for (int i = 0; i < 2; ++i) { int R, C; stage_rc(tid * 16 + i * 8192, R, C); const int Rb = Epi::PERM ? ((R & ~31) + perm32(R & 31)) : R;
        voffA[i] = (unsigned)(R * K + C) * 2u; voffB[i] = (unsigned)(Rb * K + C) * 2u; }
    const size_t kstep = (size_t)(BK * 2);
    const size_t hstep = (size_t)HALF * K * 2;
    const size_t tstep = 2 * hstep;
    const unsigned ldsw = (unsigned)wid * 1024u;
    const int aoff = lds_byte(wr * 64 + fr, fq * 8), boff = lds_byte(wc * 32 + fr, fq * 8);
#define PG8_SA(b, h) (((b) * 2 + (h)) * HTB)
#define PG8_SB(b, h) ((4 + (b) * 2 + (h)) * HTB)
#define PG8_STAGE(bufoff, gbase, voff) do { _Pragma("unroll") for (int _i = 0; _i < 2; ++_i) \
        __builtin_amdgcn_global_load_lds((const unsigned*)((const char*)(gbase) + (voff)[_i]), (PG8_LAS unsigned*)(lds + (bufoff) + ldsw + _i * 8192), 16, 0, 0); } while (0)
#define PG8_LDA(dst, b, h) do { _Pragma("unroll") for (int m = 0; m < 4; ++m) _Pragma("unroll") for (int k = 0; k < 2; ++k) dst[m][k] = *(const PG8_LAS bf16x8*)(lds + PG8_SA(b, h) + aoff + m * 2048 + k * 1024); } while (0)
#define PG8_LDB(dst, b, h) do { _Pragma("unroll") for (int n = 0; n < 2; ++n) _Pragma("unroll") for (int k = 0; k < 2; ++k) dst[n][k] = *(const PG8_LAS bf16x8*)(lds + PG8_SB(b, h) + boff + n * 2048 + k * 1024); } while (0)
#define PG8_MMA(ai, bj, At, Bt) do { __builtin_amdgcn_s_setprio(1); _Pragma("unroll") for (int m = 0; m < 4; ++m) _Pragma("unroll") for (int n = 0; n < 2; ++n) _Pragma("unroll") for (int k = 0; k < 2; ++k) \
        acc[ai][bj][m][n] = __builtin_amdgcn_mfma_f32_16x16x32_bf16(Bt[n][k], At[m][k], acc[ai][bj][m][n], 0, 0, 0); __builtin_amdgcn_s_setprio(0); } while (0)
#define PG8_WAIT_V(n) asm volatile("s_waitcnt vmcnt(" #n ")" ::: "memory")
#define PG8_WAIT_L(n) asm volatile("s_waitcnt lgkmcnt(" #n ")" ::: "memory")
#define PG8_BAR __builtin_amdgcn_s_barrier()
#define PG8_SCHED __builtin_amdgcn_sched_barrier(0)
    Unit cur, nxt; int ui = 0;
    if (!S.next(0, cur)) return;
    f32x4 acc[2][2][4][2];
#pragma unroll
    for (int a = 0; a < 2; ++a)
#pragma unroll
        for (int b = 0; b < 2; ++b)
#pragma unroll
            for (int m = 0; m < 4; ++m)
#pragma unroll
                for (int n = 0; n < 2; ++n) acc[a][b][m][n] = (f32x4){0.f, 0.f, 0.f, 0.f};
    bf16x8 At[4][2], B0[2][2], B1[2][2];
    const char* cA = (const char*)g.A + (size_t)cur.pm * tstep; const char* cB = (const char*)g.Bt + (size_t)cur.pn * tstep;
    S.a_ready(cur);
    if constexpr (SP2) {
        PG8_STAGE(PG8_SB(0, 0), cB, voffB); PG8_STAGE(PG8_SB(0, 1), cB + hstep, voffB); PG8_STAGE(PG8_SA(0, 0), cA, voffA); PG8_STAGE(PG8_SA(0, 1), cA + hstep, voffA);
        if (wr == 1) PG8_BAR;
        PG8_WAIT_V(2); PG8_BAR;
        PG8_STAGE(PG8_SB(1, 0), cB + kstep, voffB); PG8_STAGE(PG8_SA(1, 0), cA + kstep, voffA); PG8_STAGE(PG8_SB(1, 1), cB + hstep + kstep, voffB);
        PG8_WAIT_V(6); PG8_BAR;
    } else {
        PG8_STAGE(PG8_SB(0, 0), cB, voffB); PG8_STAGE(PG8_SA(0, 0), cA, voffA); PG8_STAGE(PG8_SB(0, 1), cB + hstep, voffB); PG8_STAGE(PG8_SA(0, 1), cA + hstep, voffA);
        if (wr == 1) PG8_BAR;
        PG8_WAIT_V(4); PG8_BAR;
        PG8_STAGE(PG8_SB(1, 0), cB + kstep, voffB); PG8_STAGE(PG8_SA(1, 0), cA + kstep, voffA); PG8_STAGE(PG8_SB(1, 1), cB + hstep + kstep, voffB);
        PG8_WAIT_V(6); PG8_BAR;
    }
    for (;;) {
        const bool has_next = S.next(ui + 1, nxt);
        const char* nA = has_next ? (const char*)g.A + (size_t)nxt.pm * tstep : cA; const char* nB = has_next ? (const char*)g.Bt + (size_t)nxt.pn * tstep : cB;
        constexpr int NSEG = Epi::MID ? 2 : 1; const int seglen = nt / NSEG;
        for (int seg = 0; seg < NSEG; ++seg) {
        if constexpr (Epi::MID) { if (seg == 1) E.mid(acc, cur, wr, wc, fr, fq); }
        for (int t = seg * seglen; t < (seg + 1) * seglen; t += 2) {
            const bool last = (t == nt - 2);
            const char* a1 = cA + (size_t)(t + 1) * kstep;
            const char* a2 = last ? nA : cA + (size_t)(t + 2) * kstep; const char* b2 = last ? nB : cB + (size_t)(t + 2) * kstep;
            const char* a3 = a2 + kstep; const char* b3 = b2 + kstep;
            if (last && has_next) S.a_ready(nxt);
            if constexpr (SP2) {
            PG8_LDB(B0, 0, 0); PG8_LDB(B1, 0, 1); PG8_SCHED; PG8_LDA(At, 0, 0); PG8_STAGE(PG8_SA(1, 1), a1 + hstep, voffA);
            PG8_WAIT_V(8); PG8_WAIT_L(0); PG8_BAR; PG8_MMA(0, 0, At, B0); PG8_MMA(0, 1, At, B1); PG8_BAR; PG8_SCHED;
            PG8_LDA(At, 0, 1); PG8_STAGE(PG8_SB(0, 0), b2, voffB); PG8_STAGE(PG8_SB(0, 1), b2 + hstep, voffB); PG8_STAGE(PG8_SA(0, 0), a2, voffA);
            PG8_WAIT_V(8); PG8_WAIT_L(0); PG8_BAR; PG8_MMA(1, 0, At, B0); PG8_MMA(1, 1, At, B1); PG8_BAR; PG8_SCHED;
            PG8_LDB(B0, 1, 0); PG8_LDB(B1, 1, 1); PG8_SCHED; PG8_LDA(At, 1, 0); PG8_STAGE(PG8_SA(0, 1), a2 + hstep, voffA);
            PG8_WAIT_V(8); PG8_WAIT_L(0); PG8_BAR; PG8_MMA(0, 0, At, B0); PG8_MMA(0, 1, At, B1); PG8_BAR; PG8_SCHED;
            PG8_LDA(At, 1, 1); PG8_STAGE(PG8_SB(1, 0), b3, voffB); PG8_STAGE(PG8_SB(1, 1), b3 + hstep, voffB); PG8_STAGE(PG8_SA(1, 0), a3, voffA);
            PG8_WAIT_V(8); PG8_WAIT_L(0); PG8_BAR; PG8_MMA(1, 0, At, B0); PG8_MMA(1, 1, At, B1); PG8_BAR; PG8_SCHED;
            } else {
            PG8_LDB(B0, 0, 0); PG8_SCHED; PG8_LDA(At, 0, 0); PG8_STAGE(PG8_SA(1, 1), a1 + hstep, voffA);
            PG8_WAIT_L(8); PG8_BAR; PG8_WAIT_L(0); PG8_MMA(0, 0, At, B0); PG8_BAR; PG8_SCHED;
            PG8_LDB(B1, 0, 1); PG8_STAGE(PG8_SB(0, 0), b2, voffB);
            PG8_BAR; PG8_WAIT_L(0); PG8_MMA(0, 1, At, B1); PG8_BAR;
            PG8_LDA(At, 0, 1); PG8_STAGE(PG8_SA(0, 0), a2, voffA);
            PG8_BAR; PG8_WAIT_L(0); PG8_MMA(1, 0, At, B0); PG8_BAR; PG8_SCHED;
            PG8_STAGE(PG8_SB(0, 1), b2 + hstep, voffB);
            PG8_WAIT_V(6); PG8_BAR; PG8_MMA(1, 1, At, B1); PG8_BAR;
            PG8_LDB(B0, 1, 0); PG8_SCHED; PG8_LDA(At, 1, 0); PG8_STAGE(PG8_SA(0, 1), a2 + hstep, voffA);
            PG8_WAIT_L(8); PG8_BAR; PG8_WAIT_L(0); PG8_MMA(0, 0, At, B0); PG8_BAR; PG8_SCHED;
            PG8_LDB(B1, 1, 1); PG8_STAGE(PG8_SB(1, 0), b3, voffB);
            PG8_BAR; PG8_WAIT_L(0); PG8_MMA(0, 1, At, B1); PG8_BAR;
            PG8_LDA(At, 1, 1); PG8_STAGE(PG8_SA(1, 0), a3, voffA);
            PG8_BAR; PG8_WAIT_L(0); PG8_MMA(1, 0, At, B0); PG8_BAR; PG8_SCHED;
            PG8_STAGE(PG8_SB(1, 1), b3 + hstep, voffB);
            PG8_WAIT_V(6); PG8_BAR; PG8_MMA(1, 1, At, B1); PG8_BAR;
            }
        }
        }
        if constexpr (ALIGN_EPI) { if (wr == 0) PG8_BAR; }
        if constexpr (!Epi::AFTER_DRAIN) { E(acc, cur, wr, wc, fr, fq); S.done(cur); }
        if (!has_next) break;
#pragma unroll
        for (int a = 0; a < 2; ++a)
#pragma unroll
            for (int b = 0; b < 2; ++b)
#pragma unroll
                for (int m = 0; m < 4; ++m)
#pragma unroll
                    for (int n = 0; n < 2; ++n) acc[a][b][m][n] = (f32x4){0.f, 0.f, 0.f, 0.f};
        cur = nxt; cA = nA; cB = nB; ++ui;
        if constexpr (ALIGN_EPI) { if (wr == 1) PG8_BAR; }
    }
    PG8_WAIT_V(0);
    if constexpr (!ALIGN_EPI) { if (wr == 0) PG8_BAR; }
    PG8_BAR;
    if constexpr (Epi::AFTER_DRAIN) { E.fused(acc, cur, wr, wc, fr, fq, lds, wid, lane); S.done(cur); }
#undef PG8_SA
#undef PG8_SB
#undef PG8_STAGE
#undef PG8_LDA
#undef PG8_LDB
#undef PG8_MMA
#undef PG8_WAIT_V
#undef PG8_WAIT_L
#undef PG8_BAR
#undef PG8_SCHED
}
}
#ifndef MK_N_LAUNCHES
#define MK_N_LAUNCHES 1
#endif
constexpr int NWAVES = 8;
constexpr int M_ROWS = 40960, NP_ROWS = 32768, D = 2048, FF = 8192, INW = 8704, QKVW = 4608, GW_ = 4096, HD = 128;
constexpr float EPS = 1e-6f;
constexpr size_t MiB = 1u << 20;
constexpr size_t WS_TAB = 0;
constexpr size_t WS_RSTD2 = 1 * MiB;
constexpr size_t WS_SS2 = 2 * MiB;
constexpr size_t WS_SS = 8 * MiB;
constexpr size_t WS_WIN = 32 * MiB;
constexpr size_t WS_WBR = 66 * MiB;
constexpr size_t WS_WOUT = 74 * MiB;
constexpr size_t WS_WUP = 82 * MiB;
constexpr size_t WS_WDN = 114 * MiB;
constexpr size_t WS_BUFA = 146 * MiB;
constexpr size_t WS_QKV = 306 * MiB;
constexpr size_t WS_GATES = 666 * MiB;
constexpr size_t WS_END = 986 * MiB;
constexpr int LDS_BYTES = 147456;

#define LAS __attribute__((address_space(3)))
typedef unsigned short bf16;
typedef unsigned v4u __attribute__((ext_vector_type(4)));
typedef float f32x4 __attribute__((ext_vector_type(4)));
#define LDS_WAIT() asm volatile("s_waitcnt lgkmcnt(0)" ::: "memory")
__device__ __forceinline__ unsigned f2bf(float f) { unsigned u = __builtin_bit_cast(unsigned, f); return (u + 0x7fffu + ((u >> 16) & 1u)) >> 16; }
__device__ __forceinline__ unsigned pk2(float lo, float hi) { return f2bf(lo) | (f2bf(hi) << 16); }
__device__ __forceinline__ float bflo(unsigned w) { return __uint_as_float(w << 16); }
__device__ __forceinline__ float bfhi(unsigned w) { return __uint_as_float(w & 0xffff0000u); }
__device__ __forceinline__ float wave_sum(float v) {
#pragma unroll
    for (int o = 1; o < 64; o <<= 1) v += __shfl_xor(v, o);
    return v;
}
__device__ __forceinline__ float wave_max(float v) {
#pragma unroll
    for (int o = 1; o < 64; o <<= 1) v = fmaxf(v, __shfl_xor(v, o));
    return v;
}
__device__ __forceinline__ void wave_sync() { __builtin_amdgcn_fence(__ATOMIC_RELEASE, "wavefront"); __builtin_amdgcn_wave_barrier(); __builtin_amdgcn_fence(__ATOMIC_ACQUIRE, "wavefront"); }

__device__ __forceinline__ int t5_bucket_dev(int rel) {
    const int n = rel < 0 ? -rel : rel;
    const int b = n < 8 ? n : 8 + (n >= 12) + (n >= 16) + (n >= 23) + (n >= 32) + (n >= 46) + (n >= 64) + (n >= 91);
    return b + (rel > 0 ? 16 : 0);
}

struct Frame {
    unsigned char* lds; int tid, lane, wave, G, bid;
    const float *xp, *xs, *g1, *w_in, *gqa, *gka, *t5, *sink, *gqb, *gkb, *rpb, *wbra, *wbrb, *wout, *g2, *wup, *wdn;
    float* out; unsigned char* ws;
};
__device__ __forceinline__ const float* xrow_ptr(const Frame& F, int m) { return m < NP_ROWS ? F.xp + (size_t)m * D : F.xs + (size_t)(m - NP_ROWS) * D; }

__device__ __forceinline__ void p0_transpose_item(const float* W, int K, int N, bf16* WT, int ldk, int koff, const float* kscale, float* scr, int item, int lane) {
    const int nblk = N / 32, kb = item / nblk, nb = item % nblk, k0 = 64 * kb, n0 = 32 * nb;
#pragma unroll 8
    for (int i = 0; i < 32; ++i) { const int kk = 2 * i + (lane >> 5); float w = W[(size_t)(k0 + kk) * N + n0 + (lane & 31)]; if (kscale) w *= kscale[k0 + kk]; scr[kk * 33 + (lane & 31)] = w; }
    wave_sync();
    const int c = lane & 7;
#pragma unroll
    for (int j = 0; j < 4; ++j) { const int n = (lane >> 3) + 8 * j; const float* s = scr + (8 * c) * 33 + n;
        v4u o; o.x = pk2(s[0 * 33], s[1 * 33]); o.y = pk2(s[2 * 33], s[3 * 33]); o.z = pk2(s[4 * 33], s[5 * 33]); o.w = pk2(s[6 * 33], s[7 * 33]);
        *(v4u*)(WT + (size_t)(n0 + n) * ldk + koff + k0 + 8 * c) = o; }
    wave_sync();
}
__device__ __forceinline__ void p0_prologue(Frame& F) {
    float* scr = (float*)(F.lds + F.wave * 16384);
    const int gw = F.bid * NWAVES + F.wave, NGW = F.G * NWAVES;
    constexpr int I_IN = (D / 64) * (INW / 32), I_BR = (1024 / 64) * (D / 32), I_OUT = (D / 64) * (D / 32), I_UP = (D / 64) * (FF / 32), I_DN = (FF / 64) * (D / 32);
    constexpr int NITEMS = I_IN + 2 * I_BR + I_OUT + I_UP + I_DN;
    for (int it = gw; it < NITEMS; it += NGW) {
        int r = it;
        if (r < I_IN) { p0_transpose_item(F.w_in, D, INW, (bf16*)(F.ws + WS_WIN), D, 0, nullptr, scr, r, F.lane); continue; } r -= I_IN;
        if (r < I_BR) { p0_transpose_item(F.wbra, 1024, D, (bf16*)(F.ws + WS_WBR), D, 0, nullptr, scr, r, F.lane); continue; } r -= I_BR;
        if (r < I_BR) { p0_transpose_item(F.wbrb, 1024, D, (bf16*)(F.ws + WS_WBR), D, 1024, nullptr, scr, r, F.lane); continue; } r -= I_BR;
        if (r < I_OUT) { p0_transpose_item(F.wout, D, D, (bf16*)(F.ws + WS_WOUT), D, 0, nullptr, scr, r, F.lane); continue; } r -= I_OUT;
        if (r < I_UP) { p0_transpose_item(F.wup, D, FF, (bf16*)(F.ws + WS_WUP), D, 0, F.g2, scr, r, F.lane); continue; } r -= I_UP;
        p0_transpose_item(F.wdn, FF, D, (bf16*)(F.ws + WS_WDN), FF, 0, nullptr, scr, r, F.lane);
    }
    bf16* H = (bf16*)(F.ws + WS_BUFA);
    for (int m = gw; m < M_ROWS; m += NGW) {
        const f32x4* xr = (const f32x4*)xrow_ptr(F, m) + F.lane; f32x4 v[8]; float s = 0.f;
#pragma unroll
        for (int j = 0; j < 8; ++j) { v[j] = xr[64 * j]; s += (v[j].x * v[j].x + v[j].y * v[j].y) + (v[j].z * v[j].z + v[j].w * v[j].w); }
        const float rstd = 1.0f / sqrtf(wave_sum(s) * (1.f / D) + EPS);
        unsigned long long* o8 = (unsigned long long*)(H + (size_t)m * D) + F.lane; const f32x4* gp = (const f32x4*)F.g1 + F.lane;
#pragma unroll
        for (int j = 0; j < 8; ++j) { const f32x4 g = gp[64 * j]; o8[64 * j] = (unsigned long long)pk2(v[j].x * rstd * g.x, v[j].y * rstd * g.y) | ((unsigned long long)pk2(v[j].z * rstd * g.z, v[j].w * rstd * g.w) << 32); }
    }
    float* BA = (float*)(F.ws + WS_TAB);
    for (int i = F.bid * 512 + F.tid; i < 8 * 257; i += F.G * 512) { const int h = i / 257, rel = i % 257 - 128; BA[i] = F.t5[t5_bucket_dev(rel) * 8 + h]; }
}

struct SeqPos { int base, t, L; };
__device__ __forceinline__ SeqPos seq_of_row(int row) { SeqPos p; if (row < NP_ROWS) { p.base = row & ~4095; p.t = row & 4095; p.L = 4096; } else { const int r2 = row - NP_ROWS; p.base = NP_ROWS + (r2 & ~2047); p.t = r2 & 2047; p.L = 2048; } return p; }
__device__ __forceinline__ float rstd_ss(const float* SS, int row, int hs) { const f32x4 p = *(const f32x4*)(SS + ((size_t)row * 36 + hs) * 4); return 1.0f / sqrtf(((p.x + p.y) + (p.z + p.w)) * (1.f / HD) + EPS); }
__device__ __forceinline__ void naive_core(const Frame& F, float* qs, float* sc, int* kr, int nk, int row, int qoff, int koff, int voff, int hsq, int hsk, const float* gq, const float* gk, bool has_sink, float sinkv, int outcol) {
    const bf16* QKV = (const bf16*)(F.ws + WS_QKV); const float* SS = (const float*)(F.ws + WS_SS); bf16* ATT = (bf16*)(F.ws + WS_BUFA);
    const int lane = F.lane;
    { const unsigned w = *(const unsigned*)(QKV + (size_t)row * QKVW + qoff + 2 * lane); const float sc0 = 0.08838834764831845f;
      qs[2 * lane] = bflo(w) * gq[2 * lane] * gk[2 * lane] * sc0; qs[2 * lane + 1] = bfhi(w) * gq[2 * lane + 1] * gk[2 * lane + 1] * sc0; }
    const float rq = rstd_ss(SS, row, hsq);
    wave_sync();
    float sv[5]; float mx = -1e30f;
#pragma unroll
    for (int i = 0; i < 5; ++i) { const int j = lane + 64 * i; float s = -1e30f;
        if (j < nk && kr[j] >= 0) { const int k = kr[j]; const float rk = rstd_ss(SS, k, hsk); const v4u* kp = (const v4u*)(QKV + (size_t)k * QKVW + koff); float dot = 0.f;
            for (int c = 0; c < 16; ++c) { const v4u w = kp[c]; const float* q = qs + 8 * c;
                dot += q[0] * bflo(w.x) + q[1] * bfhi(w.x) + q[2] * bflo(w.y) + q[3] * bfhi(w.y) + q[4] * bflo(w.z) + q[5] * bfhi(w.z) + q[6] * bflo(w.w) + q[7] * bfhi(w.w); }
            s = dot * rq * rk + sc[j]; }
        sv[i] = s; mx = fmaxf(mx, s); }
    mx = wave_max(mx); if (has_sink) mx = fmaxf(mx, sinkv);
    float sum = 0.f;
#pragma unroll
    for (int i = 0; i < 5; ++i) { sv[i] = __expf(sv[i] - mx); sum += sv[i]; }
    sum = wave_sum(sum); if (has_sink) sum += __expf(sinkv - mx);
    const float inv = 1.0f / sum;
    wave_sync();
#pragma unroll
    for (int i = 0; i < 5; ++i) sc[lane + 64 * i] = sv[i] * inv;
    wave_sync();
    float a0 = 0.f, a1 = 0.f;
    for (int j = 0; j < nk; ++j) { const int k = kr[j]; if (k >= 0) { const float p = sc[j]; const unsigned w = *(const unsigned*)(QKV + (size_t)k * QKVW + voff + 2 * lane); a0 += p * bflo(w); a1 += p * bfhi(w); } }
    *(unsigned*)(ATT + (size_t)row * D + outcol + 2 * lane) = pk2(a0, a1);
    wave_sync();
}
__device__ __forceinline__ void naive_attention(Frame& F) {
    float* qs = (float*)(F.lds + F.wave * 4096); float* sc = qs + 128; int* kr = (int*)(sc + 320);
    const float* BA = (const float*)(F.ws + WS_TAB);
    const int gw = F.bid * NWAVES + F.wave, NGW = F.G * NWAVES, lane = F.lane;
    for (int it = gw; it < M_ROWS * 16; it += NGW) {
        const int row = it >> 4, hh = it & 15; const SeqPos sp = seq_of_row(row);
#ifdef PROBE_ZERO
        if ((PROBE_ZERO == 3) || (PROBE_ZERO == 1 && hh < 8) || (PROBE_ZERO == 2 && hh >= 8)) { *(unsigned*)((bf16*)(F.ws + WS_BUFA) + (size_t)row * D + hh * 128 + 2 * lane) = 0u; continue; }
#endif
        if (hh < 8) {
            const int h = hh, hk = h >> 2;
#pragma unroll
            for (int i = 0; i < 5; ++i) { const int j = lane + 64 * i; const int kt = sp.t - 128 + j; const bool ok = (j < 257) && kt >= 0 && kt < sp.L; kr[j] = ok ? sp.base + kt : -1; sc[j] = ok ? F.t5[t5_bucket_dev(j - 128) * 8 + h] : 0.f; }
            wave_sync();
            naive_core(F, qs, sc, kr, 257, row, h * 128, 1024 + hk * 128, 1280 + hk * 128, h, 8 + hk, F.gqa, F.gka, true, F.sink[h], h * 128);
        } else {
            const int h = hh - 8, rows = sp.L >> 6, r = sp.t >> 6, c = sp.t & 63;
            int rs = r - 4; rs = rs < 0 ? 0 : (rs > rows - 8 ? rows - 8 : rs);
            int cs = c - 8; cs = cs < 0 ? 0 : (cs > 48 ? 48 : cs);
#pragma unroll
            for (int i = 0; i < 5; ++i) { const int j = lane + 64 * i; const int kr_ = rs + (j >> 4), kc = cs + (j & 15); const bool ok = j < 128;
                int dcc = kc - c; dcc = (dcc < -15 ? -15 : (dcc > 15 ? 15 : dcc)) + 15; const int dr = kr_ - r + 7;
                kr[j] = ok ? sp.base + kr_ * 64 + kc : -1; sc[j] = ok ? F.rpb[(h * 15 + dr) * 31 + dcc] : 0.f; }
            wave_sync();
            naive_core(F, qs, sc, kr, 128, row, 1536 + h * 128, 2560 + h * 128, 3584 + h * 128, 12 + h, 20 + h, F.gqb, F.gkb, false, 0.f, 1024 + h * 128);
        }
    }
}

struct Args { const float* in[17]; float* out; unsigned char* ws; int ph_lo, ph_hi; };
constexpr int N_PHASES = 8;
__global__ void __launch_bounds__(NWAVES * 64, 2) fwd_megakernel(Args args) {
    extern __shared__ __attribute__((aligned(16))) unsigned char lds[];
    cg::grid_group grid = cg::this_grid();
    Frame F;
    F.lds = lds; F.tid = threadIdx.x; F.lane = F.tid & 63; F.wave = __builtin_amdgcn_readfirstlane(F.tid >> 6); F.G = gridDim.x; F.bid = blockIdx.x;
    F.xp = args.in[0]; F.xs = args.in[1]; F.g1 = args.in[2]; F.w_in = args.in[3]; F.gqa = args.in[4]; F.gka = args.in[5]; F.t5 = args.in[6]; F.sink = args.in[7];
    F.gqb = args.in[8]; F.gkb = args.in[9]; F.rpb = args.in[10]; F.wbra = args.in[11]; F.wbrb = args.in[12]; F.wout = args.in[13]; F.g2 = args.in[14]; F.wup = args.in[15]; F.wdn = args.in[16];
    F.out = args.out; F.ws = args.ws;
    unsigned char* ws = args.ws;
    PG8_LAS unsigned char* ldsl = (PG8_LAS unsigned char*)lds;
    const int lo = args.ph_lo, hi = args.ph_hi;
#ifndef PHASE_MASK
#define PHASE_MASK 0xff
#endif
#define IN(k) (((PHASE_MASK >> (k)) & 1) && lo <= (k) && (k) < hi)
#define SEAM(k) do { if (IN(k) && IN((k) + 1)) grid.sync(); } while (0)
    bf16* BUFA = (bf16*)(ws + WS_BUFA); bf16* QKV = (bf16*)(ws + WS_QKV); bf16* GATES = (bf16*)(ws + WS_GATES);
    float* SS = (float*)(ws + WS_SS); float* SS2 = (float*)(ws + WS_SS2); float* RSTD2 = (float*)(ws + WS_RSTD2);

    if (IN(0)) { p0_prologue(F); __syncthreads(); }
    SEAM(0);
    if (IN(1)) {
        pg8::Gemm g{BUFA, (const bf16*)(ws + WS_WIN), M_ROWS, INW, D}; pg8::StaticOrder S; S.init(M_ROWS, INW, F.G, F.bid);
        pg8::EpiProj E{QKV, GATES, SS};
        pg8::gemm_phase<pg8::EpiProj, pg8::StaticOrder, true, true>(ldsl, g, S, E);
    }
    SEAM(1);
    if (IN(2)) { naive_attention(F); __syncthreads(); }
    SEAM(2);
    if (IN(3)) {
        pg8::Gemm g{BUFA, (const bf16*)(ws + WS_WBR), M_ROWS, D, D}; pg8::StaticOrder S; S.init(M_ROWS, D, F.G, F.bid);
        pg8::EpiMerge E{GATES, QKV};
        pg8::gemm_phase<pg8::EpiMerge, pg8::StaticOrder, true, true>(ldsl, g, S, E);
    }
    SEAM(3);
    if (IN(4)) {
        pg8::Gemm g{QKV, (const bf16*)(ws + WS_WOUT), M_ROWS, D, D}; pg8::StaticOrder S; S.init(M_ROWS, D, F.G, F.bid);
        pg8::EpiOut1 E{F.xp, F.xs, F.out, BUFA, SS2};
        pg8::gemm_phase<pg8::EpiOut1, pg8::StaticOrder, true, true>(ldsl, g, S, E);
    }
    SEAM(4);
    if (IN(5)) {
        for (int m = F.bid * 512 + F.tid; m < M_ROWS; m += F.G * 512) { const f32x4* p = (const f32x4*)(SS2 + (size_t)m * 32); float s = 0.f;
#pragma unroll
            for (int j = 0; j < 8; ++j) { const f32x4 v = p[j]; s += (v.x + v.y) + (v.z + v.w); }
            RSTD2[m] = 1.0f / sqrtf(s * (1.f / D) + EPS); }
    }
    SEAM(5);
    if (IN(6)) {
        pg8::Gemm g{BUFA, (const bf16*)(ws + WS_WUP), M_ROWS, FF, D}; pg8::StaticOrder S; S.init(M_ROWS, FF, F.G, F.bid);
        pg8::EpiUp E{RSTD2, QKV};
        pg8::gemm_phase<pg8::EpiUp, pg8::StaticOrder, true, true>(ldsl, g, S, E);
    }
    SEAM(6);
    if (IN(7)) {
        pg8::Gemm g{QKV, (const bf16*)(ws + WS_WDN), M_ROWS, D, FF}; pg8::StaticOrder S; S.init(M_ROWS, D, F.G, F.bid);
        pg8::EpiDown E{F.out};
        pg8::gemm_phase<pg8::EpiDown, pg8::StaticOrder, true, true>(ldsl, g, S, E);
    }
#undef IN
#undef SEAM
}


#ifdef SELFCHECK
__device__ __forceinline__ float bf1(const bf16* p) { return __uint_as_float(((unsigned)*p) << 16); }
__device__ __forceinline__ float rbf(float f) { return __uint_as_float(f2bf(f) << 16); }
__global__ void chk_kernel(Args a, int which) {
    const int lane = threadIdx.x, e = blockIdx.x; unsigned char* ws = a.ws; unsigned* flags = (unsigned*)(ws + WS_TAB + 65536);
    const bf16* BUFA = (const bf16*)(ws + WS_BUFA); const bf16* QKV = (const bf16*)(ws + WS_QKV); const bf16* GATES = (const bf16*)(ws + WS_GATES);
    const float* SS = (const float*)(ws + WS_SS); const float* RSTD2 = (const float*)(ws + WS_RSTD2);
    unsigned h1 = (unsigned)e * 2654435761u + 12345u; h1 ^= h1 >> 15; h1 *= 2246822519u; h1 ^= h1 >> 13; h1 *= 3266489917u; h1 ^= h1 >> 16;
    unsigned h2 = ((unsigned)e + 777u) * 2246822519u; h2 ^= h2 >> 13; h2 *= 2654435761u; h2 ^= h2 >> 16; h2 *= 668265263u; h2 ^= h2 >> 15;
    const int row = (int)(h1 % (unsigned)M_ROWS);
    bool bad = false;
    if (which == 0) { const int col = (int)(h2 % (unsigned)INW); float s = 0.f;
        for (int k = lane; k < D; k += 64) s += bf1(BUFA + (size_t)row * D + k) * rbf(a.in[3][(size_t)k * INW + col]);
        s = wave_sum(s);
        float got, ref; if (col < QKVW) { got = bf1(QKV + (size_t)row * QKVW + col); ref = s; } else { got = bf1(GATES + (size_t)row * GW_ + col - QKVW); ref = 1.f / (1.f + expf(-s)); }
        bad = false; if (fabsf(got - ref) > 0.02f + 0.01f * fabsf(ref) && lane == 0) atomicOr(flags, (col < QKVW ? 1u : 2u) | ((col & 7) < 4 ? 4u : 8u) | ((row & 15) < 8 ? 16u : 32u));
    } else if (which == 1) { const int hs = (int)(h2 % 36u); float s = 0.f;
        for (int c = lane; c < 128; c += 64) { const float v = bf1(QKV + (size_t)row * QKVW + hs * 128 + c); s += v * v; }
        s = wave_sum(s); const float* p = SS + ((size_t)row * 36 + hs) * 4; const float got = p[0] + p[1] + p[2] + p[3];
        bad = fabsf(got - s) > 0.02f * s + 1e-3f;
    } else if (which == 2) { const int col = (int)(h2 % (unsigned)D); float ya = 0.f, yb = 0.f;
        for (int k = lane; k < 1024; k += 64) { ya += bf1(BUFA + (size_t)row * D + k) * rbf(a.in[11][(size_t)k * D + col]); yb += bf1(BUFA + (size_t)row * D + 1024 + k) * rbf(a.in[12][(size_t)k * D + col]); }
        ya = wave_sum(ya); yb = wave_sum(yb);
        const float ref = bf1(GATES + (size_t)row * GW_ + col) * ya + bf1(GATES + (size_t)row * GW_ + 2048 + col) * yb; const float got = bf1(QKV + (size_t)row * D + col);
        bad = fabsf(got - ref) > 0.004f + 0.02f * fabsf(ref);
    } else if (which == 3) { const int col = (int)(h2 % (unsigned)D); float s = 0.f;
        for (int k = lane; k < D; k += 64) s += bf1(QKV + (size_t)row * D + k) * rbf(a.in[13][(size_t)k * D + col]);
        s = wave_sum(s); const float xv = row < NP_ROWS ? a.in[0][(size_t)row * D + col] : a.in[1][(size_t)(row - NP_ROWS) * D + col];
        const float ref = xv + s, got = a.out[(size_t)row * D + col], gotb = bf1(BUFA + (size_t)row * D + col);
        bad = fabsf(got - ref) > 0.004f + 0.002f * fabsf(ref) || fabsf(gotb - ref) > 0.004f + 0.01f * fabsf(ref);
    } else if (which == 4) { float s = 0.f;
        for (int k = lane; k < D; k += 64) { const float v = a.out[(size_t)row * D + k]; s += v * v; }
        s = wave_sum(s); const float ref = 1.f / sqrtf(s / D + EPS); bad = fabsf(RSTD2[row] - ref) > 0.001f * ref;
    } else if (which == 5) { const int col = (int)(h2 % (unsigned)FF); float s = 0.f;
        for (int k = lane; k < D; k += 64) s += bf1(BUFA + (size_t)row * D + k) * rbf(a.in[14][k] * a.in[15][(size_t)k * FF + col]);
        s = wave_sum(s) * RSTD2[row]; const float r = fmaxf(s, 0.f) * fmaxf(s, 0.f); const float got = bf1(QKV + (size_t)row * FF + col);
        bad = fabsf(got - r) > 0.01f + 0.03f * fabsf(r);
    }
    else if (which == 8) { const int col = (int)(h2 % (unsigned)D); float s = 0.f;
        for (int k = lane; k < FF; k += 64) s += bf1(QKV + (size_t)row * FF + k) * rbf(a.in[16][(size_t)k * D + col]);
        s = wave_sum(s); const float ref = bf1(BUFA + (size_t)row * D + col) + s, got = a.out[(size_t)row * D + col];
        bad = fabsf(got - ref) > 0.03f + 0.01f * fabsf(ref);
    }
    else if (which == 6 || which == 7) {
        __shared__ float sh_s[320]; __shared__ int sh_k[320];
        const int h = (int)(h2 % 8u); const bool isA = (which == 6); const SeqPos sp = seq_of_row(row);
        const int qoff = isA ? h * 128 : 1536 + h * 128, koff = isA ? 1024 + (h / 4) * 128 : 2560 + h * 128, voff = isA ? 1280 + (h / 4) * 128 : 3584 + h * 128;
        const float* gq = isA ? a.in[4] : a.in[8]; const float* gk = isA ? a.in[5] : a.in[9];
        float qn[2]; { float q0 = bf1(QKV + (size_t)row * QKVW + qoff + lane), q1 = bf1(QKV + (size_t)row * QKVW + qoff + 64 + lane);
            const float ssq = wave_sum(q0 * q0 + q1 * q1); const float r = 1.f / sqrtf(ssq / 128.f + EPS); qn[0] = q0 * r * gq[lane] * 0.08838834764831845f; qn[1] = q1 * r * gq[64 + lane] * 0.08838834764831845f; }
        int nk = 0;
        if (isA) { nk = 257; for (int j = lane; j < 320; j += 64) { const int kt = sp.t - 128 + j; sh_k[j] = (j < 257 && kt >= 0 && kt < sp.L) ? sp.base + kt : -1; } }
        else { nk = 256; const int rows = sp.L / 64, r = sp.t / 64, c = sp.t % 64; int rs = r - 4; if (rs < 0) rs = 0; if (rs > rows - 8) rs = rows - 8; const int cb = c / 16; int reg = cb * 16 - 8; if (reg < 0) reg = 0; if (reg > 32) reg = 32;
            int sc_ = c - 8; if (sc_ < 0) sc_ = 0; if (sc_ > 48) sc_ = 48;
            for (int j = lane; j < 320; j += 64) { const int kc = reg + (j & 31), kr_ = rs + (j >> 5); sh_k[j] = (j < 256 && kc >= sc_ && kc < sc_ + 16) ? sp.base + kr_ * 64 + kc : -1; } }
        __syncthreads();
        for (int j = 0; j < nk; ++j) { const int k = sh_k[j]; float sv = -1e30f;
            if (k >= 0) { const float k0 = bf1(QKV + (size_t)k * QKVW + koff + lane), k1 = bf1(QKV + (size_t)k * QKVW + koff + 64 + lane);
                const float ssk = wave_sum(k0 * k0 + k1 * k1); const float rk = 1.f / sqrtf(ssk / 128.f + EPS);
                float d = wave_sum(qn[0] * k0 * rk * gk[lane] + qn[1] * k1 * rk * gk[64 + lane]);
                float bias;
                if (isA) { const int rel = (k - sp.base) - sp.t; bias = a.in[6][t5_bucket_dev(rel) * 8 + h]; }
                else { const int kt = k - sp.base, kr_ = kt / 64, kc = kt % 64, r = sp.t / 64, c = sp.t % 64; int dcc = kc - c; if (dcc < -15) dcc = -15; if (dcc > 15) dcc = 15; bias = a.in[10][(h * 15 + (kr_ - r + 7)) * 31 + dcc + 15]; }
                sv = d + bias; }
            if (lane == 0) sh_s[j] = sv; }
        __syncthreads();
        float m = -1e30f; for (int j = 0; j < nk; ++j) m = fmaxf(m, sh_s[j]);
        if (isA) m = fmaxf(m, a.in[7][h]);
        float den = 0.f; for (int j = 0; j < nk; ++j) den += expf(sh_s[j] - m);
        if (isA) den += expf(a.in[7][h] - m);
        float o0 = 0.f, o1 = 0.f;
        for (int j = 0; j < nk; ++j) { const int k = sh_k[j]; if (k >= 0) { const float p = expf(sh_s[j] - m) / den; o0 += p * bf1(QKV + (size_t)k * QKVW + voff + lane); o1 += p * bf1(QKV + (size_t)k * QKVW + voff + 64 + lane); } }
        const int oc = isA ? h * 128 : 1024 + h * 128;
        const float g0 = bf1(BUFA + (size_t)row * D + oc + lane), g1 = bf1(BUFA + (size_t)row * D + oc + 64 + lane);
        const bool b2 = fabsf(g0 - o0) > 0.004f + 0.015f * fabsf(o0) || fabsf(g1 - o1) > 0.004f + 0.015f * fabsf(o1);
        bad = __any(b2);
    }
    if (which == 10) { const float* xr = row < NP_ROWS ? a.in[0] + (size_t)row * D : a.in[1] + (size_t)(row - NP_ROWS) * D; float ss = 0.f;
        for (int k = lane; k < D; k += 64) ss += xr[k] * xr[k];
        ss = wave_sum(ss); const float r = 1.f / sqrtf(ss / D + EPS); bool b2 = false;
        for (int k = lane; k < D; k += 64) { const float ref = xr[k] * r * a.in[2][k], got = bf1(BUFA + (size_t)row * D + k); b2 = b2 || fabsf(got - ref) > 0.002f + 0.006f * fabsf(ref); }
        bad = __any(b2); }
    if (lane == 0 && bad && which == 0) atomicOr(flags, 1u << which);
}
__global__ void chk_final(Args a) { const unsigned f = *(const unsigned*)(a.ws + WS_TAB + 65536); const int i = blockIdx.x * 256 + threadIdx.x; if (i < 4096) { a.out[i] += 100.f * (float)f; a.out[4096 + i] += 30.f; } }
#endif
extern "C" void kernel_launch(void* const* d_in, const int* in_sizes, int n_in, void* d_out, int out_size, void* d_ws, size_t ws_size, hipStream_t stream) {
    static int grid = 0;
    if (grid == 0) {
        if (n_in != 17 || in_sizes[0] != NP_ROWS * D || in_sizes[1] != (M_ROWS - NP_ROWS) * D || out_size != M_ROWS * D || ws_size < WS_END) {
            fprintf(stderr, "kernel_launch: shape/workspace mismatch (n_in %d, in0 %d, out %d, ws %zu < %zu); nothing launched\n", n_in, n_in > 0 ? in_sizes[0] : -1, out_size, ws_size, (size_t)WS_END); grid = -1; return; }
        int dev = 0, cus = 0, per_cu = 0;
        if (hipGetDevice(&dev) != hipSuccess || hipDeviceGetAttribute(&cus, hipDeviceAttributeMultiprocessorCount, dev) != hipSuccess) { fprintf(stderr, "kernel_launch: device query failed\n"); grid = -1; return; }
        if (hipFuncSetAttribute((const void*)fwd_megakernel, hipFuncAttributeMaxDynamicSharedMemorySize, LDS_BYTES) != hipSuccess) { fprintf(stderr, "kernel_launch: hipFuncSetAttribute failed\n"); grid = -1; return; }
        if (hipOccupancyMaxActiveBlocksPerMultiprocessor(&per_cu, (const void*)fwd_megakernel, NWAVES * 64, LDS_BYTES) != hipSuccess || per_cu < 1) { fprintf(stderr, "kernel_launch: occupancy query says %d blocks per CU\n", per_cu); per_cu = 1; }
        (void)hipGetLastError();
        grid = cus * 1;
    }
    if (grid < 0) return;
    Args a{};
    for (int i = 0; i < 17; ++i) a.in[i] = (const float*)d_in[i];
    a.out = (float*)d_out; a.ws = (unsigned char*)d_ws;
#if MK_N_LAUNCHES == 1
    a.ph_lo = 0; a.ph_hi = N_PHASES;
    void* kargs[] = {&a};
    hipError_t e = hipLaunchCooperativeKernel((const void*)fwd_megakernel, dim3(grid), dim3(NWAVES * 64), kargs, LDS_BYTES, stream);
    if (e != hipSuccess) fprintf(stderr, "kernel_launch: cooperative launch failed: %s (grid %d)\n", hipGetErrorString(e), grid);
#else
#ifdef SELFCHECK
    hipMemsetAsync((char*)d_ws + WS_TAB + 65536, 0, 64, stream);
#endif
    for (int ph = 0; ph < N_PHASES; ++ph) {
        a.ph_lo = ph; a.ph_hi = ph + 1;
        hipLaunchKernelGGL(fwd_megakernel, dim3(grid), dim3(NWAVES * 64), LDS_BYTES, stream, a);
        const hipError_t le = hipPeekAtLastError();
        if (le != hipSuccess) { fprintf(stderr, "kernel_launch: launch %d failed: %s\n", ph, hipGetErrorName(le)); break; }
#ifdef SELFCHECK
        if (ph == 0) hipLaunchKernelGGL(chk_kernel, dim3(65536), dim3(64), 0, stream, a, 10);
        if (ph == 1) { hipLaunchKernelGGL(chk_kernel, dim3(65536), dim3(64), 0, stream, a, 0); hipLaunchKernelGGL(chk_kernel, dim3(65536), dim3(64), 0, stream, a, 1); }
        if (ph == 2) { hipLaunchKernelGGL(chk_kernel, dim3(65536), dim3(64), 0, stream, a, 6); hipLaunchKernelGGL(chk_kernel, dim3(65536), dim3(64), 0, stream, a, 7); }
        if (ph == 3) hipLaunchKernelGGL(chk_kernel, dim3(65536), dim3(64), 0, stream, a, 2);
        if (ph == 4) hipLaunchKernelGGL(chk_kernel, dim3(65536), dim3(64), 0, stream, a, 3);
        if (ph == 5) hipLaunchKernelGGL(chk_kernel, dim3(65536), dim3(64), 0, stream, a, 4);
        if (ph == 6) hipLaunchKernelGGL(chk_kernel, dim3(65536), dim3(64), 0, stream, a, 5);
        if (ph == 7) { hipLaunchKernelGGL(chk_kernel, dim3(65536), dim3(64), 0, stream, a, 8); }
        if (ph == 7) hipLaunchKernelGGL(chk_final, dim3(16), dim3(256), 0, stream, a);
#endif
    }
#endif
}
```

```cpp
#include <hip/hip_runtime.h>
#include <hip/hip_cooperative_groups.h>
#include <cstdio>
#include <cstdint>
namespace cg = cooperative_groups;
#define MK_N_LAUNCHES 1
namespace pg8 {
#define PG8_LAS __attribute__((address_space(3)))
typedef unsigned short bf16_t;
typedef short bf16x8 __attribute__((ext_vector_type(8)));
typedef float f32x4 __attribute__((ext_vector_type(4)));
typedef unsigned u32x4 __attribute__((ext_vector_type(4)));
constexpr int BM = 256, BK = 64, HALF = 128, HTB = HALF * BK * 2  , STAGE_BYTES = 8 * HTB, NXCD = 8, WGM = 8;

__host__ __device__ __forceinline__ int lds_byte(int r, int c) { const int st = (r >> 4) * 2 + (c >> 5), rr = r & 15, cc = c & 31, ob = rr * 64 + cc * 2; return st * 1024 + (ob ^ (((ob >> 9) & 1) << 5)); }
__host__ __device__ __forceinline__ void stage_rc(int b, int& R, int& C) { const int st = b / 1024, sb = b % 1024, swz = sb ^ (((sb >> 9) & 1) << 5); R = (st >> 1) * 16 + swz / 64; C = (st & 1) * 32 + (swz % 64) / 2; }
__host__ __device__ __forceinline__ int perm32(int rho) { const int n = rho >> 4, i = rho & 15; return 8 * (i >> 2) + 4 * n + (i & 3); }

struct Unit { int pm, pn; };
struct Gemm { const bf16_t* A; const bf16_t* Bt; int M, N, K; };

struct StaticOrder {
    int nM, nN, nwg, G, c;
    __host__ __device__ void init(int M, int N, int G_, int c_) { nM = M / BM; nN = N / BM; nwg = nM * nN; G = G_; c = c_; }
    __host__ __device__ bool next(int i, Unit& u) const {
        const long L = (long)i * G + c; if (L >= nwg) return false;
        int wgid = (int)L; { const int q = nwg / NXCD, r = nwg % NXCD, xcd = wgid % NXCD, off = wgid / NXCD; wgid = (xcd < r ? xcd * (q + 1) : r * (q + 1) + (xcd - r) * q) + off; }
        const int nig = WGM * nN, gid = wgid / nig, fm = gid * WGM, gsz = (nM - fm) < WGM ? (nM - fm) : WGM;
        u.pm = fm + ((wgid % nig) % gsz); u.pn = (wgid % nig) / gsz; return true;
    }
    __device__ __forceinline__ void a_ready(const Unit&) const {}
    __device__ __forceinline__ void done(const Unit&) const {}
};

__device__ __forceinline__ unsigned cvt_pk_bf16(float lo, float hi) { unsigned r; asm volatile("s_nop 0\n\tv_cvt_pk_bf16_f32 %0, %1, %2" : "=v"(r) : "v"(lo), "v"(hi)); return r; }
typedef float f32x2 __attribute__((ext_vector_type(2)));
typedef unsigned u32x2 __attribute__((ext_vector_type(2)));
__device__ __forceinline__ float bf_lo(unsigned w) { return __uint_as_float(w << 16); }
__device__ __forceinline__ float bf_hi(unsigned w) { return __uint_as_float(w & 0xffff0000u); }
__device__ __forceinline__ u32x4 pack8(const f32x4 v0, const f32x4 v1) { u32x4 w; w.x = cvt_pk_bf16(v0[0], v0[1]); w.y = cvt_pk_bf16(v0[2], v0[3]); w.z = cvt_pk_bf16(v1[0], v1[1]); w.w = cvt_pk_bf16(v1[2], v1[3]); return w; }
__device__ __forceinline__ float sigmoidf_(float x) { return __builtin_amdgcn_rcpf(1.0f + __builtin_amdgcn_exp2f(-1.44269504089f * x)); }
constexpr int QKV_LD = 4608, GATE_LD = 4096, DM = 2048, FFD = 8192, NHS = 36, NPROMPT_ROWS = 32768;

struct EpiProj {
    static constexpr bool PERM = true, AFTER_DRAIN = false, MID = false;
    bf16_t* QKV; bf16_t* GATES; float* SS;
    __device__ __forceinline__ void operator()(const f32x4 (&acc)[2][2][4][2], const Unit& u, int wr, int wc, int fr, int fq) const {
        const int row0 = u.pm * BM + wr * 64 + fr;
        if (u.pn < 18) {
            const int col0 = u.pn * BM + wc * 32 + 8 * fq;
#pragma unroll
            for (int ai = 0; ai < 2; ++ai)
#pragma unroll
                for (int m = 0; m < 4; ++m) { const int row = row0 + ai * HALF + m * 16; bf16_t* rowp = QKV + (size_t)row * QKV_LD + col0;
#pragma unroll
                    for (int bj = 0; bj < 2; ++bj) { const f32x4 v0 = acc[ai][bj][m][0], v1 = acc[ai][bj][m][1];
                        float s = (v0[0] * v0[0] + v0[1] * v0[1]) + (v0[2] * v0[2] + v0[3] * v0[3]) + (v1[0] * v1[0] + v1[1] * v1[1]) + (v1[2] * v1[2] + v1[3] * v1[3]);
                        s += __shfl_xor(s, 16); s += __shfl_xor(s, 32);
                        if (fq == 0) SS[((size_t)row * NHS + u.pn * 2 + bj) * 4 + wc] = s;
                        *(u32x4*)(rowp + bj * HALF) = pack8(v0, v1); } }
        } else {
            const int col0 = (u.pn - 18) * BM + wc * 32 + 8 * fq;
#pragma unroll
            for (int ai = 0; ai < 2; ++ai)
#pragma unroll
                for (int m = 0; m < 4; ++m) { const int row = row0 + ai * HALF + m * 16; bf16_t* rowp = GATES + (size_t)row * GATE_LD + col0;
#pragma unroll
                    for (int bj = 0; bj < 2; ++bj) { f32x4 v0 = acc[ai][bj][m][0], v1 = acc[ai][bj][m][1];
#pragma unroll
                        for (int j = 0; j < 4; ++j) { v0[j] = sigmoidf_(v0[j]); v1[j] = sigmoidf_(v1[j]); }
                        *(u32x4*)(rowp + bj * HALF) = pack8(v0, v1); } }
        }
    }
};

struct EpiMerge {
    static constexpr bool PERM = true, AFTER_DRAIN = false, MID = true;
    const bf16_t* GATES; bf16_t* OUT;
    __device__ __forceinline__ void mid(f32x4 (&acc)[2][2][4][2], const Unit& u, int wr, int wc, int fr, int fq) const {
        const int row0 = u.pm * BM + wr * 64 + fr, col0 = u.pn * BM + wc * 32 + 8 * fq;
        const bf16_t* gp0 = GATES + (size_t)row0 * GATE_LD + col0;
        asm volatile("" : "+v"(gp0));
#pragma unroll
        for (int ai = 0; ai < 2; ++ai)
#pragma unroll
            for (int m = 0; m < 4; ++m)
#pragma unroll
                for (int bj = 0; bj < 2; ++bj) { const bf16_t* gp = gp0 + (size_t)(ai * HALF + m * 16) * GATE_LD + bj * HALF;
                    const u32x4 a = *(const u32x4*)gp, b = *(const u32x4*)(gp + DM);
                    f32x4& c0 = acc[ai][bj][m][0]; f32x4& c1 = acc[ai][bj][m][1];
                    c0[0] *= bf_lo(a.x) * __builtin_amdgcn_rcpf(bf_lo(b.x)); c0[1] *= bf_hi(a.x) * __builtin_amdgcn_rcpf(bf_hi(b.x));
                    c0[2] *= bf_lo(a.y) * __builtin_amdgcn_rcpf(bf_lo(b.y)); c0[3] *= bf_hi(a.y) * __builtin_amdgcn_rcpf(bf_hi(b.y));
                    c1[0] *= bf_lo(a.z) * __builtin_amdgcn_rcpf(bf_lo(b.z)); c1[1] *= bf_hi(a.z) * __builtin_amdgcn_rcpf(bf_hi(b.z));
                    c1[2] *= bf_lo(a.w) * __builtin_amdgcn_rcpf(bf_lo(b.w)); c1[3] *= bf_hi(a.w) * __builtin_amdgcn_rcpf(bf_hi(b.w));
                    asm volatile("" ::: "memory"); }
    }
    __device__ __forceinline__ void operator()(const f32x4 (&acc)[2][2][4][2], const Unit& u, int wr, int wc, int fr, int fq) const {
        const int row0 = u.pm * BM + wr * 64 + fr, col0 = u.pn * BM + wc * 32 + 8 * fq;
#pragma unroll
        for (int ai = 0; ai < 2; ++ai)
#pragma unroll
            for (int m = 0; m < 4; ++m) { const size_t row = (size_t)(row0 + ai * HALF + m * 16); const bf16_t* gp = GATES + row * GATE_LD + DM + col0; bf16_t* op = OUT + row * DM + col0;
#pragma unroll
                for (int bj = 0; bj < 2; ++bj) { const u32x4 b = *(const u32x4*)(gp + bj * HALF);
                    f32x4 v0 = acc[ai][bj][m][0], v1 = acc[ai][bj][m][1];
                    v0[0] *= bf_lo(b.x); v0[1] *= bf_hi(b.x); v0[2] *= bf_lo(b.y); v0[3] *= bf_hi(b.y);
                    v1[0] *= bf_lo(b.z); v1[1] *= bf_hi(b.z); v1[2] *= bf_lo(b.w); v1[3] *= bf_hi(b.w);
                    *(u32x4*)(op + bj * HALF) = pack8(v0, v1); }
                asm volatile("" ::: "memory"); }
    }
};

struct EpiOut1 {
    static constexpr bool PERM = true, AFTER_DRAIN = false, MID = false;
    const float* xp; const float* xs; float* OUT; bf16_t* X1B; float* SS2;
    __device__ __forceinline__ void operator()(const f32x4 (&acc)[2][2][4][2], const Unit& u, int wr, int wc, int fr, int fq) const {
        const int row0 = u.pm * BM + wr * 64 + fr, col0 = u.pn * BM + wc * 32 + 8 * fq;
        const float* xb = (u.pm * BM < NPROMPT_ROWS) ? xp : xs - (size_t)NPROMPT_ROWS * DM;
#pragma unroll
        for (int ai = 0; ai < 2; ++ai)
#pragma unroll
            for (int m = 0; m < 4; ++m) { const size_t row = (size_t)(row0 + ai * HALF + m * 16); const float* xr = xb + row * DM + col0; float* op = OUT + row * DM + col0; bf16_t* bp = X1B + row * DM + col0;
                float s = 0.f;
#pragma unroll
                for (int bj = 0; bj < 2; ++bj) { const f32x4 v0 = acc[ai][bj][m][0] + *(const f32x4*)(xr + bj * HALF), v1 = acc[ai][bj][m][1] + *(const f32x4*)(xr + bj * HALF + 4);
                    s += (v0[0] * v0[0] + v0[1] * v0[1]) + (v0[2] * v0[2] + v0[3] * v0[3]) + (v1[0] * v1[0] + v1[1] * v1[1]) + (v1[2] * v1[2] + v1[3] * v1[3]);
                    *(f32x4*)(op + bj * HALF) = v0; *(f32x4*)(op + bj * HALF + 4) = v1; *(u32x4*)(bp + bj * HALF) = pack8(v0, v1); }
                s += __shfl_xor(s, 16); s += __shfl_xor(s, 32);
                if (fq == 0) SS2[row * 32 + u.pn * 4 + wc] = s;
                asm volatile("" ::: "memory"); }
    }
};

struct EpiUp {
    static constexpr bool PERM = true, AFTER_DRAIN = false, MID = false;
    const float* RSTD2; bf16_t* U;
    __device__ __forceinline__ void operator()(const f32x4 (&acc)[2][2][4][2], const Unit& u, int wr, int wc, int fr, int fq) const {
        const int row0 = u.pm * BM + wr * 64 + fr, col0 = u.pn * BM + wc * 32 + 8 * fq;
#pragma unroll
        for (int ai = 0; ai < 2; ++ai)
#pragma unroll
            for (int m = 0; m < 4; ++m) { const size_t row = (size_t)(row0 + ai * HALF + m * 16); const float rs = RSTD2[row]; bf16_t* op = U + row * FFD + col0;
#pragma unroll
                for (int bj = 0; bj < 2; ++bj) { f32x4 v0 = acc[ai][bj][m][0] * rs, v1 = acc[ai][bj][m][1] * rs;
#pragma unroll
                    for (int j = 0; j < 4; ++j) { const float a = fmaxf(v0[j], 0.f), b = fmaxf(v1[j], 0.f); v0[j] = a * a; v1[j] = b * b; }
                    *(u32x4*)(op + bj * HALF) = pack8(v0, v1); } }
    }
};

struct EpiDown {
    static constexpr bool PERM = true, AFTER_DRAIN = false, MID = false;
    float* OUT;
    __device__ __forceinline__ void operator()(const f32x4 (&acc)[2][2][4][2], const Unit& u, int wr, int wc, int fr, int fq) const {
        const int row0 = u.pm * BM + wr * 64 + fr, col0 = u.pn * BM + wc * 32 + 8 * fq;
#pragma unroll
        for (int ai = 0; ai < 2; ++ai)
#pragma unroll
            for (int m = 0; m < 4; ++m) { float* op = OUT + (size_t)(row0 + ai * HALF + m * 16) * DM + col0;
#pragma unroll
                for (int bj = 0; bj < 2; ++bj) { const f32x4 v0 = acc[ai][bj][m][0] + *(const f32x4*)(op + bj * HALF), v1 = acc[ai][bj][m][1] + *(const f32x4*)(op + bj * HALF + 4);
                    *(f32x4*)(op + bj * HALF) = v0; *(f32x4*)(op + bj * HALF + 4) = v1; }
                asm volatile("" ::: "memory"); }
    }
};

template <class Epi, class Sched, bool ALIGN_EPI = false, bool SP2 = false>
__device__ __forceinline__ void gemm_phase(PG8_LAS unsigned char* lds, const Gemm g, const Sched& S, const Epi& E) {
    const int tid = threadIdx.x, wid = __builtin_amdgcn_readfirstlane(tid >> 6), lane = tid & 63, wr = wid >> 2, wc = wid & 3, fr = lane & 15, fq = lane >> 4;
    const int K = g.K, nt = K / BK;
    unsigned voffA[2], voffB[2];
#pragma unroll
    for (int i = 0; i < 2; ++i) { int R, C; stage_rc(tid * 16 + i * 8192, R, C); const int Rb = Epi::PERM ? ((R & ~31) + perm32(R & 31)) : R;
        voffA[i] = (unsigned)(R * K + C) * 2u; voffB[i] = (unsigned)(Rb * K + C) * 2u; }
    const size_t kstep = (size_t)(BK * 2);
    const size_t hstep = (size_t)HALF * K * 2;
    const size_t tstep = 2 * hstep;
    const unsigned ldsw = (unsigned)wid * 1024u;
    const int aoff = lds_byte(wr * 64 + fr, fq * 8), boff = lds_byte(wc * 32 + fr, fq * 8);
#define PG8_SA(b, h) (((b) * 2 + (h)) * HTB)
#define PG8_SB(b, h) ((4 + (b) * 2 + (h)) * HTB)
#define PG8_STAGE(bufoff, gbase, voff) do { _Pragma("unroll") for (int _i = 0; _i < 2; ++_i) \
        __builtin_amdgcn_global_load_lds((const unsigned*)((const char*)(gbase) + (voff)[_i]), (PG8_LAS unsigned*)(lds + (bufoff) + ldsw + _i * 8192), 16, 0, 0); } while (0)
#define PG8_LDA(dst, b, h) do { _Pragma("unroll") for (int m = 0; m < 4; ++m) _Pragma("unroll") for (int k = 0; k < 2; ++k) dst[m][k] = *(const PG8_LAS bf16x8*)(lds + PG8_SA(b, h) + aoff + m * 2048 + k * 1024); } while (0)
#define PG8_LDB(dst, b, h) do { _Pragma("unroll") for (int n = 0; n < 2; ++n) _Pragma("unroll") for (int k = 0; k < 2; ++k) dst[n][k] = *(const PG8_LAS bf16x8*)(lds + PG8_SB(b, h) + boff + n * 2048 + k * 1024); } while (0)
#define PG8_MMA(ai, bj, At, Bt) do { __builtin_amdgcn_s_setprio(1); _Pragma("unroll") for (int m = 0; m < 4; ++m) _Pragma("unroll") for (int n = 0; n < 2; ++n) _Pragma("unroll") for (int k = 0; k < 2; ++k) \
        acc[ai][bj][m][n] = __builtin_amdgcn_mfma_f32_16x16x32_bf16(Bt[n][k], At[m][k], acc[ai][bj][m][n], 0, 0, 0); __builtin_amdgcn_s_setprio(0); } while (0)
#define PG8_WAIT_V(n) asm volatile("s_waitcnt vmcnt(" #n ")" ::: "memory")
#define PG8_WAIT_L(n) asm volatile("s_waitcnt lgkmcnt(" #n ")" ::: "memory")
#define PG8_BAR __builtin_amdgcn_s_barrier()
#define PG8_SCHED __builtin_amdgcn_sched_barrier(0)
    Unit cur, nxt; int ui = 0;
    if (!S.next(0, cur)) return;
    f32x4 acc[2][2][4][2];
#pragma unroll
    for (int a = 0; a < 2; ++a)
#pragma unroll
        for (int b = 0; b < 2; ++b)
#pragma unroll
            for (int m = 0; m < 4; ++m)
#pragma unroll
                for (int n = 0; n < 2; ++n) acc[a][b][m][n] = (f32x4){0.f, 0.f, 0.f, 0.f};
    bf16x8 At[4][2], B0[2][2], B1[2][2];
    const char* cA = (const char*)g.A + (size_t)cur.pm * tstep; const char* cB = (const char*)g.Bt + (size_t)cur.pn * tstep;
    S.a_ready(cur);
    if constexpr (SP2) {
        PG8_STAGE(PG8_SB(0, 0), cB, voffB); PG8_STAGE(PG8_SB(0, 1), cB + hstep, voffB); PG8_STAGE(PG8_SA(0, 0), cA, voffA); PG8_STAGE(PG8_SA(0, 1), cA + hstep, voffA);
        if (wr == 1) PG8_BAR;
        PG8_WAIT_V(2); PG8_BAR;
        PG8_STAGE(PG8_SB(1, 0), cB + kstep, voffB); PG8_STAGE(PG8_SA(1, 0), cA + kstep, voffA); PG8_STAGE(PG8_SB(1, 1), cB + hstep + kstep, voffB);
        PG8_WAIT_V(6); PG8_BAR;
    } else {
        PG8_STAGE(PG8_SB(0, 0), cB, voffB); PG8_STAGE(PG8_SA(0, 0), cA, voffA); PG8_STAGE(PG8_SB(0, 1), cB + hstep, voffB); PG8_STAGE(PG8_SA(0, 1), cA + hstep, voffA);
        if (wr == 1) PG8_BAR;
        PG8_WAIT_V(4); PG8_BAR;
        PG8_STAGE(PG8_SB(1, 0), cB + kstep, voffB); PG8_STAGE(PG8_SA(1, 0), cA + kstep, voffA); PG8_STAGE(PG8_SB(1, 1), cB + hstep + kstep, voffB);
        PG8_WAIT_V(6); PG8_BAR;
    }
    for (;;) {
        const bool has_next = S.next(ui + 1, nxt);
        const char* nA = has_next ? (const char*)g.A + (size_t)nxt.pm * tstep : cA; const char* nB = has_next ? (const char*)g.Bt + (size_t)nxt.pn * tstep : cB;
        constexpr int NSEG = Epi::MID ? 2 : 1; const int seglen = nt / NSEG;
        for (int seg = 0; seg < NSEG; ++seg) {
        if constexpr (Epi::MID) { if (seg == 1) E.mid(acc, cur, wr, wc, fr, fq); }
        for (int t = seg * seglen; t < (seg + 1) * seglen; t += 2) {
            const bool last = (t == nt - 2);
            const char* a1 = cA + (size_t)(t + 1) * kstep;
            const char* a2 = last ? nA : cA + (size_t)(t + 2) * kstep; const char* b2 = last ? nB : cB + (size_t)(t + 2) * kstep;
            const char* a3 = a2 + kstep; const char* b3 = b2 + kstep;
            if (last && has_next) S.a_ready(nxt);
            if constexpr (SP2) {
            PG8_LDB(B0, 0, 0); PG8_LDB(B1, 0, 1); PG8_SCHED; PG8_LDA(At, 0, 0); PG8_STAGE(PG8_SA(1, 1), a1 + hstep, voffA);
            PG8_WAIT_V(8); PG8_WAIT_L(0); PG8_BAR; PG8_MMA(0, 0, At, B0); PG8_MMA(0, 1, At, B1); PG8_BAR; PG8_SCHED;
            PG8_LDA(At, 0, 1); PG8_STAGE(PG8_SB(0, 0), b2, voffB); PG8_STAGE(PG8_SB(0, 1), b2 + hstep, voffB); PG8_STAGE(PG8_SA(0, 0), a2, voffA);
            PG8_WAIT_V(8); PG8_WAIT_L(0); PG8_BAR; PG8_MMA(1, 0, At, B0); PG8_MMA(1, 1, At, B1); PG8_BAR; PG8_SCHED;
            PG8_LDB(B0, 1, 0); PG8_LDB(B1, 1, 1); PG8_SCHED; PG8_LDA(At, 1, 0); PG8_STAGE(PG8_SA(0, 1), a2 + hstep, voffA);
            PG8_WAIT_V(8); PG8_WAIT_L(0); PG8_BAR; PG8_MMA(0, 0, At, B0); PG8_MMA(0, 1, At, B1); PG8_BAR; PG8_SCHED;
            PG8_LDA(At, 1, 1); PG8_STAGE(PG8_SB(1, 0), b3, voffB); PG8_STAGE(PG8_SB(1, 1), b3 + hstep, voffB); PG8_STAGE(PG8_SA(1, 0), a3, voffA);
            PG8_WAIT_V(8); PG8_WAIT_L(0); PG8_BAR; PG8_MMA(1, 0, At, B0); PG8_MMA(1, 1, At, B1); PG8_BAR; PG8_SCHED;
            } else {
            PG8_LDB(B0, 0, 0); PG8_SCHED; PG8_LDA(At, 0, 0); PG8_STAGE(PG8_SA(1, 1), a1 + hstep, voffA);
            PG8_WAIT_L(8); PG8_BAR; PG8_WAIT_L(0); PG8_MMA(0, 0, At, B0); PG8_BAR; PG8_SCHED;
            PG8_LDB(B1, 0, 1); PG8_STAGE(PG8_SB(0, 0), b2, voffB);
            PG8_BAR; PG8_WAIT_L(0); PG8_MMA(0, 1, At, B1); PG8_BAR;
            PG8_LDA(At, 0, 1); PG8_STAGE(PG8_SA(0, 0), a2, voffA);
            PG8_BAR; PG8_WAIT_L(0); PG8_MMA(1, 0, At, B0); PG8_BAR; PG8_SCHED;
            PG8_STAGE(PG8_SB(0, 1), b2 + hstep, voffB);
            PG8_WAIT_V(6); PG8_BAR; PG8_MMA(1, 1, At, B1); PG8_BAR;
            PG8_LDB(B0, 1, 0); PG8_SCHED; PG8_LDA(At, 1, 0); PG8_STAGE(PG8_SA(0, 1), a2 + hstep, voffA);
            PG8_WAIT_L(8); PG8_BAR; PG8_WAIT_L(0); PG8_MMA(0, 0, At, B0); PG8_BAR; PG8_SCHED;
            PG8_LDB(B1, 1, 1); PG8_STAGE(PG8_SB(1, 0), b3, voffB);
            PG8_BAR; PG8_WAIT_L(0); PG8_MMA(0, 1, At, B1); PG8_BAR;
            PG8_LDA(At, 1, 1); PG8_STAGE(PG8_SA(1, 0), a3, voffA);
            PG8_BAR; PG8_WAIT_L(0); PG8_MMA(1, 0, At, B0); PG8_BAR; PG8_SCHED;
            PG8_STAGE(PG8_SB(1, 1), b3 + hstep, voffB);
            PG8_WAIT_V(6); PG8_BAR; PG8_MMA(1, 1, At, B1); PG8_BAR;
            }
        }
        }
        if constexpr (ALIGN_EPI) { if (wr == 0) PG8_BAR; }
        if constexpr (!Epi::AFTER_DRAIN) { E(acc, cur, wr, wc, fr, fq); S.done(cur); }
        if (!has_next) break;
#pragma unroll
        for (int a = 0; a < 2; ++a)
#pragma unroll
            for (int b = 0; b < 2; ++b)
#pragma unroll
                for (int m = 0; m < 4; ++m)
#pragma unroll
                    for (int n = 0; n < 2; ++n) acc[a][b][m][n] = (f32x4){0.f, 0.f, 0.f, 0.f};
        cur = nxt; cA = nA; cB = nB; ++ui;
        if constexpr (ALIGN_EPI) { if (wr == 1) PG8_BAR; }
    }
    PG8_WAIT_V(0);
    if constexpr (!ALIGN_EPI) { if (wr == 0) PG8_BAR; }
    PG8_BAR;
    if constexpr (Epi::AFTER_DRAIN) { E.fused(acc, cur, wr, wc, fr, fq, lds, wid, lane); S.done(cur); }
#undef PG8_SA
#undef PG8_SB
#undef PG8_STAGE
#undef PG8_LDA
#undef PG8_LDB
#undef PG8_MMA
#undef PG8_WAIT_V
#undef PG8_WAIT_L
#undef PG8_BAR
#undef PG8_SCHED
}
}
#ifndef MK_N_LAUNCHES
#define MK_N_LAUNCHES 1
#endif
constexpr int NWAVES = 8;
constexpr int M_ROWS = 40960, NP_ROWS = 32768, D = 2048, FF = 8192, INW = 8704, QKVW = 4608, GW_ = 4096, HD = 128;
constexpr float EPS = 1e-6f;
constexpr size_t MiB = 1u << 20;
constexpr size_t WS_TAB = 0;
constexpr size_t WS_RSTD2 = 1 * MiB;
constexpr size_t WS_SS2 = 2 * MiB;
constexpr size_t WS_SS = 8 * MiB;
constexpr size_t WS_WIN = 32 * MiB;
constexpr size_t WS_WBR = 66 * MiB;
constexpr size_t WS_WOUT = 74 * MiB;
constexpr size_t WS_WUP = 82 * MiB;
constexpr size_t WS_WDN = 114 * MiB;
constexpr size_t WS_BUFA = 146 * MiB;
constexpr size_t WS_QKV = 306 * MiB;
constexpr size_t WS_GATES = 666 * MiB;
constexpr size_t WS_END = 986 * MiB;
constexpr int LDS_BYTES = 147456;

#define LAS __attribute__((address_space(3)))
typedef unsigned short bf16;
typedef unsigned v4u __attribute__((ext_vector_type(4)));
typedef float f32x4 __attribute__((ext_vector_type(4)));
#define LDS_WAIT() asm volatile("s_waitcnt lgkmcnt(0)" ::: "memory")
__device__ __forceinline__ unsigned f2bf(float f) { unsigned u = __builtin_bit_cast(unsigned, f); return (u + 0x7fffu + ((u >> 16) & 1u)) >> 16; }
__device__ __forceinline__ unsigned pk2(float lo, float hi) { return f2bf(lo) | (f2bf(hi) << 16); }
__device__ __forceinline__ float bflo(unsigned w) { return __uint_as_float(w << 16); }
__device__ __forceinline__ float bfhi(unsigned w) { return __uint_as_float(w & 0xffff0000u); }
__device__ __forceinline__ float wave_sum(float v) {
#pragma unroll
    for (int o = 1; o < 64; o <<= 1) v += __shfl_xor(v, o);
    return v;
}
__device__ __forceinline__ float wave_max(float v) {
#pragma unroll
    for (int o = 1; o < 64; o <<= 1) v = fmaxf(v, __shfl_xor(v, o));
    return v;
}
__device__ __forceinline__ void wave_sync() { __builtin_amdgcn_fence(__ATOMIC_RELEASE, "wavefront"); __builtin_amdgcn_wave_barrier(); __builtin_amdgcn_fence(__ATOMIC_ACQUIRE, "wavefront"); }

__device__ __forceinline__ int t5_bucket_dev(int rel) {
    const int n = rel < 0 ? -rel : rel;
    const int b = n < 8 ? n : 8 + (n >= 12) + (n >= 16) + (n >= 23) + (n >= 32) + (n >= 46) + (n >= 64) + (n >= 91);
    return b + (rel > 0 ? 16 : 0);
}

struct Frame {
    unsigned char* lds; int tid, lane, wave, G, bid;
    const float *xp, *xs, *g1, *w_in, *gqa, *gka, *t5, *sink, *gqb, *gkb, *rpb, *wbra, *wbrb, *wout, *g2, *wup, *wdn;
    float* out; unsigned char* ws;
};
__device__ __forceinline__ const float* xrow_ptr(const Frame& F, int m) { return m < NP_ROWS ? F.xp + (size_t)m * D : F.xs + (size_t)(m - NP_ROWS) * D; }

__device__ __forceinline__ void p0_transpose_item(const float* W, int K, int N, bf16* WT, int ldk, int koff, const float* kscale, float* scr, int item, int lane) {
    const int nblk = N / 32, kb = item / nblk, nb = item % nblk, k0 = 64 * kb, n0 = 32 * nb;
#pragma unroll 8
    for (int i = 0; i < 32; ++i) { const int kk = 2 * i + (lane >> 5); float w = W[(size_t)(k0 + kk) * N + n0 + (lane & 31)]; if (kscale) w *= kscale[k0 + kk]; scr[kk * 33 + (lane & 31)] = w; }
    wave_sync();
    const int c = lane & 7;
#pragma unroll
    for (int j = 0; j < 4; ++j) { const int n = (lane >> 3) + 8 * j; const float* s = scr + (8 * c) * 33 + n;
        v4u o; o.x = pk2(s[0 * 33], s[1 * 33]); o.y = pk2(s[2 * 33], s[3 * 33]); o.z = pk2(s[4 * 33], s[5 * 33]); o.w = pk2(s[6 * 33], s[7 * 33]);
        *(v4u*)(WT + (size_t)(n0 + n) * ldk + koff + k0 + 8 * c) = o; }
    wave_sync();
}
__device__ __forceinline__ void p0_prologue(Frame& F) {
    float* scr = (float*)(F.lds + F.wave * 16384);
    const int gw = F.bid * NWAVES + F.wave, NGW = F.G * NWAVES;
    constexpr int I_IN = (D / 64) * (INW / 32), I_BR = (1024 / 64) * (D / 32), I_OUT = (D / 64) * (D / 32), I_UP = (D / 64) * (FF / 32), I_DN = (FF / 64) * (D / 32);
    constexpr int NITEMS = I_IN + 2 * I_BR + I_OUT + I_UP + I_DN;
    for (int it = gw; it < NITEMS; it += NGW) {
        int r = it;
        if (r < I_IN) { p0_transpose_item(F.w_in, D, INW, (bf16*)(F.ws + WS_WIN), D, 0, nullptr, scr, r, F.lane); continue; } r -= I_IN;
        if (r < I_BR) { p0_transpose_item(F.wbra, 1024, D, (bf16*)(F.ws + WS_WBR), D, 0, nullptr, scr, r, F.lane); continue; } r -= I_BR;
        if (r < I_BR) { p0_transpose_item(F.wbrb, 1024, D, (bf16*)(F.ws + WS_WBR), D, 1024, nullptr, scr, r, F.lane); continue; } r -= I_BR;
        if (r < I_OUT) { p0_transpose_item(F.wout, D, D, (bf16*)(F.ws + WS_WOUT), D, 0, nullptr, scr, r, F.lane); continue; } r -= I_OUT;
        if (r < I_UP) { p0_transpose_item(F.wup, D, FF, (bf16*)(F.ws + WS_WUP), D, 0, F.g2, scr, r, F.lane); continue; } r -= I_UP;
        p0_transpose_item(F.wdn, FF, D, (bf16*)(F.ws + WS_WDN), FF, 0, nullptr, scr, r, F.lane);
    }
    bf16* H = (bf16*)(F.ws + WS_BUFA);
    for (int m = gw; m < M_ROWS; m += NGW) {
        const f32x4* xr = (const f32x4*)xrow_ptr(F, m) + F.lane; f32x4 v[8]; float s = 0.f;
#pragma unroll
        for (int j = 0; j < 8; ++j) { v[j] = xr[64 * j]; s += (v[j].x * v[j].x + v[j].y * v[j].y) + (v[j].z * v[j].z + v[j].w * v[j].w); }
        const float rstd = 1.0f / sqrtf(wave_sum(s) * (1.f / D) + EPS);
        unsigned long long* o8 = (unsigned long long*)(H + (size_t)m * D) + F.lane; const f32x4* gp = (const f32x4*)F.g1 + F.lane;
#pragma unroll
        for (int j = 0; j < 8; ++j) { const f32x4 g = gp[64 * j]; o8[64 * j] = (unsigned long long)pk2(v[j].x * rstd * g.x, v[j].y * rstd * g.y) | ((unsigned long long)pk2(v[j].z * rstd * g.z, v[j].w * rstd * g.w) << 32); }
    }
    float* BA = (float*)(F.ws + WS_TAB);
    for (int i = F.bid * 512 + F.tid; i < 8 * 257; i += F.G * 512) { const int h = i / 257, rel = i % 257 - 128; BA[i] = F.t5[t5_bucket_dev(rel) * 8 + h]; }
}

struct SeqPos { int base, t, L; };
__device__ __forceinline__ SeqPos seq_of_row(int row) { SeqPos p; if (row < NP_ROWS) { p.base = row & ~4095; p.t = row & 4095; p.L = 4096; } else { const int r2 = row - NP_ROWS; p.base = NP_ROWS + (r2 & ~2047); p.t = r2 & 2047; p.L = 2048; } return p; }
__device__ __forceinline__ float rstd_ss(const float* SS, int row, int hs) { const f32x4 p = *(const f32x4*)(SS + ((size_t)row * 36 + hs) * 4); return 1.0f / sqrtf(((p.x + p.y) + (p.z + p.w)) * (1.f / HD) + EPS); }
__device__ __forceinline__ void naive_core(const Frame& F, float* qs, float* sc, int* kr, int nk, int row, int qoff, int koff, int voff, int hsq, int hsk, const float* gq, const float* gk, bool has_sink, float sinkv, int outcol) {
    const bf16* QKV = (const bf16*)(F.ws + WS_QKV); const float* SS = (const float*)(F.ws + WS_SS); bf16* ATT = (bf16*)(F.ws + WS_BUFA);
    const int lane = F.lane;
    { const unsigned w = *(const unsigned*)(QKV + (size_t)row * QKVW + qoff + 2 * lane); const float sc0 = 0.08838834764831845f;
      qs[2 * lane] = bflo(w) * gq[2 * lane] * gk[2 * lane] * sc0; qs[2 * lane + 1] = bfhi(w) * gq[2 * lane + 1] * gk[2 * lane + 1] * sc0; }
    const float rq = rstd_ss(SS, row, hsq);
    wave_sync();
    float sv[5]; float mx = -1e30f;
#pragma unroll
    for (int i = 0; i < 5; ++i) { const int j = lane + 64 * i; float s = -1e30f;
        if (j < nk && kr[j] >= 0) { const int k = kr[j]; const float rk = rstd_ss(SS, k, hsk); const v4u* kp = (const v4u*)(QKV + (size_t)k * QKVW + koff); float dot = 0.f;
            for (int c = 0; c < 16; ++c) { const v4u w = kp[c]; const float* q = qs + 8 * c;
                dot += q[0] * bflo(w.x) + q[1] * bfhi(w.x) + q[2] * bflo(w.y) + q[3] * bfhi(w.y) + q[4] * bflo(w.z) + q[5] * bfhi(w.z) + q[6] * bflo(w.w) + q[7] * bfhi(w.w); }
            s = dot * rq * rk + sc[j]; }
        sv[i] = s; mx = fmaxf(mx, s); }
    mx = wave_max(mx); if (has_sink) mx = fmaxf(mx, sinkv);
    float sum = 0.f;
#pragma unroll
    for (int i = 0; i < 5; ++i) { sv[i] = __expf(sv[i] - mx); sum += sv[i]; }
    sum = wave_sum(sum); if (has_sink) sum += __expf(sinkv - mx);
    const float inv = 1.0f / sum;
    wave_sync();
#pragma unroll
    for (int i = 0; i < 5; ++i) sc[lane + 64 * i] = sv[i] * inv;
    wave_sync();
    float a0 = 0.f, a1 = 0.f;
    for (int j = 0; j < nk; ++j) { const int k = kr[j]; if (k >= 0) { const float p = sc[j]; const unsigned w = *(const unsigned*)(QKV + (size_t)k * QKVW + voff + 2 * lane); a0 += p * bflo(w); a1 += p * bfhi(w); } }
    *(unsigned*)(ATT + (size_t)row * D + outcol + 2 * lane) = pk2(a0, a1);
    wave_sync();
}
__device__ __forceinline__ void naive_attention(Frame& F) {
    float* qs = (float*)(F.lds + F.wave * 4096); float* sc = qs + 128; int* kr = (int*)(sc + 320);
    const float* BA = (const float*)(F.ws + WS_TAB);
    const int gw = F.bid * NWAVES + F.wave, NGW = F.G * NWAVES, lane = F.lane;
    for (int it = gw; it < M_ROWS * 16; it += NGW) {
        const int row = it >> 4, hh = it & 15; const SeqPos sp = seq_of_row(row);
#ifdef PROBE_ZERO
        if ((PROBE_ZERO == 3) || (PROBE_ZERO == 1 && hh < 8) || (PROBE_ZERO == 2 && hh >= 8)) { *(unsigned*)((bf16*)(F.ws + WS_BUFA) + (size_t)row * D + hh * 128 + 2 * lane) = 0u; continue; }
#endif
        if (hh < 8) {
            const int h = hh, hk = h >> 2;
#pragma unroll
            for (int i = 0; i < 5; ++i) { const int j = lane + 64 * i; const int kt = sp.t - 128 + j; const bool ok = (j < 257) && kt >= 0 && kt < sp.L; kr[j] = ok ? sp.base + kt : -1; sc[j] = ok ? F.t5[t5_bucket_dev(j - 128) * 8 + h] : 0.f; }
            wave_sync();
            naive_core(F, qs, sc, kr, 257, row, h * 128, 1024 + hk * 128, 1280 + hk * 128, h, 8 + hk, F.gqa, F.gka, true, F.sink[h], h * 128);
        } else {
            const int h = hh - 8, rows = sp.L >> 6, r = sp.t >> 6, c = sp.t & 63;
            int rs = r - 4; rs = rs < 0 ? 0 : (rs > rows - 8 ? rows - 8 : rs);
            int cs = c - 8; cs = cs < 0 ? 0 : (cs > 48 ? 48 : cs);
#pragma unroll
            for (int i = 0; i < 5; ++i) { const int j = lane + 64 * i; const int kr_ = rs + (j >> 4), kc = cs + (j & 15); const bool ok = j < 128;
                int dcc = kc - c; dcc = (dcc < -15 ? -15 : (dcc > 15 ? 15 : dcc)) + 15; const int dr = kr_ - r + 7;
                kr[j] = ok ? sp.base + kr_ * 64 + kc : -1; sc[j] = ok ? F.rpb[(h * 15 + dr) * 31 + dcc] : 0.f; }
            wave_sync();
            naive_core(F, qs, sc, kr, 128, row, 1536 + h * 128, 2560 + h * 128, 3584 + h * 128, 12 + h, 20 + h, F.gqb, F.gkb, false, 0.f, 1024 + h * 128);
        }
    }
}


namespace att {
#define ALAS __attribute__((address_space(3)))
typedef short bf16x8 __attribute__((ext_vector_type(8)));
typedef short v4i16_t __attribute__((ext_vector_type(4)));
constexpr int TAB_OFF = 131072;
constexpr float LOG2E = 1.4426950408889634f;
__device__ __forceinline__ unsigned img_off(int row, int chunk) { return (unsigned)(row * 256 + (((chunk ^ row) & 15) << 4)); }
__device__ __forceinline__ v4i16_t vtr(const ALAS unsigned char* p) { return __builtin_amdgcn_ds_read_tr16_b64_v4i16((ALAS v4i16_t*)p); }
__device__ __forceinline__ unsigned tr_off(int row, int dt, int i16) { const int ch = 2 * dt + ((i16 & 3) >> 1); return (unsigned)(row * 256 + (((ch ^ row) & 15) << 4) + (i16 & 1) * 8); }
__device__ __forceinline__ void load_q(bf16x8 (&qf)[4], const bf16* QKV, int qrow, int qoff, const float* gq, const float* gk, int g) {
#pragma unroll
    for (int ks = 0; ks < 4; ++ks) { const int d0 = 32 * ks + 8 * g; const v4u w = *(const v4u*)(QKV + (size_t)qrow * QKVW + qoff + d0);
        const f32x4 a0 = *(const f32x4*)(gq + d0), a1 = *(const f32x4*)(gq + d0 + 4), b0 = *(const f32x4*)(gk + d0), b1 = *(const f32x4*)(gk + d0 + 4); const float c = 0.08838834764831845f;
        v4u o; o.x = pk2(bflo(w.x) * a0.x * b0.x * c, bfhi(w.x) * a0.y * b0.y * c); o.y = pk2(bflo(w.y) * a0.z * b0.z * c, bfhi(w.y) * a0.w * b0.w * c);
        o.z = pk2(bflo(w.z) * a1.x * b1.x * c, bfhi(w.z) * a1.y * b1.y * c); o.w = pk2(bflo(w.w) * a1.z * b1.z * c, bfhi(w.w) * a1.w * b1.w * c);
        qf[ks] = __builtin_bit_cast(bf16x8, o); }
}
__device__ __forceinline__ bf16x8 pack_p(const f32x4 a, const f32x4 b) { v4u o; o.x = pk2(a[0], a[1]); o.y = pk2(a[2], a[3]); o.z = pk2(b[0], b[1]); o.w = pk2(b[2], b[3]); return __builtin_bit_cast(bf16x8, o); }

__device__ __forceinline__ void attn_a(const Frame& F, ALAS unsigned char* L) {
    ALAS float* rkT = (ALAS float*)(L + TAB_OFF); ALAS float* baT = (ALAS float*)(L + TAB_OFF + 2048);
    const bf16* QKV = (const bf16*)(F.ws + WS_QKV); const float* SS = (const float*)(F.ws + WS_SS); bf16* ATT = (bf16*)(F.ws + WS_BUFA);
    const int tid = F.tid, lane = F.lane, w = F.wave, g = lane >> 4, i16 = lane & 15;
    for (int u = F.bid; u < 2560; u += F.G) {
        const int h = u & 7, blk = u >> 3; int base, n, Ls;
        if (blk < 256) { base = (blk >> 5) * 4096; n = blk & 31; Ls = 4096; } else { const int b2 = blk - 256; base = NP_ROWS + (b2 >> 4) * 2048; n = b2 & 15; Ls = 2048; }
        const int hk = h >> 2, koff = 1024 + hk * 128, voff = 1280 + hk * 128, qoff = h * 128, kpos0 = n * 128 - 128;
        __syncthreads();
        { v4u kv[12];
#pragma unroll
          for (int j = 0; j < 12; ++j) { const int idx = tid + 512 * j, row = idx >> 4, ch = idx & 15, kp = kpos0 + row; const bool ok = kp >= 0 && kp < Ls;
              kv[j] = ok ? *(const v4u*)(QKV + (size_t)(base + kp) * QKVW + koff + ch * 8) : (v4u){0u, 0u, 0u, 0u}; }
#pragma unroll
          for (int j = 0; j < 12; ++j) { const int idx = tid + 512 * j, row = idx >> 4, ch = idx & 15; *(ALAS v4u*)(L + img_off(row, ch)) = kv[j]; } }
        if (tid < 384) { const int kp = kpos0 + tid; rkT[tid] = (kp >= 0 && kp < Ls) ? rstd_ss(SS, base + kp, 8 + hk) : 0.f; }
        if (tid < 257) baT[tid] = F.t5[t5_bucket_dev(tid - 128) * 8 + h] * LOG2E;
        const int qrow = base + n * 128 + 16 * w + i16; const float rq = rstd_ss(SS, qrow, h) * LOG2E;
        bf16x8 qf[4]; load_q(qf, QKV, qrow, qoff, F.gqa, F.gka, g);
        __syncthreads();
        f32x4 s[17];
        unsigned kb[4];
#pragma unroll
        for (int ks = 0; ks < 4; ++ks) kb[ks] = img_off(16 * w + i16, 4 * ks + g);
#pragma unroll
        for (int t = 0; t < 17; ++t) { f32x4 acc = {0.f, 0.f, 0.f, 0.f};
#pragma unroll
            for (int ks = 0; ks < 4; ++ks) { const bf16x8 kf = *(const ALAS bf16x8*)(L + kb[ks] + t * 4096); acc = __builtin_amdgcn_mfma_f32_16x16x32_bf16(kf, qf[ks], acc, 0, 0, 0); }
            s[t] = acc; }
        const int bb = 4 * g - i16; float m = -1e30f;
#pragma unroll
        for (int t = 0; t < 17; ++t) { const int bi0 = 16 * (w + t) + 4 * g; const f32x4 rk4 = *(const ALAS f32x4*)(rkT + bi0);
#pragma unroll
            for (int r = 0; r < 4; ++r) { const int idx = 16 * t + r + bb, kp = kpos0 + bi0 + r; const bool valid = (unsigned)idx <= 256u && kp >= 0 && kp < Ls;
                const int idc = idx < 0 ? 0 : (idx > 256 ? 256 : idx);
                const float v = valid ? s[t][r] * rq * rk4[r] + baT[idc] : -1e30f; s[t][r] = v; m = fmaxf(m, v); } }
        m = fmaxf(m, __shfl_xor(m, 16)); m = fmaxf(m, __shfl_xor(m, 32));
        const float sk2 = F.sink[h] * LOG2E; m = fmaxf(m, sk2);
        float l = 0.f;
#pragma unroll
        for (int t = 0; t < 17; ++t)
#pragma unroll
            for (int r = 0; r < 4; ++r) { const float p = __builtin_amdgcn_exp2f(s[t][r] - m); s[t][r] = p; l += p; }
        l += __shfl_xor(l, 16); l += __shfl_xor(l, 32); l += __builtin_amdgcn_exp2f(sk2 - m);
        bf16x8 pk[9];
#pragma unroll
        for (int kk = 0; kk < 8; ++kk) pk[kk] = pack_p(s[2 * kk], s[2 * kk + 1]);
        pk[8] = pack_p(s[16], (f32x4){0.f, 0.f, 0.f, 0.f});
        __syncthreads();
        { v4u kv[12];
#pragma unroll
          for (int j = 0; j < 12; ++j) { const int idx = tid + 512 * j, row = idx >> 4, ch = idx & 15, kp = kpos0 + row; const bool ok = kp >= 0 && kp < Ls;
              kv[j] = ok ? *(const v4u*)(QKV + (size_t)(base + kp) * QKVW + voff + ch * 8) : (v4u){0u, 0u, 0u, 0u}; }
#pragma unroll
          for (int j = 0; j < 12; ++j) { const int idx = tid + 512 * j, row = idx >> 4, ch = idx & 15; *(ALAS v4u*)(L + img_off(row, ch)) = kv[j]; } }
        __syncthreads();
        f32x4 o[8];
#pragma unroll
        for (int dt = 0; dt < 8; ++dt) o[dt] = (f32x4){0.f, 0.f, 0.f, 0.f};
        unsigned tb[8];
#pragma unroll
        for (int dt = 0; dt < 8; ++dt) tb[dt] = tr_off(16 * w + 4 * g + (i16 >> 2), dt, i16);
        const unsigned t17off = (unsigned)((w == 7 ? 16 : 17) * 4096);
#pragma unroll
        for (int kk = 0; kk < 9; ++kk) { const unsigned offb = kk < 8 ? (unsigned)((2 * kk + 1) * 4096) : t17off;
#pragma unroll
            for (int dt = 0; dt < 8; ++dt) { const v4i16_t lo = vtr(L + tb[dt] + 2 * kk * 4096), hi = vtr(L + tb[dt] + offb);
                const bf16x8 vf = {lo[0], lo[1], lo[2], lo[3], hi[0], hi[1], hi[2], hi[3]};
                o[dt] = __builtin_amdgcn_mfma_f32_16x16x32_bf16(vf, pk[kk], o[dt], 0, 0, 0); } }
        const float inv = 1.0f / l; bf16* op = ATT + (size_t)qrow * D + h * 128 + 4 * g;
#pragma unroll
        for (int dt = 0; dt < 8; ++dt) { const unsigned long long v = (unsigned long long)pk2(o[dt][0] * inv, o[dt][1] * inv) | ((unsigned long long)pk2(o[dt][2] * inv, o[dt][3] * inv) << 32); *(unsigned long long*)(op + 16 * dt) = v; }
    }
}

__device__ __forceinline__ void attn_b(const Frame& F, ALAS unsigned char* L) {
    ALAS float* rkT = (ALAS float*)(L + TAB_OFF); ALAS float* bT = (ALAS float*)(L + TAB_OFF + 2048);
    const bf16* QKV = (const bf16*)(F.ws + WS_QKV); const float* SS = (const float*)(F.ws + WS_SS); bf16* ATT = (bf16*)(F.ws + WS_BUFA);
    const int tid = F.tid, lane = F.lane, w = F.wave, g = lane >> 4, i16 = lane & 15, cb = w & 3, dh = w >> 2;
    for (int u = F.bid; u < 5120; u += F.G) {
        const int h = u & 7, rowid = u >> 3; int base, r, rows;
        if (rowid < 512) { base = (rowid >> 6) * 4096; r = rowid & 63; rows = 64; } else { const int r2 = rowid - 512; base = NP_ROWS + (r2 >> 5) * 2048; r = r2 & 31; rows = 32; }
        int rs = r - 4; rs = rs < 0 ? 0 : (rs > rows - 8 ? rows - 8 : rs);
        const int krow0 = base + rs * 64, qoff = 1536 + h * 128, koff = 2560 + h * 128, voff = 3584 + h * 128;
        const int c = 16 * cb + i16; int reg = 16 * cb - 8; reg = reg < 0 ? 0 : (reg > 32 ? 32 : reg); int cs = c - 8; cs = cs < 0 ? 0 : (cs > 48 ? 48 : cs);
        __syncthreads();
        { v4u kv[16];
#pragma unroll
          for (int j = 0; j < 16; ++j) { const int idx = tid + 512 * j, row = idx >> 4, ch = idx & 15; kv[j] = *(const v4u*)(QKV + (size_t)(krow0 + row) * QKVW + koff + ch * 8); }
#pragma unroll
          for (int j = 0; j < 16; ++j) { const int idx = tid + 512 * j, row = idx >> 4, ch = idx & 15; *(ALAS v4u*)(L + img_off(row, ch)) = kv[j]; } }
        rkT[tid] = rstd_ss(SS, krow0 + tid, 20 + h);
        bT[tid] = tid < 465 ? F.rpb[h * 465 + tid] * LOG2E : 0.f;
        const int qrow = base + r * 64 + c; const float rq = rstd_ss(SS, qrow, 12 + h) * LOG2E;
        bf16x8 qf[4]; load_q(qf, QKV, qrow, qoff, F.gqb, F.gkb, g);
        __syncthreads();
        f32x4 s[16];
        unsigned kb[4];
#pragma unroll
        for (int ks = 0; ks < 4; ++ks) kb[ks] = img_off(reg + i16, 4 * ks + g);
#pragma unroll
        for (int t = 0; t < 16; ++t) { f32x4 acc = {0.f, 0.f, 0.f, 0.f};
#pragma unroll
            for (int ks = 0; ks < 4; ++ks) { const bf16x8 kf = *(const ALAS bf16x8*)(L + kb[ks] + (4 * (t >> 1) + (t & 1)) * 4096); acc = __builtin_amdgcn_mfma_f32_16x16x32_bf16(kf, qf[ks], acc, 0, 0, 0); }
            s[t] = acc; }
        float m = -1e30f;
#pragma unroll
        for (int t = 0; t < 16; ++t) { const int i = t >> 1, R0 = i * 64 + reg + 16 * (t & 1) + 4 * g; const f32x4 rk4 = *(const ALAS f32x4*)(rkT + R0); const int kc0 = reg + 16 * (t & 1) + 4 * g, brow = (rs + i - r + 7) * 31 + 15 - c;
#pragma unroll
            for (int rr = 0; rr < 4; ++rr) { const int kc = kc0 + rr; const bool valid = kc >= cs && kc < cs + 16; int bi = brow + kc; bi = bi < 0 ? 0 : (bi > 464 ? 464 : bi);
                const float v = valid ? s[t][rr] * rq * rk4[rr] + bT[bi] : -1e30f; s[t][rr] = v; m = fmaxf(m, v); } }
        m = fmaxf(m, __shfl_xor(m, 16)); m = fmaxf(m, __shfl_xor(m, 32));
        float l = 0.f;
#pragma unroll
        for (int t = 0; t < 16; ++t)
#pragma unroll
            for (int rr = 0; rr < 4; ++rr) { const float p = __builtin_amdgcn_exp2f(s[t][rr] - m); s[t][rr] = p; l += p; }
        l += __shfl_xor(l, 16); l += __shfl_xor(l, 32);
        bf16x8 pk[8];
#pragma unroll
        for (int kk = 0; kk < 8; ++kk) pk[kk] = pack_p(s[2 * kk], s[2 * kk + 1]);
        __syncthreads();
        { v4u kv[16];
#pragma unroll
          for (int j = 0; j < 16; ++j) { const int idx = tid + 512 * j, row = idx >> 4, ch = idx & 15; kv[j] = *(const v4u*)(QKV + (size_t)(krow0 + row) * QKVW + voff + ch * 8); }
#pragma unroll
          for (int j = 0; j < 16; ++j) { const int idx = tid + 512 * j, row = idx >> 4, ch = idx & 15; *(ALAS v4u*)(L + img_off(row, ch)) = kv[j]; } }
        __syncthreads();
        f32x4 o[4];
#pragma unroll
        for (int d = 0; d < 4; ++d) o[d] = (f32x4){0.f, 0.f, 0.f, 0.f};
        unsigned tb[4];
#pragma unroll
        for (int d = 0; d < 4; ++d) tb[d] = tr_off(reg + 4 * g + (i16 >> 2), 4 * dh + d, i16);
#pragma unroll
        for (int kk = 0; kk < 8; ++kk) {
#pragma unroll
            for (int d = 0; d < 4; ++d) { const v4i16_t lo = vtr(L + tb[d] + kk * 16384), hi = vtr(L + tb[d] + kk * 16384 + 4096);
                const bf16x8 vf = {lo[0], lo[1], lo[2], lo[3], hi[0], hi[1], hi[2], hi[3]};
                o[d] = __builtin_amdgcn_mfma_f32_16x16x32_bf16(vf, pk[kk], o[d], 0, 0, 0); } }
        const float inv = 1.0f / l; bf16* op = ATT + (size_t)qrow * D + 1024 + h * 128 + 64 * dh + 4 * g;
#pragma unroll
        for (int d = 0; d < 4; ++d) { const unsigned long long v = (unsigned long long)pk2(o[d][0] * inv, o[d][1] * inv) | ((unsigned long long)pk2(o[d][2] * inv, o[d][3] * inv) << 32); *(unsigned long long*)(op + 16 * d) = v; }
    }
}
}

struct Args { const float* in[17]; float* out; unsigned char* ws; int ph_lo, ph_hi; };
constexpr int N_PHASES = 8;
__global__ void __launch_bounds__(NWAVES * 64, 2) fwd_megakernel(Args args) {
    extern __shared__ __attribute__((aligned(16))) unsigned char lds[];
    cg::grid_group grid = cg::this_grid();
    Frame F;
    F.lds = lds; F.tid = threadIdx.x; F.lane = F.tid & 63; F.wave = __builtin_amdgcn_readfirstlane(F.tid >> 6); F.G = gridDim.x; F.bid = blockIdx.x;
    F.xp = args.in[0]; F.xs = args.in[1]; F.g1 = args.in[2]; F.w_in = args.in[3]; F.gqa = args.in[4]; F.gka = args.in[5]; F.t5 = args.in[6]; F.sink = args.in[7];
    F.gqb = args.in[8]; F.gkb = args.in[9]; F.rpb = args.in[10]; F.wbra = args.in[11]; F.wbrb = args.in[12]; F.wout = args.in[13]; F.g2 = args.in[14]; F.wup = args.in[15]; F.wdn = args.in[16];
    F.out = args.out; F.ws = args.ws;
    unsigned char* ws = args.ws;
    PG8_LAS unsigned char* ldsl = (PG8_LAS unsigned char*)lds;
    const int lo = args.ph_lo, hi = args.ph_hi;
#ifndef PHASE_MASK
#define PHASE_MASK 0xff
#endif
#define IN(k) (((PHASE_MASK >> (k)) & 1) && lo <= (k) && (k) < hi)
#define SEAM(k) do { if (IN(k) && IN((k) + 1)) grid.sync(); } while (0)
    bf16* BUFA = (bf16*)(ws + WS_BUFA); bf16* QKV = (bf16*)(ws + WS_QKV); bf16* GATES = (bf16*)(ws + WS_GATES);
    float* SS = (float*)(ws + WS_SS); float* SS2 = (float*)(ws + WS_SS2); float* RSTD2 = (float*)(ws + WS_RSTD2);

    if (IN(0)) { p0_prologue(F); __syncthreads(); }
    SEAM(0);
    if (IN(1)) {
        pg8::Gemm g{BUFA, (const bf16*)(ws + WS_WIN), M_ROWS, INW, D}; pg8::StaticOrder S; S.init(M_ROWS, INW, F.G, F.bid);
        pg8::EpiProj E{QKV, GATES, SS};
        pg8::gemm_phase<pg8::EpiProj, pg8::StaticOrder, true, true>(ldsl, g, S, E);
    }
    SEAM(1);
#ifdef NAIVE_ATTN
    if (IN(2)) { naive_attention(F); __syncthreads(); }
#else
    if (IN(2)) { att::attn_a(F, (ALAS unsigned char*)lds); att::attn_b(F, (ALAS unsigned char*)lds); __syncthreads(); }
#endif
    SEAM(2);
    if (IN(3)) {
        pg8::Gemm g{BUFA, (const bf16*)(ws + WS_WBR), M_ROWS, D, D}; pg8::StaticOrder S; S.init(M_ROWS, D, F.G, F.bid);
        pg8::EpiMerge E{GATES, QKV};
        pg8::gemm_phase<pg8::EpiMerge, pg8::StaticOrder, true, true>(ldsl, g, S, E);
    }
    SEAM(3);
    if (IN(4)) {
        pg8::Gemm g{QKV, (const bf16*)(ws + WS_WOUT), M_ROWS, D, D}; pg8::StaticOrder S; S.init(M_ROWS, D, F.G, F.bid);
        pg8::EpiOut1 E{F.xp, F.xs, F.out, BUFA, SS2};
        pg8::gemm_phase<pg8::EpiOut1, pg8::StaticOrder, true, true>(ldsl, g, S, E);
    }
    SEAM(4);
    if (IN(5)) {
        for (int m = F.bid * 512 + F.tid; m < M_ROWS; m += F.G * 512) { const f32x4* p = (const f32x4*)(SS2 + (size_t)m * 32); float s = 0.f;
#pragma unroll
            for (int j = 0; j < 8; ++j) { const f32x4 v = p[j]; s += (v.x + v.y) + (v.z + v.w); }
            RSTD2[m] = 1.0f / sqrtf(s * (1.f / D) + EPS); }
    }
    SEAM(5);
    if (IN(6)) {
        pg8::Gemm g{BUFA, (const bf16*)(ws + WS_WUP), M_ROWS, FF, D}; pg8::StaticOrder S; S.init(M_ROWS, FF, F.G, F.bid);
        pg8::EpiUp E{RSTD2, QKV};
        pg8::gemm_phase<pg8::EpiUp, pg8::StaticOrder, true, true>(ldsl, g, S, E);
    }
    SEAM(6);
    if (IN(7)) {
        pg8::Gemm g{QKV, (const bf16*)(ws + WS_WDN), M_ROWS, D, FF}; pg8::StaticOrder S; S.init(M_ROWS, D, F.G, F.bid);
        pg8::EpiDown E{F.out};
        pg8::gemm_phase<pg8::EpiDown, pg8::StaticOrder, true, true>(ldsl, g, S, E);
    }
#undef IN
#undef SEAM
}


#ifdef SELFCHECK
__device__ __forceinline__ float bf1(const bf16* p) { return __uint_as_float(((unsigned)*p) << 16); }
__device__ __forceinline__ float rbf(float f) { return __uint_as_float(f2bf(f) << 16); }
__global__ void chk_kernel(Args a, int which) {
    const int lane = threadIdx.x, e = blockIdx.x; unsigned char* ws = a.ws; unsigned* flags = (unsigned*)(ws + WS_TAB + 65536);
    const bf16* BUFA = (const bf16*)(ws + WS_BUFA); const bf16* QKV = (const bf16*)(ws + WS_QKV); const bf16* GATES = (const bf16*)(ws + WS_GATES);
    const float* SS = (const float*)(ws + WS_SS); const float* RSTD2 = (const float*)(ws + WS_RSTD2);
    unsigned h1 = (unsigned)e * 2654435761u + 12345u; h1 ^= h1 >> 15; h1 *= 2246822519u; h1 ^= h1 >> 13; h1 *= 3266489917u; h1 ^= h1 >> 16;
    unsigned h2 = ((unsigned)e + 777u) * 2246822519u; h2 ^= h2 >> 13; h2 *= 2654435761u; h2 ^= h2 >> 16; h2 *= 668265263u; h2 ^= h2 >> 15;
    const int row = (int)(h1 % (unsigned)M_ROWS);
    bool bad = false;
    if (which == 0) { const int col = (int)(h2 % (unsigned)INW); float s = 0.f;
        for (int k = lane; k < D; k += 64) s += bf1(BUFA + (size_t)row * D + k) * rbf(a.in[3][(size_t)k * INW + col]);
        s = wave_sum(s);
        float got, ref; if (col < QKVW) { got = bf1(QKV + (size_t)row * QKVW + col); ref = s; } else { got = bf1(GATES + (size_t)row * GW_ + col - QKVW); ref = 1.f / (1.f + expf(-s)); }
        bad = false; if (fabsf(got - ref) > 0.02f + 0.01f * fabsf(ref) && lane == 0) atomicOr(flags, (col < QKVW ? 1u : 2u) | ((col & 7) < 4 ? 4u : 8u) | ((row & 15) < 8 ? 16u : 32u));
    } else if (which == 1) { const int hs = (int)(h2 % 36u); float s = 0.f;
        for (int c = lane; c < 128; c += 64) { const float v = bf1(QKV + (size_t)row * QKVW + hs * 128 + c); s += v * v; }
        s = wave_sum(s); const float* p = SS + ((size_t)row * 36 + hs) * 4; const float got = p[0] + p[1] + p[2] + p[3];
        bad = fabsf(got - s) > 0.02f * s + 1e-3f;
    } else if (which == 2) { const int col = (int)(h2 % (unsigned)D); float ya = 0.f, yb = 0.f;
        for (int k = lane; k < 1024; k += 64) { ya += bf1(BUFA + (size_t)row * D + k) * rbf(a.in[11][(size_t)k * D + col]); yb += bf1(BUFA + (size_t)row * D + 1024 + k) * rbf(a.in[12][(size_t)k * D + col]); }
        ya = wave_sum(ya); yb = wave_sum(yb);
        const float ref = bf1(GATES + (size_t)row * GW_ + col) * ya + bf1(GATES + (size_t)row * GW_ + 2048 + col) * yb; const float got = bf1(QKV + (size_t)row * D + col);
        bad = fabsf(got - ref) > 0.004f + 0.02f * fabsf(ref);
    } else if (which == 3) { const int col = (int)(h2 % (unsigned)D); float s = 0.f;
        for (int k = lane; k < D; k += 64) s += bf1(QKV + (size_t)row * D + k) * rbf(a.in[13][(size_t)k * D + col]);
        s = wave_sum(s); const float xv = row < NP_ROWS ? a.in[0][(size_t)row * D + col] : a.in[1][(size_t)(row - NP_ROWS) * D + col];
        const float ref = xv + s, got = a.out[(size_t)row * D + col], gotb = bf1(BUFA + (size_t)row * D + col);
        bad = fabsf(got - ref) > 0.004f + 0.002f * fabsf(ref) || fabsf(gotb - ref) > 0.004f + 0.01f * fabsf(ref);
    } else if (which == 4) { float s = 0.f;
        for (int k = lane; k < D; k += 64) { const float v = a.out[(size_t)row * D + k]; s += v * v; }
        s = wave_sum(s); const float ref = 1.f / sqrtf(s / D + EPS); bad = fabsf(RSTD2[row] - ref) > 0.001f * ref;
    } else if (which == 5) { const int col = (int)(h2 % (unsigned)FF); float s = 0.f;
        for (int k = lane; k < D; k += 64) s += bf1(BUFA + (size_t)row * D + k) * rbf(a.in[14][k] * a.in[15][(size_t)k * FF + col]);
        s = wave_sum(s) * RSTD2[row]; const float r = fmaxf(s, 0.f) * fmaxf(s, 0.f); const float got = bf1(QKV + (size_t)row * FF + col);
        bad = fabsf(got - r) > 0.01f + 0.03f * fabsf(r);
    }
    else if (which == 8) { const int col = (int)(h2 % (unsigned)D); float s = 0.f;
        for (int k = lane; k < FF; k += 64) s += bf1(QKV + (size_t)row * FF + k) * rbf(a.in[16][(size_t)k * D + col]);
        s = wave_sum(s); const float ref = bf1(BUFA + (size_t)row * D + col) + s, got = a.out[(size_t)row * D + col];
        bad = fabsf(got - ref) > 0.03f + 0.01f * fabsf(ref);
    }
    else if (which == 6 || which == 7) {
        __shared__ float sh_s[320]; __shared__ int sh_k[320];
        const int h = (int)(h2 % 8u); const bool isA = (which == 6); const SeqPos sp = seq_of_row(row);
        const int qoff = isA ? h * 128 : 1536 + h * 128, koff = isA ? 1024 + (h / 4) * 128 : 2560 + h * 128, voff = isA ? 1280 + (h / 4) * 128 : 3584 + h * 128;
        const float* gq = isA ? a.in[4] : a.in[8]; const float* gk = isA ? a.in[5] : a.in[9];
        float qn[2]; { float q0 = bf1(QKV + (size_t)row * QKVW + qoff + lane), q1 = bf1(QKV + (size_t)row * QKVW + qoff + 64 + lane);
            const float ssq = wave_sum(q0 * q0 + q1 * q1); const float r = 1.f / sqrtf(ssq / 128.f + EPS); qn[0] = q0 * r * gq[lane] * 0.08838834764831845f; qn[1] = q1 * r * gq[64 + lane] * 0.08838834764831845f; }
        int nk = 0;
        if (isA) { nk = 257; for (int j = lane; j < 320; j += 64) { const int kt = sp.t - 128 + j; sh_k[j] = (j < 257 && kt >= 0 && kt < sp.L) ? sp.base + kt : -1; } }
        else { nk = 256; const int rows = sp.L / 64, r = sp.t / 64, c = sp.t % 64; int rs = r - 4; if (rs < 0) rs = 0; if (rs > rows - 8) rs = rows - 8; const int cb = c / 16; int reg = cb * 16 - 8; if (reg < 0) reg = 0; if (reg > 32) reg = 32;
            int sc_ = c - 8; if (sc_ < 0) sc_ = 0; if (sc_ > 48) sc_ = 48;
            for (int j = lane; j < 320; j += 64) { const int kc = reg + (j & 31), kr_ = rs + (j >> 5); sh_k[j] = (j < 256 && kc >= sc_ && kc < sc_ + 16) ? sp.base + kr_ * 64 + kc : -1; } }
        __syncthreads();
        for (int j = 0; j < nk; ++j) { const int k = sh_k[j]; float sv = -1e30f;
            if (k >= 0) { const float k0 = bf1(QKV + (size_t)k * QKVW + koff + lane), k1 = bf1(QKV + (size_t)k * QKVW + koff + 64 + lane);
                const float ssk = wave_sum(k0 * k0 + k1 * k1); const float rk = 1.f / sqrtf(ssk / 128.f + EPS);
                float d = wave_sum(qn[0] * k0 * rk * gk[lane] + qn[1] * k1 * rk * gk[64 + lane]);
                float bias;
                if (isA) { const int rel = (k - sp.base) - sp.t; bias = a.in[6][t5_bucket_dev(rel) * 8 + h]; }
                else { const int kt = k - sp.base, kr_ = kt / 64, kc = kt % 64, r = sp.t / 64, c = sp.t % 64; int dcc = kc - c; if (dcc < -15) dcc = -15; if (dcc > 15) dcc = 15; bias = a.in[10][(h * 15 + (kr_ - r + 7)) * 31 + dcc + 15]; }
                sv = d + bias; }
            if (lane == 0) sh_s[j] = sv; }
        __syncthreads();
        float m = -1e30f; for (int j = 0; j < nk; ++j) m = fmaxf(m, sh_s[j]);
        if (isA) m = fmaxf(m, a.in[7][h]);
        float den = 0.f; for (int j = 0; j < nk; ++j) den += expf(sh_s[j] - m);
        if (isA) den += expf(a.in[7][h] - m);
        float o0 = 0.f, o1 = 0.f;
        for (int j = 0; j < nk; ++j) { const int k = sh_k[j]; if (k >= 0) { const float p = expf(sh_s[j] - m) / den; o0 += p * bf1(QKV + (size_t)k * QKVW + voff + lane); o1 += p * bf1(QKV + (size_t)k * QKVW + voff + 64 + lane); } }
        const int oc = isA ? h * 128 : 1024 + h * 128;
        const float g0 = bf1(BUFA + (size_t)row * D + oc + lane), g1 = bf1(BUFA + (size_t)row * D + oc + 64 + lane);
        const bool b2 = fabsf(g0 - o0) > 0.004f + 0.015f * fabsf(o0) || fabsf(g1 - o1) > 0.004f + 0.015f * fabsf(o1);
        bad = __any(b2);
    }
    if (which == 10) { const float* xr = row < NP_ROWS ? a.in[0] + (size_t)row * D : a.in[1] + (size_t)(row - NP_ROWS) * D; float ss = 0.f;
        for (int k = lane; k < D; k += 64) ss += xr[k] * xr[k];
        ss = wave_sum(ss); const float r = 1.f / sqrtf(ss / D + EPS); bool b2 = false;
        for (int k = lane; k < D; k += 64) { const float ref = xr[k] * r * a.in[2][k], got = bf1(BUFA + (size_t)row * D + k); b2 = b2 || fabsf(got - ref) > 0.002f + 0.006f * fabsf(ref); }
        bad = __any(b2); }
    if (lane == 0 && bad && which == 0) atomicOr(flags, 1u << which);
}
__global__ void chk_final(Args a) { const unsigned f = *(const unsigned*)(a.ws + WS_TAB + 65536); const int i = blockIdx.x * 256 + threadIdx.x; if (i < 4096) { a.out[i] += 100.f * (float)f; a.out[4096 + i] += 30.f; } }
#endif
extern "C" void kernel_launch(void* const* d_in, const int* in_sizes, int n_in, void* d_out, int out_size, void* d_ws, size_t ws_size, hipStream_t stream) {
    static int grid = 0;
    if (grid == 0) {
        if (n_in != 17 || in_sizes[0] != NP_ROWS * D || in_sizes[1] != (M_ROWS - NP_ROWS) * D || out_size != M_ROWS * D || ws_size < WS_END) {
            fprintf(stderr, "kernel_launch: shape/workspace mismatch (n_in %d, in0 %d, out %d, ws %zu < %zu); nothing launched\n", n_in, n_in > 0 ? in_sizes[0] : -1, out_size, ws_size, (size_t)WS_END); grid = -1; return; }
        int dev = 0, cus = 0, per_cu = 0;
        if (hipGetDevice(&dev) != hipSuccess || hipDeviceGetAttribute(&cus, hipDeviceAttributeMultiprocessorCount, dev) != hipSuccess) { fprintf(stderr, "kernel_launch: device query failed\n"); grid = -1; return; }
        if (hipFuncSetAttribute((const void*)fwd_megakernel, hipFuncAttributeMaxDynamicSharedMemorySize, LDS_BYTES) != hipSuccess) { fprintf(stderr, "kernel_launch: hipFuncSetAttribute failed\n"); grid = -1; return; }
        if (hipOccupancyMaxActiveBlocksPerMultiprocessor(&per_cu, (const void*)fwd_megakernel, NWAVES * 64, LDS_BYTES) != hipSuccess || per_cu < 1) { fprintf(stderr, "kernel_launch: occupancy query says %d blocks per CU\n", per_cu); per_cu = 1; }
        (void)hipGetLastError();
        grid = cus * 1;
    }
    if (grid < 0) return;
    Args a{};
    for (int i = 0; i < 17; ++i) a.in[i] = (const float*)d_in[i];
    a.out = (float*)d_out; a.ws = (unsigned char*)d_ws;
#if MK_N_LAUNCHES == 1
    a.ph_lo = 0; a.ph_hi = N_PHASES;
    void* kargs[] = {&a};
    hipError_t e = hipLaunchCooperativeKernel((const void*)fwd_megakernel, dim3(grid), dim3(NWAVES * 64), kargs, LDS_BYTES, stream);
    if (e != hipSuccess) fprintf(stderr, "kernel_launch: cooperative launch failed: %s (grid %d)\n", hipGetErrorString(e), grid);
#else
#ifdef SELFCHECK
    hipMemsetAsync((char*)d_ws + WS_TAB + 65536, 0, 64, stream);
#endif
    for (int ph = 0; ph < N_PHASES; ++ph) {
        a.ph_lo = ph; a.ph_hi = ph + 1;
        hipLaunchKernelGGL(fwd_megakernel, dim3(grid), dim3(NWAVES * 64), LDS_BYTES, stream, a);
        const hipError_t le = hipPeekAtLastError();
        if (le != hipSuccess) { fprintf(stderr, "kernel_launch: launch %d failed: %s\n", ph, hipGetErrorName(le)); break; }
#ifdef SELFCHECK
        if (ph == 0) hipLaunchKernelGGL(chk_kernel, dim3(65536), dim3(64), 0, stream, a, 10);
        if (ph == 1) { hipLaunchKernelGGL(chk_kernel, dim3(65536), dim3(64), 0, stream, a, 0); hipLaunchKernelGGL(chk_kernel, dim3(65536), dim3(64), 0, stream, a, 1); }
        if (ph == 2) { hipLaunchKernelGGL(chk_kernel, dim3(65536), dim3(64), 0, stream, a, 6); hipLaunchKernelGGL(chk_kernel, dim3(65536), dim3(64), 0, stream, a, 7); }
        if (ph == 3) hipLaunchKernelGGL(chk_kernel, dim3(65536), dim3(64), 0, stream, a, 2);
        if (ph == 4) hipLaunchKernelGGL(chk_kernel, dim3(65536), dim3(64), 0, stream, a, 3);
        if (ph == 5) hipLaunchKernelGGL(chk_kernel, dim3(65536), dim3(64), 0, stream, a, 4);
        if (ph == 6) hipLaunchKernelGGL(chk_kernel, dim3(65536), dim3(64), 0, stream, a, 5);
        if (ph == 7) { hipLaunchKernelGGL(chk_kernel, dim3(65536), dim3(64), 0, stream, a, 8); }
        if (ph == 7) hipLaunchKernelGGL(chk_final, dim3(16), dim3(256), 0, stream, a);
#endif
    }
#endif
}
```

```cpp
#include <hip/hip_runtime.h>
#include <hip/hip_cooperative_groups.h>
#include <cstdio>
#include <cstdint>
namespace cg = cooperative_groups;
#define MK_N_LAUNCHES 1
namespace pg8 {
#define PG8_LAS __attribute__((address_space(3)))
typedef unsigned short bf16_t;
typedef short bf16x8 __attribute__((ext_vector_type(8)));
typedef float f32x4 __attribute__((ext_vector_type(4)));
typedef unsigned u32x4 __attribute__((ext_vector_type(4)));
constexpr int BM = 256, BK = 64, HALF = 128, HTB = HALF * BK * 2  , STAGE_BYTES = 8 * HTB, NXCD = 8, WGM = 8;

__host__ __device__ __forceinline__ int lds_byte(int r, int c) { const int st = (r >> 4) * 2 + (c >> 5), rr = r & 15, cc = c & 31, ob = rr * 64 + cc * 2; return st * 1024 + (ob ^ (((ob >> 9) & 1) << 5)); }
__host__ __device__ __forceinline__ void stage_rc(int b, int& R, int& C) { const int st = b / 1024, sb = b % 1024, swz = sb ^ (((sb >> 9) & 1) << 5); R = (st >> 1) * 16 + swz / 64; C = (st & 1) * 32 + (swz % 64) / 2; }
__host__ __device__ __forceinline__ int perm32(int rho) { const int n = rho >> 4, i = rho & 15; return 8 * (i >> 2) + 4 * n + (i & 3); }

struct Unit { int pm, pn; };
struct Gemm { const bf16_t* A; const bf16_t* Bt; int M, N, K; };

struct StaticOrder {
    int nM, nN, nwg, G, c;
    __host__ __device__ void init(int M, int N, int G_, int c_) { nM = M / BM; nN = N / BM; nwg = nM * nN; G = G_; c = c_; }
    __host__ __device__ bool next(int i, Unit& u) const {
        const long L = (long)i * G + c; if (L >= nwg) return false;
        int wgid = (int)L; { const int q = nwg / NXCD, r = nwg % NXCD, xcd = wgid % NXCD, off = wgid / NXCD; wgid = (xcd < r ? xcd * (q + 1) : r * (q + 1) + (xcd - r) * q) + off; }
        const int nig = WGM * nN, gid = wgid / nig, fm = gid * WGM, gsz = (nM - fm) < WGM ? (nM - fm) : WGM;
        u.pm = fm + ((wgid % nig) % gsz); u.pn = (wgid % nig) / gsz; return true;
    }
    __device__ __forceinline__ void a_ready(const Unit&) const {}
    __device__ __forceinline__ void done(const Unit&) const {}
};

__device__ __forceinline__ unsigned cvt_pk_bf16(float lo, float hi) { unsigned r; asm volatile("s_nop 0\n\tv_cvt_pk_bf16_f32 %0, %1, %2" : "=v"(r) : "v"(lo), "v"(hi)); return r; }
typedef float f32x2 __attribute__((ext_vector_type(2)));
typedef unsigned u32x2 __attribute__((ext_vector_type(2)));
__device__ __forceinline__ float bf_lo(unsigned w) { return __uint_as_float(w << 16); }
__device__ __forceinline__ float bf_hi(unsigned w) { return __uint_as_float(w & 0xffff0000u); }
__device__ __forceinline__ u32x4 pack8(const f32x4 v0, const f32x4 v1) { u32x4 w; w.x = cvt_pk_bf16(v0[0], v0[1]); w.y = cvt_pk_bf16(v0[2], v0[3]); w.z = cvt_pk_bf16(v1[0], v1[1]); w.w = cvt_pk_bf16(v1[2], v1[3]); return w; }
__device__ __forceinline__ float sigmoidf_(float x) { return __builtin_amdgcn_rcpf(1.0f + __builtin_amdgcn_exp2f(-1.44269504089f * x)); }
constexpr int QKV_LD = 4608, GATE_LD = 4096, DM = 2048, FFD = 8192, NHS = 36, NPROMPT_ROWS = 32768;

struct EpiProj {
    static constexpr bool PERM = true, AFTER_DRAIN = false, MID = false;
    bf16_t* QKV; bf16_t* GATES; float* SS;
    __device__ __forceinline__ void operator()(const f32x4 (&acc)[2][2][4][2], const Unit& u, int wr, int wc, int fr, int fq) const {
        const int row0 = u.pm * BM + wr * 64 + fr;
        if (u.pn < 18) {
            const int col0 = u.pn * BM + wc * 32 + 8 * fq;
#pragma unroll
            for (int ai = 0; ai < 2; ++ai)
#pragma unroll
                for (int m = 0; m < 4; ++m) { const int row = row0 + ai * HALF + m * 16; bf16_t* rowp = QKV + ((size_t)(u.pn * 2) * 40960 + (size_t)row) * 128 + wc * 32 + 8 * fq;
#pragma unroll
                    for (int bj = 0; bj < 2; ++bj) { const f32x4 v0 = acc[ai][bj][m][0], v1 = acc[ai][bj][m][1];
                        float s = (v0[0] * v0[0] + v0[1] * v0[1]) + (v0[2] * v0[2] + v0[3] * v0[3]) + (v1[0] * v1[0] + v1[1] * v1[1]) + (v1[2] * v1[2] + v1[3] * v1[3]);
                        s += __shfl_xor(s, 16); s += __shfl_xor(s, 32);
                        if (fq == 0) SS[((size_t)row * NHS + u.pn * 2 + bj) * 4 + wc] = s;
                        *(u32x4*)(rowp + (size_t)bj * 40960 * 128) = pack8(v0, v1); } }
        } else {
            const int col0 = (u.pn - 18) * BM + wc * 32 + 8 * fq;
#pragma unroll
            for (int ai = 0; ai < 2; ++ai)
#pragma unroll
                for (int m = 0; m < 4; ++m) { const int row = row0 + ai * HALF + m * 16; bf16_t* rowp = GATES + (size_t)row * GATE_LD + col0;
#pragma unroll
                    for (int bj = 0; bj < 2; ++bj) { f32x4 v0 = acc[ai][bj][m][0], v1 = acc[ai][bj][m][1];
#pragma unroll
                        for (int j = 0; j < 4; ++j) { v0[j] = sigmoidf_(v0[j]); v1[j] = sigmoidf_(v1[j]); }
                        *(u32x4*)(rowp + bj * HALF) = pack8(v0, v1); } }
        }
    }
};

struct EpiMerge {
    static constexpr bool PERM = true, AFTER_DRAIN = false, MID = true;
    const bf16_t* GATES; bf16_t* OUT;
    __device__ __forceinline__ void mid(f32x4 (&acc)[2][2][4][2], const Unit& u, int wr, int wc, int fr, int fq) const {
        const int row0 = u.pm * BM + wr * 64 + fr, col0 = u.pn * BM + wc * 32 + 8 * fq;
        const bf16_t* gp0 = GATES + (size_t)row0 * GATE_LD + col0;
        asm volatile("" : "+v"(gp0));
#pragma unroll
        for (int ai = 0; ai < 2; ++ai)
#pragma unroll
            for (int m = 0; m < 4; ++m)
#pragma unroll
                for (int bj = 0; bj < 2; ++bj) { const bf16_t* gp = gp0 + (size_t)(ai * HALF + m * 16) * GATE_LD + bj * HALF;
                    const u32x4 a = *(const u32x4*)gp, b = *(const u32x4*)(gp + DM);
                    f32x4& c0 = acc[ai][bj][m][0]; f32x4& c1 = acc[ai][bj][m][1];
                    c0[0] *= bf_lo(a.x) * __builtin_amdgcn_rcpf(bf_lo(b.x)); c0[1] *= bf_hi(a.x) * __builtin_amdgcn_rcpf(bf_hi(b.x));
                    c0[2] *= bf_lo(a.y) * __builtin_amdgcn_rcpf(bf_lo(b.y)); c0[3] *= bf_hi(a.y) * __builtin_amdgcn_rcpf(bf_hi(b.y));
                    c1[0] *= bf_lo(a.z) * __builtin_amdgcn_rcpf(bf_lo(b.z)); c1[1] *= bf_hi(a.z) * __builtin_amdgcn_rcpf(bf_hi(b.z));
                    c1[2] *= bf_lo(a.w) * __builtin_amdgcn_rcpf(bf_lo(b.w)); c1[3] *= bf_hi(a.w) * __builtin_amdgcn_rcpf(bf_hi(b.w));
                    asm volatile("" ::: "memory"); }
    }
    __device__ __forceinline__ void operator()(const f32x4 (&acc)[2][2][4][2], const Unit& u, int wr, int wc, int fr, int fq) const {
        const int row0 = u.pm * BM + wr * 64 + fr, col0 = u.pn * BM + wc * 32 + 8 * fq;
#pragma unroll
        for (int ai = 0; ai < 2; ++ai)
#pragma unroll
            for (int m = 0; m < 4; ++m) { const size_t row = (size_t)(row0 + ai * HALF + m * 16); const bf16_t* gp = GATES + row * GATE_LD + DM + col0; bf16_t* op = OUT + row * DM + col0;
#pragma unroll
                for (int bj = 0; bj < 2; ++bj) { const u32x4 b = *(const u32x4*)(gp + bj * HALF);
                    f32x4 v0 = acc[ai][bj][m][0], v1 = acc[ai][bj][m][1];
                    v0[0] *= bf_lo(b.x); v0[1] *= bf_hi(b.x); v0[2] *= bf_lo(b.y); v0[3] *= bf_hi(b.y);
                    v1[0] *= bf_lo(b.z); v1[1] *= bf_hi(b.z); v1[2] *= bf_lo(b.w); v1[3] *= bf_hi(b.w);
                    *(u32x4*)(op + bj * HALF) = pack8(v0, v1); }
                asm volatile("" ::: "memory"); }
    }
};

struct EpiOut1 {
    static constexpr bool PERM = true, AFTER_DRAIN = false, MID = false;
    const float* xp; const float* xs; float* OUT; bf16_t* X1B; float* SS2;
    __device__ __forceinline__ void operator()(const f32x4 (&acc)[2][2][4][2], const Unit& u, int wr, int wc, int fr, int fq) const {
        const int row0 = u.pm * BM + wr * 64 + fr, col0 = u.pn * BM + wc * 32 + 8 * fq;
        const float* xb = (u.pm * BM < NPROMPT_ROWS) ? xp : xs - (size_t)NPROMPT_ROWS * DM;
#pragma unroll
        for (int ai = 0; ai < 2; ++ai)
#pragma unroll
            for (int m = 0; m < 4; ++m) { const size_t row = (size_t)(row0 + ai * HALF + m * 16); const float* xr = xb + row * DM + col0; float* op = OUT + row * DM + col0; bf16_t* bp = X1B + row * DM + col0;
                float s = 0.f;
#pragma unroll
                for (int bj = 0; bj < 2; ++bj) { const f32x4 v0 = acc[ai][bj][m][0] + *(const f32x4*)(xr + bj * HALF), v1 = acc[ai][bj][m][1] + *(const f32x4*)(xr + bj * HALF + 4);
                    s += (v0[0] * v0[0] + v0[1] * v0[1]) + (v0[2] * v0[2] + v0[3] * v0[3]) + (v1[0] * v1[0] + v1[1] * v1[1]) + (v1[2] * v1[2] + v1[3] * v1[3]);
                    *(f32x4*)(op + bj * HALF) = v0; *(f32x4*)(op + bj * HALF + 4) = v1; *(u32x4*)(bp + bj * HALF) = pack8(v0, v1); }
                s += __shfl_xor(s, 16); s += __shfl_xor(s, 32);
                if (fq == 0) SS2[row * 32 + u.pn * 4 + wc] = s;
                asm volatile("" ::: "memory"); }
    }
};

struct EpiUp {
    static constexpr bool PERM = true, AFTER_DRAIN = false, MID = false;
    const float* RSTD2; bf16_t* U;
    __device__ __forceinline__ void operator()(const f32x4 (&acc)[2][2][4][2], const Unit& u, int wr, int wc, int fr, int fq) const {
        const int row0 = u.pm * BM + wr * 64 + fr, col0 = u.pn * BM + wc * 32 + 8 * fq;
#pragma unroll
        for (int ai = 0; ai < 2; ++ai)
#pragma unroll
            for (int m = 0; m < 4; ++m) { const size_t row = (size_t)(row0 + ai * HALF + m * 16); const float rs = RSTD2[row]; bf16_t* op = U + row * FFD + col0;
#pragma unroll
                for (int bj = 0; bj < 2; ++bj) { f32x4 v0 = acc[ai][bj][m][0] * rs, v1 = acc[ai][bj][m][1] * rs;
#pragma unroll
                    for (int j = 0; j < 4; ++j) { const float a = fmaxf(v0[j], 0.f), b = fmaxf(v1[j], 0.f); v0[j] = a * a; v1[j] = b * b; }
                    *(u32x4*)(op + bj * HALF) = pack8(v0, v1); } }
    }
};

struct EpiDown {
    static constexpr bool PERM = true, AFTER_DRAIN = false, MID = false;
    float* OUT;
    __device__ __forceinline__ void operator()(const f32x4 (&acc)[2][2][4][2], const Unit& u, int wr, int wc, int fr, int fq) const {
        const int row0 = u.pm * BM + wr * 64 + fr, col0 = u.pn * BM + wc * 32 + 8 * fq;
#pragma unroll
        for (int ai = 0; ai < 2; ++ai)
#pragma unroll
            for (int m = 0; m < 4; ++m) { float* op = OUT + (size_t)(row0 + ai * HALF + m * 16) * DM + col0;
#pragma unroll
                for (int bj = 0; bj < 2; ++bj) { const f32x4 v0 = acc[ai][bj][m][0] + *(const f32x4*)(op + bj * HALF), v1 = acc[ai][bj][m][1] + *(const f32x4*)(op + bj * HALF + 4);
                    *(f32x4*)(op + bj * HALF) = v0; *(f32x4*)(op + bj * HALF + 4) = v1; }
                asm volatile("" ::: "memory"); }
    }
};

template <class Epi, class Sched, bool ALIGN_EPI = false, bool SP2 = false>
__device__ __forceinline__ void gemm_phase(PG8_LAS unsigned char* lds, const Gemm g, const Sched& S, const Epi& E) {
    const int tid = threadIdx.x, wid = __builtin_amdgcn_readfirstlane(tid >> 6), lane = tid & 63, wr = wid >> 2, wc = wid & 3, fr = lane & 15, fq = lane >> 4;
    const int K = g.K, nt = K / BK;
    unsigned voffA[2], voffB[2];
#pragma unroll
    for (int i = 0; i < 2; ++i) { int R, C; stage_rc(tid * 16 + i * 8192, R, C); const int Rb = Epi::PERM ? ((R & ~31) + perm32(R & 31)) : R;
        voffA[i] = (unsigned)(R * K + C) * 2u; voffB[i] = (unsigned)(Rb * K + C) * 2u; }
    const size_t kstep = (size_t)(BK * 2);
    const size_t hstep = (size_t)HALF * K * 2;
    const size_t tstep = 2 * hstep;
    const unsigned ldsw = (unsigned)wid * 1024u;
    const int aoff = lds_byte(wr * 64 + fr, fq * 8), boff = lds_byte(wc * 32 + fr, fq * 8);
#define PG8_SA(b, h) (((b) * 2 + (h)) * HTB)
#define PG8_SB(b, h) ((4 + (b) * 2 + (h)) * HTB)
#define PG8_STAGE(bufoff, gbase, voff) do { _Pragma("unroll") for (int _i = 0; _i < 2; ++_i) \
        __builtin_amdgcn_global_load_lds((const unsigned*)((const char*)(gbase) + (voff)[_i]), (PG8_LAS unsigned*)(lds + (bufoff) + ldsw + _i * 8192), 16, 0, 0); } while (0)
#define PG8_LDA(dst, b, h) do { _Pragma("unroll") for (int m = 0; m < 4; ++m) _Pragma("unroll") for (int k = 0; k < 2; ++k) dst[m][k] = *(const PG8_LAS bf16x8*)(lds + PG8_SA(b, h) + aoff + m * 2048 + k * 1024); } while (0)
#define PG8_LDB(dst, b, h) do { _Pragma("unroll") for (int n = 0; n < 2; ++n) _Pragma("unroll") for (int k = 0; k < 2; ++k) dst[n][k] = *(const PG8_LAS bf16x8*)(lds + PG8_SB(b, h) + boff + n * 2048 + k * 1024); } while (0)
#define PG8_MMA(ai, bj, At, Bt) do { __builtin_amdgcn_s_setprio(1); _Pragma("unroll") for (int m = 0; m < 4; ++m) _Pragma("unroll") for (int n = 0; n < 2; ++n) _Pragma("unroll") for (int k = 0; k < 2; ++k) \
        acc[ai][bj][m][n] = __builtin_amdgcn_mfma_f32_16x16x32_bf16(Bt[n][k], At[m][k], acc[ai][bj][m][n], 0, 0, 0); __builtin_amdgcn_s_setprio(0); } while (0)
#define PG8_WAIT_V(n) asm volatile("s_waitcnt vmcnt(" #n ")" ::: "memory")
#define PG8_WAIT_L(n) asm volatile("s_waitcnt lgkmcnt(" #n ")" ::: "memory")
#define PG8_BAR __builtin_amdgcn_s_barrier()
#define PG8_SCHED __builtin_amdgcn_sched_barrier(0)
    Unit cur, nxt; int ui = 0;
    if (!S.next(0, cur)) return;
    f32x4 acc[2][2][4][2];
#pragma unroll
    for (int a = 0; a < 2; ++a)
#pragma unroll
        for (int b = 0; b < 2; ++b)
#pragma unroll
            for (int m = 0; m < 4; ++m)
#pragma unroll
                for (int n = 0; n < 2; ++n) acc[a][b][m][n] = (f32x4){0.f, 0.f, 0.f, 0.f};
    bf16x8 At[4][2], B0[2][2], B1[2][2];
    const char* cA = (const char*)g.A + (size_t)cur.pm * tstep; const char* cB = (const char*)g.Bt + (size_t)cur.pn * tstep;
    S.a_ready(cur);
    if constexpr (SP2) {
        PG8_STAGE(PG8_SB(0, 0), cB, voffB); PG8_STAGE(PG8_SB(0, 1), cB + hstep, voffB); PG8_STAGE(PG8_SA(0, 0), cA, voffA); PG8_STAGE(PG8_SA(0, 1), cA + hstep, voffA);
        if (wr == 1) PG8_BAR;
        PG8_WAIT_V(2); PG8_BAR;
        PG8_STAGE(PG8_SB(1, 0), cB + kstep, voffB); PG8_STAGE(PG8_SA(1, 0), cA + kstep, voffA); PG8_STAGE(PG8_SB(1, 1), cB + hstep + kstep, voffB);
        PG8_WAIT_V(6); PG8_BAR;
    } else {
        PG8_STAGE(PG8_SB(0, 0), cB, voffB); PG8_STAGE(PG8_SA(0, 0), cA, voffA); PG8_STAGE(PG8_SB(0, 1), cB + hstep, voffB); PG8_STAGE(PG8_SA(0, 1), cA + hstep, voffA);
        if (wr == 1) PG8_BAR;
        PG8_WAIT_V(4); PG8_BAR;
        PG8_STAGE(PG8_SB(1, 0), cB + kstep, voffB); PG8_STAGE(PG8_SA(1, 0), cA + kstep, voffA); PG8_STAGE(PG8_SB(1, 1), cB + hstep + kstep, voffB);
        PG8_WAIT_V(6); PG8_BAR;
    }
    for (;;) {
        const bool has_next = S.next(ui + 1, nxt);
        const char* nA = has_next ? (const char*)g.A + (size_t)nxt.pm * tstep : cA; const char* nB = has_next ? (const char*)g.Bt + (size_t)nxt.pn * tstep : cB;
        constexpr int NSEG = Epi::MID ? 2 : 1; const int seglen = nt / NSEG;
        for (int seg = 0; seg < NSEG; ++seg) {
        if constexpr (Epi::MID) { if (seg == 1) E.mid(acc, cur, wr, wc, fr, fq); }
        for (int t = seg * seglen; t < (seg + 1) * seglen; t += 2) {
            const bool last = (t == nt - 2);
            const char* a1 = cA + (size_t)(t + 1) * kstep;
            const char* a2 = last ? nA : cA + (size_t)(t + 2) * kstep; const char* b2 = last ? nB : cB + (size_t)(t + 2) * kstep;
            const char* a3 = a2 + kstep; const char* b3 = b2 + kstep;
            if (last && has_next) S.a_ready(nxt);
            if constexpr (SP2) {
            PG8_LDB(B0, 0, 0); PG8_LDB(B1, 0, 1); PG8_SCHED; PG8_LDA(At, 0, 0); PG8_STAGE(PG8_SA(1, 1), a1 + hstep, voffA);
            PG8_WAIT_V(8); PG8_WAIT_L(0); PG8_BAR; PG8_MMA(0, 0, At, B0); PG8_MMA(0, 1, At, B1); PG8_BAR; PG8_SCHED;
            PG8_LDA(At, 0, 1); PG8_STAGE(PG8_SB(0, 0), b2, voffB); PG8_STAGE(PG8_SB(0, 1), b2 + hstep, voffB); PG8_STAGE(PG8_SA(0, 0), a2, voffA);
            PG8_WAIT_V(8); PG8_WAIT_L(0); PG8_BAR; PG8_MMA(1, 0, At, B0); PG8_MMA(1, 1, At, B1); PG8_BAR; PG8_SCHED;
            PG8_LDB(B0, 1, 0); PG8_LDB(B1, 1, 1); PG8_SCHED; PG8_LDA(At, 1, 0); PG8_STAGE(PG8_SA(0, 1), a2 + hstep, voffA);
            PG8_WAIT_V(8); PG8_WAIT_L(0); PG8_BAR; PG8_MMA(0, 0, At, B0); PG8_MMA(0, 1, At, B1); PG8_BAR; PG8_SCHED;
            PG8_LDA(At, 1, 1); PG8_STAGE(PG8_SB(1, 0), b3, voffB); PG8_STAGE(PG8_SB(1, 1), b3 + hstep, voffB); PG8_STAGE(PG8_SA(1, 0), a3, voffA);
            PG8_WAIT_V(8); PG8_WAIT_L(0); PG8_BAR; PG8_MMA(1, 0, At, B0); PG8_MMA(1, 1, At, B1); PG8_BAR; PG8_SCHED;
            } else {
            PG8_LDB(B0, 0, 0); PG8_SCHED; PG8_LDA(At, 0, 0); PG8_STAGE(PG8_SA(1, 1), a1 + hstep, voffA);
            PG8_WAIT_L(8); PG8_BAR; PG8_WAIT_L(0); PG8_MMA(0, 0, At, B0); PG8_BAR; PG8_SCHED;
            PG8_LDB(B1, 0, 1); PG8_STAGE(PG8_SB(0, 0), b2, voffB);
            PG8_BAR; PG8_WAIT_L(0); PG8_MMA(0, 1, At, B1); PG8_BAR;
            PG8_LDA(At, 0, 1); PG8_STAGE(PG8_SA(0, 0), a2, voffA);
            PG8_BAR; PG8_WAIT_L(0); PG8_MMA(1, 0, At, B0); PG8_BAR; PG8_SCHED;
            PG8_STAGE(PG8_SB(0, 1), b2 + hstep, voffB);
            PG8_WAIT_V(6); PG8_BAR; PG8_MMA(1, 1, At, B1); PG8_BAR;
            PG8_LDB(B0, 1, 0); PG8_SCHED; PG8_LDA(At, 1, 0); PG8_STAGE(PG8_SA(0, 1), a2 + hstep, voffA);
            PG8_WAIT_L(8); PG8_BAR; PG8_WAIT_L(0); PG8_MMA(0, 0, At, B0); PG8_BAR; PG8_SCHED;
            PG8_LDB(B1, 1, 1); PG8_STAGE(PG8_SB(1, 0), b3, voffB);
            PG8_BAR; PG8_WAIT_L(0); PG8_MMA(0, 1, At, B1); PG8_BAR;
            PG8_LDA(At, 1, 1); PG8_STAGE(PG8_SA(1, 0), a3, voffA);
            PG8_BAR; PG8_WAIT_L(0); PG8_MMA(1, 0, At, B0); PG8_BAR; PG8_SCHED;
            PG8_STAGE(PG8_SB(1, 1), b3 + hstep, voffB);
            PG8_WAIT_V(6); PG8_BAR; PG8_MMA(1, 1, At, B1); PG8_BAR;
            }
        }
        }
        if constexpr (ALIGN_EPI) { if (wr == 0) PG8_BAR; }
        if constexpr (!Epi::AFTER_DRAIN) { E(acc, cur, wr, wc, fr, fq); S.done(cur); }
        if (!has_next) break;
#pragma unroll
        for (int a = 0; a < 2; ++a)
#pragma unroll
            for (int b = 0; b < 2; ++b)
#pragma unroll
                for (int m = 0; m < 4; ++m)
#pragma unroll
                    for (int n = 0; n < 2; ++n) acc[a][b][m][n] = (f32x4){0.f, 0.f, 0.f, 0.f};
        cur = nxt; cA = nA; cB = nB; ++ui;
        if constexpr (ALIGN_EPI) { if (wr == 1) PG8_BAR; }
    }
    PG8_WAIT_V(0);
    if constexpr (!ALIGN_EPI) { if (wr == 0) PG8_BAR; }
    PG8_BAR;
    if constexpr (Epi::AFTER_DRAIN) { E.fused(acc, cur, wr, wc, fr, fq, lds, wid, lane); S.done(cur); }
#undef PG8_SA
#undef PG8_SB
#undef PG8_STAGE
#undef PG8_LDA
#undef PG8_LDB
#undef PG8_MMA
#undef PG8_WAIT_V
#undef PG8_WAIT_L
#undef PG8_BAR
#undef PG8_SCHED
}
}
#ifndef MK_N_LAUNCHES
#define MK_N_LAUNCHES 1
#endif
constexpr int NWAVES = 8;
constexpr int M_ROWS = 40960, NP_ROWS = 32768, D = 2048, FF = 8192, INW = 8704, QKVW = 4608, GW_ = 4096, HD = 128;
constexpr float EPS = 1e-6f;
constexpr size_t MiB = 1u << 20;
constexpr size_t WS_TAB = 0;
constexpr size_t WS_RSTD2 = 1 * MiB;
constexpr size_t WS_SS2 = 2 * MiB;
constexpr size_t WS_SS = 8 * MiB;
constexpr size_t WS_WIN = 32 * MiB;
constexpr size_t WS_WBR = 66 * MiB;
constexpr size_t WS_WOUT = 74 * MiB;
constexpr size_t WS_WUP = 82 * MiB;
constexpr size_t WS_WDN = 114 * MiB;
constexpr size_t WS_BUFA = 146 * MiB;
constexpr size_t WS_QKV = 306 * MiB;
constexpr size_t WS_GATES = 666 * MiB;
constexpr size_t WS_END = 986 * MiB;
constexpr int LDS_BYTES = 147456;

#define LAS __attribute__((address_space(3)))
typedef unsigned short bf16;
typedef unsigned v4u __attribute__((ext_vector_type(4)));
typedef float f32x4 __attribute__((ext_vector_type(4)));
#define LDS_WAIT() asm volatile("s_waitcnt lgkmcnt(0)" ::: "memory")
__device__ __forceinline__ unsigned f2bf(float f) { unsigned u = __builtin_bit_cast(unsigned, f); return (u + 0x7fffu + ((u >> 16) & 1u)) >> 16; }
__device__ __forceinline__ unsigned pk2(float lo, float hi) { return f2bf(lo) | (f2bf(hi) << 16); }
__device__ __forceinline__ float bflo(unsigned w) { return __uint_as_float(w << 16); }
__device__ __forceinline__ float bfhi(unsigned w) { return __uint_as_float(w & 0xffff0000u); }
__device__ __forceinline__ float wave_sum(float v) {
#pragma unroll
    for (int o = 1; o < 64; o <<= 1) v += __shfl_xor(v, o);
    return v;
}
__device__ __forceinline__ float wave_max(float v) {
#pragma unroll
    for (int o = 1; o < 64; o <<= 1) v = fmaxf(v, __shfl_xor(v, o));
    return v;
}
__device__ __forceinline__ void wave_sync() { __builtin_amdgcn_fence(__ATOMIC_RELEASE, "wavefront"); __builtin_amdgcn_wave_barrier(); __builtin_amdgcn_fence(__ATOMIC_ACQUIRE, "wavefront"); }

__device__ __forceinline__ int t5_bucket_dev(int rel) {
    const int n = rel < 0 ? -rel : rel;
    const int b = n < 8 ? n : 8 + (n >= 12) + (n >= 16) + (n >= 23) + (n >= 32) + (n >= 46) + (n >= 64) + (n >= 91);
    return b + (rel > 0 ? 16 : 0);
}

struct Frame {
    unsigned char* lds; int tid, lane, wave, G, bid;
    const float *xp, *xs, *g1, *w_in, *gqa, *gka, *t5, *sink, *gqb, *gkb, *rpb, *wbra, *wbrb, *wout, *g2, *wup, *wdn;
    float* out; unsigned char* ws;
};
__device__ __forceinline__ const float* xrow_ptr(const Frame& F, int m) { return m < NP_ROWS ? F.xp + (size_t)m * D : F.xs + (size_t)(m - NP_ROWS) * D; }

__device__ __forceinline__ void p0_transpose_item(const float* W, int K, int N, bf16* WT, int ldk, int koff, const float* kscale, float* scr, int item, int lane) {
    const int nblk = N / 32, kb = item / nblk, nb = item % nblk, k0 = 64 * kb, n0 = 32 * nb;
#pragma unroll 8
    for (int i = 0; i < 32; ++i) { const int kk = 2 * i + (lane >> 5); float w = W[(size_t)(k0 + kk) * N + n0 + (lane & 31)]; if (kscale) w *= kscale[k0 + kk]; scr[kk * 33 + (lane & 31)] = w; }
    wave_sync();
    const int c = lane & 7;
#pragma unroll
    for (int j = 0; j < 4; ++j) { const int n = (lane >> 3) + 8 * j; const float* s = scr + (8 * c) * 33 + n;
        v4u o; o.x = pk2(s[0 * 33], s[1 * 33]); o.y = pk2(s[2 * 33], s[3 * 33]); o.z = pk2(s[4 * 33], s[5 * 33]); o.w = pk2(s[6 * 33], s[7 * 33]);
        *(v4u*)(WT + (size_t)(n0 + n) * ldk + koff + k0 + 8 * c) = o; }
    wave_sync();
}
__device__ __forceinline__ void p0_prologue(Frame& F) {
    float* scr = (float*)(F.lds + F.wave * 16384);
    const int gw = F.bid * NWAVES + F.wave, NGW = F.G * NWAVES;
    constexpr int I_IN = (D / 64) * (INW / 32), I_BR = (1024 / 64) * (D / 32), I_OUT = (D / 64) * (D / 32), I_UP = (D / 64) * (FF / 32), I_DN = (FF / 64) * (D / 32);
    constexpr int NITEMS = I_IN + 2 * I_BR + I_OUT + I_UP + I_DN;
    for (int it = gw; it < NITEMS; it += NGW) {
        int r = it;
        if (r < I_IN) { p0_transpose_item(F.w_in, D, INW, (bf16*)(F.ws + WS_WIN), D, 0, nullptr, scr, r, F.lane); continue; } r -= I_IN;
        if (r < I_BR) { p0_transpose_item(F.wbra, 1024, D, (bf16*)(F.ws + WS_WBR), D, 0, nullptr, scr, r, F.lane); continue; } r -= I_BR;
        if (r < I_BR) { p0_transpose_item(F.wbrb, 1024, D, (bf16*)(F.ws + WS_WBR), D, 1024, nullptr, scr, r, F.lane); continue; } r -= I_BR;
        if (r < I_OUT) { p0_transpose_item(F.wout, D, D, (bf16*)(F.ws + WS_WOUT), D, 0, nullptr, scr, r, F.lane); continue; } r -= I_OUT;
        if (r < I_UP) { p0_transpose_item(F.wup, D, FF, (bf16*)(F.ws + WS_WUP), D, 0, F.g2, scr, r, F.lane); continue; } r -= I_UP;
        p0_transpose_item(F.wdn, FF, D, (bf16*)(F.ws + WS_WDN), FF, 0, nullptr, scr, r, F.lane);
    }
    bf16* H = (bf16*)(F.ws + WS_BUFA);
    for (int m = gw; m < M_ROWS; m += NGW) {
        const f32x4* xr = (const f32x4*)xrow_ptr(F, m) + F.lane; f32x4 v[8]; float s = 0.f;
#pragma unroll
        for (int j = 0; j < 8; ++j) { v[j] = xr[64 * j]; s += (v[j].x * v[j].x + v[j].y * v[j].y) + (v[j].z * v[j].z + v[j].w * v[j].w); }
        const float rstd = 1.0f / sqrtf(wave_sum(s) * (1.f / D) + EPS);
        unsigned long long* o8 = (unsigned long long*)(H + (size_t)m * D) + F.lane; const f32x4* gp = (const f32x4*)F.g1 + F.lane;
#pragma unroll
        for (int j = 0; j < 8; ++j) { const f32x4 g = gp[64 * j]; o8[64 * j] = (unsigned long long)pk2(v[j].x * rstd * g.x, v[j].y * rstd * g.y) | ((unsigned long long)pk2(v[j].z * rstd * g.z, v[j].w * rstd * g.w) << 32); }
    }
    float* BA = (float*)(F.ws + WS_TAB);
    for (int i = F.bid * 512 + F.tid; i < 8 * 257; i += F.G * 512) { const int h = i / 257, rel = i % 257 - 128; BA[i] = F.t5[t5_bucket_dev(rel) * 8 + h]; }
}

struct SeqPos { int base, t, L; };
__device__ __forceinline__ SeqPos seq_of_row(int row) { SeqPos p; if (row < NP_ROWS) { p.base = row & ~4095; p.t = row & 4095; p.L = 4096; } else { const int r2 = row - NP_ROWS; p.base = NP_ROWS + (r2 & ~2047); p.t = r2 & 2047; p.L = 2048; } return p; }
__device__ __forceinline__ float rstd_ss(const float* SS, int row, int hs) { const f32x4 p = *(const f32x4*)(SS + ((size_t)row * 36 + hs) * 4); return 1.0f / sqrtf(((p.x + p.y) + (p.z + p.w)) * (1.f / HD) + EPS); }
__device__ __forceinline__ void naive_core(const Frame& F, float* qs, float* sc, int* kr, int nk, int row, int qoff, int koff, int voff, int hsq, int hsk, const float* gq, const float* gk, bool has_sink, float sinkv, int outcol) {
    const bf16* QKV = (const bf16*)(F.ws + WS_QKV); const float* SS = (const float*)(F.ws + WS_SS); bf16* ATT = (bf16*)(F.ws + WS_BUFA);
    const int lane = F.lane;
    { const unsigned w = *(const unsigned*)(QKV + (size_t)row * QKVW + qoff + 2 * lane); const float sc0 = 0.08838834764831845f;
      qs[2 * lane] = bflo(w) * gq[2 * lane] * gk[2 * lane] * sc0; qs[2 * lane + 1] = bfhi(w) * gq[2 * lane + 1] * gk[2 * lane + 1] * sc0; }
    const float rq = rstd_ss(SS, row, hsq);
    wave_sync();
    float sv[5]; float mx = -1e30f;
#pragma unroll
    for (int i = 0; i < 5; ++i) { const int j = lane + 64 * i; float s = -1e30f;
        if (j < nk && kr[j] >= 0) { const int k = kr[j]; const float rk = rstd_ss(SS, k, hsk); const v4u* kp = (const v4u*)(QKV + (size_t)k * QKVW + koff); float dot = 0.f;
            for (int c = 0; c < 16; ++c) { const v4u w = kp[c]; const float* q = qs + 8 * c;
                dot += q[0] * bflo(w.x) + q[1] * bfhi(w.x) + q[2] * bflo(w.y) + q[3] * bfhi(w.y) + q[4] * bflo(w.z) + q[5] * bfhi(w.z) + q[6] * bflo(w.w) + q[7] * bfhi(w.w); }
            s = dot * rq * rk + sc[j]; }
        sv[i] = s; mx = fmaxf(mx, s); }
    mx = wave_max(mx); if (has_sink) mx = fmaxf(mx, sinkv);
    float sum = 0.f;
#pragma unroll
    for (int i = 0; i < 5; ++i) { sv[i] = __expf(sv[i] - mx); sum += sv[i]; }
    sum = wave_sum(sum); if (has_sink) sum += __expf(sinkv - mx);
    const float inv = 1.0f / sum;
    wave_sync();
#pragma unroll
    for (int i = 0; i < 5; ++i) sc[lane + 64 * i] = sv[i] * inv;
    wave_sync();
    float a0 = 0.f, a1 = 0.f;
    for (int j = 0; j < nk; ++j) { const int k = kr[j]; if (k >= 0) { const float p = sc[j]; const unsigned w = *(const unsigned*)(QKV + (size_t)k * QKVW + voff + 2 * lane); a0 += p * bflo(w); a1 += p * bfhi(w); } }
    *(unsigned*)(ATT + (size_t)row * D + outcol + 2 * lane) = pk2(a0, a1);
    wave_sync();
}
__device__ __forceinline__ void naive_attention(Frame& F) {
    float* qs = (float*)(F.lds + F.wave * 4096); float* sc = qs + 128; int* kr = (int*)(sc + 320);
    const float* BA = (const float*)(F.ws + WS_TAB);
    const int gw = F.bid * NWAVES + F.wave, NGW = F.G * NWAVES, lane = F.lane;
    for (int it = gw; it < M_ROWS * 16; it += NGW) {
        const int row = it >> 4, hh = it & 15; const SeqPos sp = seq_of_row(row);
#ifdef PROBE_ZERO
        if ((PROBE_ZERO == 3) || (PROBE_ZERO == 1 && hh < 8) || (PROBE_ZERO == 2 && hh >= 8)) { *(unsigned*)((bf16*)(F.ws + WS_BUFA) + (size_t)row * D + hh * 128 + 2 * lane) = 0u; continue; }
#endif
        if (hh < 8) {
            const int h = hh, hk = h >> 2;
#pragma unroll
            for (int i = 0; i < 5; ++i) { const int j = lane + 64 * i; const int kt = sp.t - 128 + j; const bool ok = (j < 257) && kt >= 0 && kt < sp.L; kr[j] = ok ? sp.base + kt : -1; sc[j] = ok ? F.t5[t5_bucket_dev(j - 128) * 8 + h] : 0.f; }
            wave_sync();
            naive_core(F, qs, sc, kr, 257, row, h * 128, 1024 + hk * 128, 1280 + hk * 128, h, 8 + hk, F.gqa, F.gka, true, F.sink[h], h * 128);
        } else {
            const int h = hh - 8, rows = sp.L >> 6, r = sp.t >> 6, c = sp.t & 63;
            int rs = r - 4; rs = rs < 0 ? 0 : (rs > rows - 8 ? rows - 8 : rs);
            int cs = c - 8; cs = cs < 0 ? 0 : (cs > 48 ? 48 : cs);
#pragma unroll
            for (int i = 0; i < 5; ++i) { const int j = lane + 64 * i; const int kr_ = rs + (j >> 4), kc = cs + (j & 15); const bool ok = j < 128;
                int dcc = kc - c; dcc = (dcc < -15 ? -15 : (dcc > 15 ? 15 : dcc)) + 15; const int dr = kr_ - r + 7;
                kr[j] = ok ? sp.base + kr_ * 64 + kc : -1; sc[j] = ok ? F.rpb[(h * 15 + dr) * 31 + dcc] : 0.f; }
            wave_sync();
            naive_core(F, qs, sc, kr, 128, row, 1536 + h * 128, 2560 + h * 128, 3584 + h * 128, 12 + h, 20 + h, F.gqb, F.gkb, false, 0.f, 1024 + h * 128);
        }
    }
}


namespace att {
#define ALAS __attribute__((address_space(3)))
typedef short bf16x8 __attribute__((ext_vector_type(8)));
typedef short v4i16_t __attribute__((ext_vector_type(4)));
constexpr int TAB_OFF = 131072;
constexpr float LOG2E = 1.4426950408889634f;
__device__ __forceinline__ size_t hm(int hs, int row) { return ((size_t)hs * M_ROWS + (size_t)row) * 128; }
__device__ __forceinline__ unsigned img_off(int row, int chunk) { return (unsigned)(row * 256 + (((chunk ^ row) & 15) << 4)); }
__device__ __forceinline__ v4i16_t vtr(const ALAS unsigned char* p) { return __builtin_amdgcn_ds_read_tr16_b64_v4i16((ALAS v4i16_t*)p); }
__device__ __forceinline__ unsigned tr_off(int row, int dt, int i16) { const int ch = 2 * dt + ((i16 & 3) >> 1); return (unsigned)(row * 256 + (((ch ^ row) & 15) << 4) + (i16 & 1) * 8); }
__device__ __forceinline__ void load_q(bf16x8 (&qf)[4], const bf16* QKV, int qrow, int qhs, const float* gq, const float* gk, int g) {
#pragma unroll
    for (int ks = 0; ks < 4; ++ks) { const int d0 = 32 * ks + 8 * g; const v4u w = *(const v4u*)(QKV + hm(qhs, qrow) + d0);
        const f32x4 a0 = *(const f32x4*)(gq + d0), a1 = *(const f32x4*)(gq + d0 + 4), b0 = *(const f32x4*)(gk + d0), b1 = *(const f32x4*)(gk + d0 + 4); const float c = 0.08838834764831845f;
        v4u o; o.x = pk2(bflo(w.x) * a0.x * b0.x * c, bfhi(w.x) * a0.y * b0.y * c); o.y = pk2(bflo(w.y) * a0.z * b0.z * c, bfhi(w.y) * a0.w * b0.w * c);
        o.z = pk2(bflo(w.z) * a1.x * b1.x * c, bfhi(w.z) * a1.y * b1.y * c); o.w = pk2(bflo(w.w) * a1.z * b1.z * c, bfhi(w.w) * a1.w * b1.w * c);
        qf[ks] = __builtin_bit_cast(bf16x8, o); }
}
__device__ __forceinline__ bf16x8 pack_p(const f32x4 a, const f32x4 b) { v4u o; o.x = pk2(a[0], a[1]); o.y = pk2(a[2], a[3]); o.z = pk2(b[0], b[1]); o.w = pk2(b[2], b[3]); return __builtin_bit_cast(bf16x8, o); }

#define ATT_DMA(src, q) __builtin_amdgcn_global_load_lds((const unsigned*)(src), (ALAS unsigned*)(L + (q) * 1024), 16, 0, 0)
#define ATT_VMWAIT() asm volatile("s_waitcnt vmcnt(0)" ::: "memory")
struct UnitA { int base, n, Ls, h; };
__device__ __forceinline__ UnitA decode_a(int u) { UnitA x; x.h = u & 7; const int blk = u >> 3;
    if (blk < 256) { x.base = (blk >> 5) * 4096; x.n = blk & 31; x.Ls = 4096; } else { const int b2 = blk - 256; x.base = NP_ROWS + (b2 >> 4) * 2048; x.n = b2 & 15; x.Ls = 2048; } return x; }
__device__ __forceinline__ void stage_a(ALAS unsigned char* L, const bf16* QKV, const UnitA& x, int off, int w, int lane) {
    const int rl = lane >> 4, p = lane & 15, kpos0 = x.n * 128 - 128;
#pragma unroll
    for (int j = 0; j < 12; ++j) { const int q = w + 8 * j, row = 4 * q + rl; int kp = kpos0 + row; kp = kp < 0 ? 0 : (kp > x.Ls - 1 ? x.Ls - 1 : kp);
        ATT_DMA(QKV + hm(off, x.base + kp) + ((p ^ row) & 15) * 8, q); }
}
__device__ __forceinline__ void attn_a(const Frame& F, ALAS unsigned char* L) {
    ALAS float* rkT = (ALAS float*)(L + TAB_OFF); ALAS float* baT = (ALAS float*)(L + TAB_OFF + 2048);
    const bf16* QKV = (const bf16*)(F.ws + WS_QKV); const float* SS = (const float*)(F.ws + WS_SS); bf16* ATT = (bf16*)(F.ws + WS_BUFA);
    const int tid = F.tid, lane = F.lane, w = F.wave, g = lane >> 4, i16 = lane & 15;
    __syncthreads();
    if (F.bid < 2560) { const UnitA x0 = decode_a(F.bid); stage_a(L, QKV, x0, 8 + (x0.h >> 2), w, lane); }
    for (int u = F.bid; u < 2560; u += F.G) {
        const UnitA x = decode_a(u); const int h = x.h, base = x.base, n = x.n, Ls = x.Ls;
        const int hk = h >> 2, voff = 10 + hk, qoff = h, kpos0 = n * 128 - 128;
        if (tid < 384) { int kp = kpos0 + tid; kp = kp < 0 ? 0 : (kp > Ls - 1 ? Ls - 1 : kp); rkT[tid] = rstd_ss(SS, base + kp, 8 + hk); }
        if (tid < 257) baT[tid] = F.t5[t5_bucket_dev(tid - 128) * 8 + h] * LOG2E;
        const int qrow = base + n * 128 + 16 * w + i16; const float rq = rstd_ss(SS, qrow, h) * LOG2E;
        const float* gq_ = F.gqa; const float* gk_ = F.gka; asm volatile("" : "+s"(gq_), "+s"(gk_));
        bf16x8 qf[4]; load_q(qf, QKV, qrow, qoff, gq_, gk_, g);
        ATT_VMWAIT(); __syncthreads();
        f32x4 s[17];
        unsigned kb[4];
#pragma unroll
        for (int ks = 0; ks < 4; ++ks) kb[ks] = img_off(16 * w + i16, 4 * ks + g);
#pragma unroll
        for (int t = 0; t < 17; ++t) { f32x4 acc = {0.f, 0.f, 0.f, 0.f};
#pragma unroll
            for (int ks = 0; ks < 4; ++ks) { const bf16x8 kf = *(const ALAS bf16x8*)(L + kb[ks] + t * 4096); acc = __builtin_amdgcn_mfma_f32_16x16x32_bf16(kf, qf[ks], acc, 0, 0, 0); }
            s[t] = acc; }
        __syncthreads();
        stage_a(L, QKV, x, voff, w, lane);
        int bb = 4 * g - i16; asm volatile("" : "+v"(bb));
        float m = -1e30f;
#pragma unroll
        for (int t = 0; t < 17; ++t) { const int bi0 = 16 * (w + t) + 4 * g; const f32x4 rk4 = *(const ALAS f32x4*)(rkT + bi0);
#pragma unroll
            for (int r = 0; r < 4; ++r) { const int idx = 16 * t + r + bb, kp = kpos0 + bi0 + r; const bool valid = (unsigned)idx <= 256u && kp >= 0 && kp < Ls;
                const int idc = idx < 0 ? 0 : (idx > 256 ? 256 : idx);
                const float v = valid ? s[t][r] * rq * rk4[r] + baT[idc] : -1e30f; s[t][r] = v; m = fmaxf(m, v); } }
        m = fmaxf(m, __shfl_xor(m, 16)); m = fmaxf(m, __shfl_xor(m, 32));
        const float sk2 = F.sink[h] * LOG2E; m = fmaxf(m, sk2);
        float l = 0.f;
#pragma unroll
        for (int t = 0; t < 17; ++t)
#pragma unroll
            for (int r = 0; r < 4; ++r) { const float p = __builtin_amdgcn_exp2f(s[t][r] - m); s[t][r] = p; l += p; }
        l += __shfl_xor(l, 16); l += __shfl_xor(l, 32); l += __builtin_amdgcn_exp2f(sk2 - m);
        bf16x8 pk[9];
#pragma unroll
        for (int kk = 0; kk < 8; ++kk) pk[kk] = pack_p(s[2 * kk], s[2 * kk + 1]);
        pk[8] = pack_p(s[16], (f32x4){0.f, 0.f, 0.f, 0.f});
        ATT_VMWAIT(); __syncthreads();
        f32x4 o[8];
#pragma unroll
        for (int dt = 0; dt < 8; ++dt) o[dt] = (f32x4){0.f, 0.f, 0.f, 0.f};
        unsigned tb[8];
#pragma unroll
        for (int dt = 0; dt < 8; ++dt) tb[dt] = tr_off(16 * w + 4 * g + (i16 >> 2), dt, i16);
        const unsigned t17off = (unsigned)((w == 7 ? 16 : 17) * 4096);
#pragma unroll
        for (int kk = 0; kk < 9; ++kk) { const unsigned offb = kk < 8 ? (unsigned)((2 * kk + 1) * 4096) : t17off;
#pragma unroll
            for (int dt = 0; dt < 8; ++dt) { const v4i16_t lo = vtr(L + tb[dt] + 2 * kk * 4096), hi = vtr(L + tb[dt] + offb);
                const bf16x8 vf = {lo[0], lo[1], lo[2], lo[3], hi[0], hi[1], hi[2], hi[3]};
                o[dt] = __builtin_amdgcn_mfma_f32_16x16x32_bf16(vf, pk[kk], o[dt], 0, 0, 0); } }
        __syncthreads();
        if (u + F.G < 2560) { const UnitA xn = decode_a(u + F.G); stage_a(L, QKV, xn, 8 + (xn.h >> 2), w, lane); }
        const float inv = 1.0f / l; bf16* op = ATT + (size_t)qrow * D + h * 128 + 4 * g;
#pragma unroll
        for (int dt = 0; dt < 8; ++dt) { const unsigned long long v = (unsigned long long)pk2(o[dt][0] * inv, o[dt][1] * inv) | ((unsigned long long)pk2(o[dt][2] * inv, o[dt][3] * inv) << 32); *(unsigned long long*)(op + 16 * dt) = v; }
    }
    ATT_VMWAIT();
}

struct UnitB { int base, r0, rows, kr0, h, half; };
__device__ __forceinline__ UnitB decode_b(int u) { UnitB x; x.h = u & 7; x.half = (u >> 3) & 1; const int rg = u >> 4;
    if (rg < 128) { x.base = (rg >> 4) * 4096; x.r0 = (rg & 15) * 4; x.rows = 64; } else { const int r2 = rg - 128; x.base = NP_ROWS + (r2 >> 3) * 2048; x.r0 = (r2 & 7) * 4; x.rows = 32; }
    int k = x.r0 - 4; x.kr0 = k < 0 ? 0 : (k > x.rows - 11 ? x.rows - 11 : k); return x; }
__device__ __forceinline__ void stage_b(ALAS unsigned char* L, const bf16* QKV, const UnitB& x, int off, int w, int lane) {
    const int rl = lane >> 4, p = lane & 15, col0 = x.half ? 24 : 0;
#pragma unroll
    for (int j = 0; j < 14; ++j) { const int q = w + 8 * j;
        if (q < 110) { const int row = 4 * q + rl, kr = row / 40, kc = row - kr * 40;
            ATT_DMA(QKV + hm(off, x.base + (x.kr0 + kr) * 64 + col0 + kc) + ((p ^ row) & 15) * 8, q); } }
}
__device__ __forceinline__ void attn_b(const Frame& F, ALAS unsigned char* L) {
    ALAS float* rkT = (ALAS float*)(L + TAB_OFF); ALAS float* bT = (ALAS float*)(L + TAB_OFF + 2048);
    const bf16* QKV = (const bf16*)(F.ws + WS_QKV); const float* SS = (const float*)(F.ws + WS_SS); bf16* ATT = (bf16*)(F.ws + WS_BUFA);
    int tid = F.tid, w = F.wave; asm volatile("" : "+v"(tid), "+s"(w));
    const int lane = tid & 63, g = lane >> 4, i16 = lane & 15;
    __syncthreads();
    if (F.bid < 2560) { const UnitB x0 = decode_b(F.bid); stage_b(L, QKV, x0, 20 + x0.h, w, lane); }
    for (int u = F.bid; u < 2560; u += F.G) {
        const UnitB x = decode_b(u); const int h = x.h, half = x.half, base = x.base, r0 = x.r0, rows = x.rows, kr0 = x.kr0;
        const int col0 = half ? 24 : 0, qoff = 12 + h, voff = 28 + h;
        const int r = r0 + (w >> 1), cb = 2 * half + (w & 1), c = 16 * cb + i16;
        int rs = r - 4; rs = rs < 0 ? 0 : (rs > rows - 8 ? rows - 8 : rs);
        int reg = 16 * cb - 8; reg = reg < 0 ? 0 : (reg > 32 ? 32 : reg); int cs = c - 8; cs = cs < 0 ? 0 : (cs > 48 ? 48 : cs);
        const int q0 = (rs - kr0) * 40 + (reg - col0);
        if (tid < 440) { const int kr = tid / 40, kc = tid - kr * 40; rkT[tid] = rstd_ss(SS, base + (kr0 + kr) * 64 + col0 + kc, 20 + h); }
        bT[tid] = tid < 465 ? F.rpb[h * 465 + tid] * LOG2E : 0.f;
        const int qrow = base + r * 64 + c; const float rq = rstd_ss(SS, qrow, 12 + h) * LOG2E;
        const float* gq_ = F.gqb; const float* gk_ = F.gkb; asm volatile("" : "+s"(gq_), "+s"(gk_));
        bf16x8 qf[4]; load_q(qf, QKV, qrow, qoff, gq_, gk_, g);
        ATT_VMWAIT(); __syncthreads();
        f32x4 s[16];
        unsigned kb[4];
#pragma unroll
        for (int ks = 0; ks < 4; ++ks) kb[ks] = img_off(q0 + i16, 4 * ks + g);
#pragma unroll
        for (int t = 0; t < 16; ++t) { f32x4 acc = {0.f, 0.f, 0.f, 0.f};
#pragma unroll
            for (int ks = 0; ks < 4; ++ks) { const bf16x8 kf = *(const ALAS bf16x8*)(L + (kb[ks] ^ (unsigned)(((t >> 1) & 1) << 7)) + (40 * (t >> 1) + 16 * (t & 1)) * 256); acc = __builtin_amdgcn_mfma_f32_16x16x32_bf16(kf, qf[ks], acc, 0, 0, 0); }
            s[t] = acc; }
        __syncthreads();
        stage_b(L, QKV, x, voff, w, lane);
        float m = -1e30f;
#pragma unroll
        for (int t = 0; t < 16; ++t) { const int i = t >> 1, R0 = q0 + 40 * i + 16 * (t & 1) + 4 * g; const f32x4 rk4 = *(const ALAS f32x4*)(rkT + R0); const int kc0 = reg + 16 * (t & 1) + 4 * g, brow = (rs + i - r + 7) * 31 + 15 - c;
#pragma unroll
            for (int rr = 0; rr < 4; ++rr) { const int kc = kc0 + rr; const bool valid = kc >= cs && kc < cs + 16; int bi = brow + kc; bi = bi < 0 ? 0 : (bi > 464 ? 464 : bi);
                const float v = valid ? s[t][rr] * rq * rk4[rr] + bT[bi] : -1e30f; s[t][rr] = v; m = fmaxf(m, v); } }
        m = fmaxf(m, __shfl_xor(m, 16)); m = fmaxf(m, __shfl_xor(m, 32));
        float l = 0.f;
#pragma unroll
        for (int t = 0; t < 16; ++t)
#pragma unroll
            for (int rr = 0; rr < 4; ++rr) { const float p = __builtin_amdgcn_exp2f(s[t][rr] - m); s[t][rr] = p; l += p; }
        l += __shfl_xor(l, 16); l += __shfl_xor(l, 32);
        bf16x8 pk[8];
#pragma unroll
        for (int kk = 0; kk < 8; ++kk) pk[kk] = pack_p(s[2 * kk], s[2 * kk + 1]);
        ATT_VMWAIT(); __syncthreads();
        f32x4 o[8];
#pragma unroll
        for (int d = 0; d < 8; ++d) o[d] = (f32x4){0.f, 0.f, 0.f, 0.f};
        unsigned tb[8];
#pragma unroll
        for (int d = 0; d < 8; ++d) tb[d] = tr_off(q0 + 4 * g + (i16 >> 2), d, i16);
#pragma unroll
        for (int kk = 0; kk < 8; ++kk) {
#pragma unroll
            for (int d = 0; d < 8; ++d) { const unsigned a = (tb[d] ^ (unsigned)((kk & 1) << 7)) + kk * 40 * 256; const v4i16_t lo = vtr(L + a), hi = vtr(L + a + 4096);
                const bf16x8 vf = {lo[0], lo[1], lo[2], lo[3], hi[0], hi[1], hi[2], hi[3]};
                o[d] = __builtin_amdgcn_mfma_f32_16x16x32_bf16(vf, pk[kk], o[d], 0, 0, 0); } }
        __syncthreads();
        if (u + F.G < 2560) { const UnitB xn = decode_b(u + F.G); stage_b(L, QKV, xn, 20 + xn.h, w, lane); }
        const float inv = 1.0f / l; bf16* op = ATT + (size_t)qrow * D + 1024 + h * 128 + 4 * g;
#pragma unroll
        for (int d = 0; d < 8; ++d) { const unsigned long long v = (unsigned long long)pk2(o[d][0] * inv, o[d][1] * inv) | ((unsigned long long)pk2(o[d][2] * inv, o[d][3] * inv) << 32); *(unsigned long long*)(op + 16 * d) = v; }
    }
    ATT_VMWAIT();
}
}

struct Args { const float* in[17]; float* out; unsigned char* ws; int ph_lo, ph_hi; };
constexpr int N_PHASES = 8;
__global__ void __launch_bounds__(NWAVES * 64, 2) fwd_megakernel(Args args) {
    extern __shared__ __attribute__((aligned(16))) unsigned char lds[];
    cg::grid_group grid = cg::this_grid();
    Frame F;
    F.lds = lds; F.tid = threadIdx.x; F.lane = F.tid & 63; F.wave = __builtin_amdgcn_readfirstlane(F.tid >> 6); F.G = gridDim.x; F.bid = blockIdx.x;
    F.xp = args.in[0]; F.xs = args.in[1]; F.g1 = args.in[2]; F.w_in = args.in[3]; F.gqa = args.in[4]; F.gka = args.in[5]; F.t5 = args.in[6]; F.sink = args.in[7];
    F.gqb = args.in[8]; F.gkb = args.in[9]; F.rpb = args.in[10]; F.wbra = args.in[11]; F.wbrb = args.in[12]; F.wout = args.in[13]; F.g2 = args.in[14]; F.wup = args.in[15]; F.wdn = args.in[16];
    F.out = args.out; F.ws = args.ws;
    unsigned char* ws = args.ws;
    PG8_LAS unsigned char* ldsl = (PG8_LAS unsigned char*)lds;
    const int lo = args.ph_lo, hi = args.ph_hi;
#ifndef PHASE_MASK
#define PHASE_MASK 0xff
#endif
#define IN(k) (((PHASE_MASK >> (k)) & 1) && lo <= (k) && (k) < hi)
#ifdef TSTAMP
    volatile unsigned long long* ts_ = (volatile unsigned long long*)(lds + 139264); int nts_ = 0;
#define STAMP() do { if (F.tid == 0) ts_[nts_] = __builtin_amdgcn_s_memrealtime(); ++nts_; } while (0)
#else
#define STAMP() do {} while (0)
#endif
#define SEAM(k) do { if (IN(k) && IN((k) + 1)) grid.sync(); STAMP(); } while (0)
    bf16* BUFA = (bf16*)(ws + WS_BUFA); bf16* QKV = (bf16*)(ws + WS_QKV); bf16* GATES = (bf16*)(ws + WS_GATES);
    float* SS = (float*)(ws + WS_SS); float* SS2 = (float*)(ws + WS_SS2); float* RSTD2 = (float*)(ws + WS_RSTD2);

    STAMP();
    if (IN(0)) { p0_prologue(F); __syncthreads(); }
    SEAM(0);
    if (IN(1)) {
        pg8::Gemm g{BUFA, (const bf16*)(ws + WS_WIN), M_ROWS, INW, D}; pg8::StaticOrder S; S.init(M_ROWS, INW, F.G, F.bid);
        pg8::EpiProj E{QKV, GATES, SS};
        pg8::gemm_phase<pg8::EpiProj, pg8::StaticOrder, true, true>(ldsl, g, S, E);
    }
    SEAM(1);
#ifdef NAIVE_ATTN
    if (IN(2)) { naive_attention(F); __syncthreads(); }
#else
    if (IN(2)) { att::attn_a(F, (ALAS unsigned char*)lds); att::attn_b(F, (ALAS unsigned char*)lds); __syncthreads(); }
#endif
    SEAM(2);
    if (IN(3)) {
        pg8::Gemm g{BUFA, (const bf16*)(ws + WS_WBR), M_ROWS, D, D}; pg8::StaticOrder S; S.init(M_ROWS, D, F.G, F.bid);
        pg8::EpiMerge E{GATES, QKV};
        pg8::gemm_phase<pg8::EpiMerge, pg8::StaticOrder, true, true>(ldsl, g, S, E);
    }
    SEAM(3);
    if (IN(4)) {
        pg8::Gemm g{QKV, (const bf16*)(ws + WS_WOUT), M_ROWS, D, D}; pg8::StaticOrder S; S.init(M_ROWS, D, F.G, F.bid);
        pg8::EpiOut1 E{F.xp, F.xs, F.out, BUFA, SS2};
        pg8::gemm_phase<pg8::EpiOut1, pg8::StaticOrder, true, true>(ldsl, g, S, E);
    }
    SEAM(4);
    if (IN(5)) {
        for (int m = F.bid * 512 + F.tid; m < M_ROWS; m += F.G * 512) { const f32x4* p = (const f32x4*)(SS2 + (size_t)m * 32); float s = 0.f;
#pragma unroll
            for (int j = 0; j < 8; ++j) { const f32x4 v = p[j]; s += (v.x + v.y) + (v.z + v.w); }
            RSTD2[m] = 1.0f / sqrtf(s * (1.f / D) + EPS); }
    }
    SEAM(5);
    if (IN(6)) {
        pg8::Gemm g{BUFA, (const bf16*)(ws + WS_WUP), M_ROWS, FF, D}; pg8::StaticOrder S; S.init(M_ROWS, FF, F.G, F.bid);
        pg8::EpiUp E{RSTD2, QKV};
        pg8::gemm_phase<pg8::EpiUp, pg8::StaticOrder, true, true>(ldsl, g, S, E);
    }
    SEAM(6);
    if (IN(7)) {
        pg8::Gemm g{QKV, (const bf16*)(ws + WS_WDN), M_ROWS, D, FF}; pg8::StaticOrder S; S.init(M_ROWS, D, F.G, F.bid);
        pg8::EpiDown E{F.out};
        pg8::gemm_phase<pg8::EpiDown, pg8::StaticOrder, true, true>(ldsl, g, S, E);
    }
#ifdef TSTAMP
    grid.sync();
    __syncthreads();
    if (F.bid == 0) { const float spanA = (float)(ts_[TS_A1] - ts_[TS_A0]) * 0.01f, spanB = (float)(ts_[TS_B1] - ts_[TS_B0]) * 0.01f;
        if (F.tid == 0) F.out[8] += 0.1f * spanA;
        for (int i = F.tid; i < 1024; i += 512) F.out[2048 + i] += 0.01f * spanB; }
#endif
#undef IN
#undef SEAM
}


#ifdef SELFCHECK
__device__ __forceinline__ float bf1(const bf16* p) { return __uint_as_float(((unsigned)*p) << 16); }
__device__ __forceinline__ float rbf(float f) { return __uint_as_float(f2bf(f) << 16); }
__global__ void chk_kernel(Args a, int which) {
    const int lane = threadIdx.x, e = blockIdx.x; unsigned char* ws = a.ws; unsigned* flags = (unsigned*)(ws + WS_TAB + 65536);
    const bf16* BUFA = (const bf16*)(ws + WS_BUFA); const bf16* QKV = (const bf16*)(ws + WS_QKV); const bf16* GATES = (const bf16*)(ws + WS_GATES);
    const float* SS = (const float*)(ws + WS_SS); const float* RSTD2 = (const float*)(ws + WS_RSTD2);
    unsigned h1 = (unsigned)e * 2654435761u + 12345u; h1 ^= h1 >> 15; h1 *= 2246822519u; h1 ^= h1 >> 13; h1 *= 3266489917u; h1 ^= h1 >> 16;
    unsigned h2 = ((unsigned)e + 777u) * 2246822519u; h2 ^= h2 >> 13; h2 *= 2654435761u; h2 ^= h2 >> 16; h2 *= 668265263u; h2 ^= h2 >> 15;
    const int row = (int)(h1 % (unsigned)M_ROWS);
    bool bad = false;
    if (which == 0) { const int col = (int)(h2 % (unsigned)INW); float s = 0.f;
        for (int k = lane; k < D; k += 64) s += bf1(BUFA + (size_t)row * D + k) * rbf(a.in[3][(size_t)k * INW + col]);
        s = wave_sum(s);
        float got, ref; if (col < QKVW) { got = bf1(QKV + (size_t)row * QKVW + col); ref = s; } else { got = bf1(GATES + (size_t)row * GW_ + col - QKVW); ref = 1.f / (1.f + expf(-s)); }
        bad = false; if (fabsf(got - ref) > 0.02f + 0.01f * fabsf(ref) && lane == 0) atomicOr(flags, (col < QKVW ? 1u : 2u) | ((col & 7) < 4 ? 4u : 8u) | ((row & 15) < 8 ? 16u : 32u));
    } else if (which == 1) { const int hs = (int)(h2 % 36u); float s = 0.f;
        for (int c = lane; c < 128; c += 64) { const float v = bf1(QKV + (size_t)row * QKVW + hs * 128 + c); s += v * v; }
        s = wave_sum(s); const float* p = SS + ((size_t)row * 36 + hs) * 4; const float got = p[0] + p[1] + p[2] + p[3];
        bad = fabsf(got - s) > 0.02f * s + 1e-3f;
    } else if (which == 2) { const int col = (int)(h2 % (unsigned)D); float ya = 0.f, yb = 0.f;
        for (int k = lane; k < 1024; k += 64) { ya += bf1(BUFA + (size_t)row * D + k) * rbf(a.in[11][(size_t)k * D + col]); yb += bf1(BUFA + (size_t)row * D + 1024 + k) * rbf(a.in[12][(size_t)k * D + col]); }
        ya = wave_sum(ya); yb = wave_sum(yb);
        const float ref = bf1(GATES + (size_t)row * GW_ + col) * ya + bf1(GATES + (size_t)row * GW_ + 2048 + col) * yb; const float got = bf1(QKV + (size_t)row * D + col);
        bad = fabsf(got - ref) > 0.004f + 0.02f * fabsf(ref);
    } else if (which == 3) { const int col = (int)(h2 % (unsigned)D); float s = 0.f;
        for (int k = lane; k < D; k += 64) s += bf1(QKV + (size_t)row * D + k) * rbf(a.in[13][(size_t)k * D + col]);
        s = wave_sum(s); const float xv = row < NP_ROWS ? a.in[0][(size_t)row * D + col] : a.in[1][(size_t)(row - NP_ROWS) * D + col];
        const float ref = xv + s, got = a.out[(size_t)row * D + col], gotb = bf1(BUFA + (size_t)row * D + col);
        bad = fabsf(got - ref) > 0.004f + 0.002f * fabsf(ref) || fabsf(gotb - ref) > 0.004f + 0.01f * fabsf(ref);
    } else if (which == 4) { float s = 0.f;
        for (int k = lane; k < D; k += 64) { const float v = a.out[(size_t)row * D + k]; s += v * v; }
        s = wave_sum(s); const float ref = 1.f / sqrtf(s / D + EPS); bad = fabsf(RSTD2[row] - ref) > 0.001f * ref;
    } else if (which == 5) { const int col = (int)(h2 % (unsigned)FF); float s = 0.f;
        for (int k = lane; k < D; k += 64) s += bf1(BUFA + (size_t)row * D + k) * rbf(a.in[14][k] * a.in[15][(size_t)k * FF + col]);
        s = wave_sum(s) * RSTD2[row]; const float r = fmaxf(s, 0.f) * fmaxf(s, 0.f); const float got = bf1(QKV + (size_t)row * FF + col);
        bad = fabsf(got - r) > 0.01f + 0.03f * fabsf(r);
    }
    else if (which == 8) { const int col = (int)(h2 % (unsigned)D); float s = 0.f;
        for (int k = lane; k < FF; k += 64) s += bf1(QKV + (size_t)row * FF + k) * rbf(a.in[16][(size_t)k * D + col]);
        s = wave_sum(s); const float ref = bf1(BUFA + (size_t)row * D + col) + s, got = a.out[(size_t)row * D + col];
        bad = fabsf(got - ref) > 0.03f + 0.01f * fabsf(ref);
    }
    else if (which == 6 || which == 7) {
        __shared__ float sh_s[320]; __shared__ int sh_k[320];
        const int h = (int)(h2 % 8u); const bool isA = (which == 6); const SeqPos sp = seq_of_row(row);
        const int qoff = isA ? h * 128 : 1536 + h * 128, koff = isA ? 1024 + (h / 4) * 128 : 2560 + h * 128, voff = isA ? 1280 + (h / 4) * 128 : 3584 + h * 128;
        const float* gq = isA ? a.in[4] : a.in[8]; const float* gk = isA ? a.in[5] : a.in[9];
        float qn[2]; { float q0 = bf1(QKV + (size_t)row * QKVW + qoff + lane), q1 = bf1(QKV + (size_t)row * QKVW + qoff + 64 + lane);
            const float ssq = wave_sum(q0 * q0 + q1 * q1); const float r = 1.f / sqrtf(ssq / 128.f + EPS); qn[0] = q0 * r * gq[lane] * 0.08838834764831845f; qn[1] = q1 * r * gq[64 + lane] * 0.08838834764831845f; }
        int nk = 0;
        if (isA) { nk = 257; for (int j = lane; j < 320; j += 64) { const int kt = sp.t - 128 + j; sh_k[j] = (j < 257 && kt >= 0 && kt < sp.L) ? sp.base + kt : -1; } }
        else { nk = 256; const int rows = sp.L / 64, r = sp.t / 64, c = sp.t % 64; int rs = r - 4; if (rs < 0) rs = 0; if (rs > rows - 8) rs = rows - 8; const int cb = c / 16; int reg = cb * 16 - 8; if (reg < 0) reg = 0; if (reg > 32) reg = 32;
            int sc_ = c - 8; if (sc_ < 0) sc_ = 0; if (sc_ > 48) sc_ = 48;
            for (int j = lane; j < 320; j += 64) { const int kc = reg + (j & 31), kr_ = rs + (j >> 5); sh_k[j] = (j < 256 && kc >= sc_ && kc < sc_ + 16) ? sp.base + kr_ * 64 + kc : -1; } }
        __syncthreads();
        for (int j = 0; j < nk; ++j) { const int k = sh_k[j]; float sv = -1e30f;
            if (k >= 0) { const float k0 = bf1(QKV + (size_t)k * QKVW + koff + lane), k1 = bf1(QKV + (size_t)k * QKVW + koff + 64 + lane);
                const float ssk = wave_sum(k0 * k0 + k1 * k1); const float rk = 1.f / sqrtf(ssk / 128.f + EPS);
                float d = wave_sum(qn[0] * k0 * rk * gk[lane] + qn[1] * k1 * rk * gk[64 + lane]);
                float bias;
                if (isA) { const int rel = (k - sp.base) - sp.t; bias = a.in[6][t5_bucket_dev(rel) * 8 + h]; }
                else { const int kt = k - sp.base, kr_ = kt / 64, kc = kt % 64, r = sp.t / 64, c = sp.t % 64; int dcc = kc - c; if (dcc < -15) dcc = -15; if (dcc > 15) dcc = 15; bias = a.in[10][(h * 15 + (kr_ - r + 7)) * 31 + dcc + 15]; }
                sv = d + bias; }
            if (lane == 0) sh_s[j] = sv; }
        __syncthreads();
        float m = -1e30f; for (int j = 0; j < nk; ++j) m = fmaxf(m, sh_s[j]);
        if (isA) m = fmaxf(m, a.in[7][h]);
        float den = 0.f; for (int j = 0; j < nk; ++j) den += expf(sh_s[j] - m);
        if (isA) den += expf(a.in[7][h] - m);
        float o0 = 0.f, o1 = 0.f;
        for (int j = 0; j < nk; ++j) { const int k = sh_k[j]; if (k >= 0) { const float p = expf(sh_s[j] - m) / den; o0 += p * bf1(QKV + (size_t)k * QKVW + voff + lane); o1 += p * bf1(QKV + (size_t)k * QKVW + voff + 64 + lane); } }
        const int oc = isA ? h * 128 : 1024 + h * 128;
        const float g0 = bf1(BUFA + (size_t)row * D + oc + lane), g1 = bf1(BUFA + (size_t)row * D + oc + 64 + lane);
        const bool b2 = fabsf(g0 - o0) > 0.004f + 0.015f * fabsf(o0) || fabsf(g1 - o1) > 0.004f + 0.015f * fabsf(o1);
        bad = __any(b2);
    }
    if (which == 10) { const float* xr = row < NP_ROWS ? a.in[0] + (size_t)row * D : a.in[1] + (size_t)(row - NP_ROWS) * D; float ss = 0.f;
        for (int k = lane; k < D; k += 64) ss += xr[k] * xr[k];
        ss = wave_sum(ss); const float r = 1.f / sqrtf(ss / D + EPS); bool b2 = false;
        for (int k = lane; k < D; k += 64) { const float ref = xr[k] * r * a.in[2][k], got = bf1(BUFA + (size_t)row * D + k); b2 = b2 || fabsf(got - ref) > 0.002f + 0.006f * fabsf(ref); }
        bad = __any(b2); }
    if (lane == 0 && bad && which == 0) atomicOr(flags, 1u << which);
}
__global__ void chk_final(Args a) { const unsigned f = *(const unsigned*)(a.ws + WS_TAB + 65536); const int i = blockIdx.x * 256 + threadIdx.x; if (i < 4096) { a.out[i] += 100.f * (float)f; a.out[4096 + i] += 30.f; } }
#endif
extern "C" void kernel_launch(void* const* d_in, const int* in_sizes, int n_in, void* d_out, int out_size, void* d_ws, size_t ws_size, hipStream_t stream) {
    static int grid = 0;
    if (grid == 0) {
        if (n_in != 17 || in_sizes[0] != NP_ROWS * D || in_sizes[1] != (M_ROWS - NP_ROWS) * D || out_size != M_ROWS * D || ws_size < WS_END) {
            fprintf(stderr, "kernel_launch: shape/workspace mismatch (n_in %d, in0 %d, out %d, ws %zu < %zu); nothing launched\n", n_in, n_in > 0 ? in_sizes[0] : -1, out_size, ws_size, (size_t)WS_END); grid = -1; return; }
        int dev = 0, cus = 0, per_cu = 0;
        if (hipGetDevice(&dev) != hipSuccess || hipDeviceGetAttribute(&cus, hipDeviceAttributeMultiprocessorCount, dev) != hipSuccess) { fprintf(stderr, "kernel_launch: device query failed\n"); grid = -1; return; }
        if (hipFuncSetAttribute((const void*)fwd_megakernel, hipFuncAttributeMaxDynamicSharedMemorySize, LDS_BYTES) != hipSuccess) { fprintf(stderr, "kernel_launch: hipFuncSetAttribute failed\n"); grid = -1; return; }
        if (hipOccupancyMaxActiveBlocksPerMultiprocessor(&per_cu, (const void*)fwd_megakernel, NWAVES * 64, LDS_BYTES) != hipSuccess || per_cu < 1) { fprintf(stderr, "kernel_launch: occupancy query says %d blocks per CU\n", per_cu); per_cu = 1; }
        (void)hipGetLastError();
        grid = cus * 1;
    }
    if (grid < 0) return;
    Args a{};
    for (int i = 0; i < 17; ++i) a.in[i] = (const float*)d_in[i];
    a.out = (float*)d_out; a.ws = (unsigned char*)d_ws;
#if MK_N_LAUNCHES == 1
    a.ph_lo = 0; a.ph_hi = N_PHASES;
    void* kargs[] = {&a};
    hipError_t e = hipLaunchCooperativeKernel((const void*)fwd_megakernel, dim3(grid), dim3(NWAVES * 64), kargs, LDS_BYTES, stream);
    if (e != hipSuccess) fprintf(stderr, "kernel_launch: cooperative launch failed: %s (grid %d)\n", hipGetErrorString(e), grid);
#else
#ifdef SELFCHECK
    hipMemsetAsync((char*)d_ws + WS_TAB + 65536, 0, 64, stream);
#endif
    for (int ph = 0; ph < N_PHASES; ++ph) {
        a.ph_lo = ph; a.ph_hi = ph + 1;
        hipLaunchKernelGGL(fwd_megakernel, dim3(grid), dim3(NWAVES * 64), LDS_BYTES, stream, a);
        const hipError_t le = hipPeekAtLastError();
        if (le != hipSuccess) { fprintf(stderr, "kernel_launch: launch %d failed: %s\n", ph, hipGetErrorName(le)); break; }
#ifdef SELFCHECK
        if (ph == 0) hipLaunchKernelGGL(chk_kernel, dim3(65536), dim3(64), 0, stream, a, 10);
        if (ph == 1) { hipLaunchKernelGGL(chk_kernel, dim3(65536), dim3(64), 0, stream, a, 0); hipLaunchKernelGGL(chk_kernel, dim3(65536), dim3(64), 0, stream, a, 1); }
        if (ph == 2) { hipLaunchKernelGGL(chk_kernel, dim3(65536), dim3(64), 0, stream, a, 6); hipLaunchKernelGGL(chk_kernel, dim3(65536), dim3(64), 0, stream, a, 7); }
        if (ph == 3) hipLaunchKernelGGL(chk_kernel, dim3(65536), dim3(64), 0, stream, a, 2);
        if (ph == 4) hipLaunchKernelGGL(chk_kernel, dim3(65536), dim3(64), 0, stream, a, 3);
        if (ph == 5) hipLaunchKernelGGL(chk_kernel, dim3(65536), dim3(64), 0, stream, a, 4);
        if (ph == 6) hipLaunchKernelGGL(chk_kernel, dim3(65536), dim3(64), 0, stream, a, 5);
        if (ph == 7) { hipLaunchKernelGGL(chk_kernel, dim3(65536), dim3(64), 0, stream, a, 8); }
        if (ph == 7) hipLaunchKernelGGL(chk_final, dim3(16), dim3(256), 0, stream, a);
#endif
    }
#endif
}
```

```cpp
#include <hip/hip_runtime.h>
#include <hip/hip_cooperative_groups.h>
#include <cstdio>
#include <cstdint>
namespace cg = cooperative_groups;
#define MK_N_LAUNCHES 1
namespace pg8 {
#define PG8_LAS __attribute__((address_space(3)))
typedef unsigned short bf16_t;
typedef short bf16x8 __attribute__((ext_vector_type(8)));
typedef float f32x4 __attribute__((ext_vector_type(4)));
typedef unsigned u32x4 __attribute__((ext_vector_type(4)));
constexpr int BM = 256, BK = 64, HALF = 128, HTB = HALF * BK * 2  , STAGE_BYTES = 8 * HTB, NXCD = 8, WGM = 8;

__host__ __device__ __forceinline__ int lds_byte(int r, int c) { const int st = (r >> 4) * 2 + (c >> 5), rr = r & 15, cc = c & 31, ob = rr * 64 + cc * 2; return st * 1024 + (ob ^ (((ob >> 9) & 1) << 5)); }
__host__ __device__ __forceinline__ void stage_rc(int b, int& R, int& C) { const int st = b / 1024, sb = b % 1024, swz = sb ^ (((sb >> 9) & 1) << 5); R = (st >> 1) * 16 + swz / 64; C = (st & 1) * 32 + (swz % 64) / 2; }
__host__ __device__ __forceinline__ int perm32(int rho) { const int n = rho >> 4, i = rho & 15; return 8 * (i >> 2) + 4 * n + (i & 3); }

struct Unit { int pm, pn; };
struct Gemm { const bf16_t* A; const bf16_t* Bt; int M, N, K; };

struct StaticOrder {
    int nM, nN, nwg, G, c;
    __host__ __device__ void init(int M, int N, int G_, int c_) { nM = M / BM; nN = N / BM; nwg = nM * nN; G = G_; c = c_; }
    __host__ __device__ bool next(int i, Unit& u) const {
        const long L = (long)i * G + c; if (L >= nwg) return false;
        int wgid = (int)L; { const int q = nwg / NXCD, r = nwg % NXCD, xcd = wgid % NXCD, off = wgid / NXCD; wgid = (xcd < r ? xcd * (q + 1) : r * (q + 1) + (xcd - r) * q) + off; }
        const int nig = WGM * nN, gid = wgid / nig, fm = gid * WGM, gsz = (nM - fm) < WGM ? (nM - fm) : WGM;
        u.pm = fm + ((wgid % nig) % gsz); u.pn = (wgid % nig) / gsz; return true;
    }
    __device__ __forceinline__ void a_ready(const Unit&) const {}
    __device__ __forceinline__ void done(const Unit&) const {}
};

__device__ __forceinline__ unsigned cvt_pk_bf16(float lo, float hi) { unsigned r; asm volatile("s_nop 0\n\tv_cvt_pk_bf16_f32 %0, %1, %2" : "=v"(r) : "v"(lo), "v"(hi)); return r; }
typedef float f32x2 __attribute__((ext_vector_type(2)));
typedef unsigned u32x2 __attribute__((ext_vector_type(2)));
__device__ __forceinline__ float bf_lo(unsigned w) { return __uint_as_float(w << 16); }
__device__ __forceinline__ float bf_hi(unsigned w) { return __uint_as_float(w & 0xffff0000u); }
__device__ __forceinline__ u32x4 pack8(const f32x4 v0, const f32x4 v1) { u32x4 w; w.x = cvt_pk_bf16(v0[0], v0[1]); w.y = cvt_pk_bf16(v0[2], v0[3]); w.z = cvt_pk_bf16(v1[0], v1[1]); w.w = cvt_pk_bf16(v1[2], v1[3]); return w; }
__device__ __forceinline__ float sigmoidf_(float x) { return __builtin_amdgcn_rcpf(1.0f + __builtin_amdgcn_exp2f(-1.44269504089f * x)); }
constexpr int QKV_LD = 4608, GATE_LD = 4096, DM = 2048, FFD = 8192, NHS = 36, NPROMPT_ROWS = 32768;

struct EpiProj {
    static constexpr bool PERM = true, AFTER_DRAIN = false, MID = false;
    bf16_t* QKV; bf16_t* GATES; float* SS;
    __device__ __forceinline__ void operator()(const f32x4 (&acc)[2][2][4][2], const Unit& u, int wr, int wc, int fr, int fq) const {
        const int row0 = u.pm * BM + wr * 64 + fr;
        if (u.pn < 18) {
            const int col0 = u.pn * BM + wc * 32 + 8 * fq;
#pragma unroll
            for (int ai = 0; ai < 2; ++ai)
#pragma unroll
                for (int m = 0; m < 4; ++m) { const int row = row0 + ai * HALF + m * 16; bf16_t* rowp = QKV + ((size_t)(u.pn * 2) * 40960 + (size_t)row) * 128 + wc * 32 + 8 * fq;
#pragma unroll
                    for (int bj = 0; bj < 2; ++bj) { const f32x4 v0 = acc[ai][bj][m][0], v1 = acc[ai][bj][m][1];
                        float s = (v0[0] * v0[0] + v0[1] * v0[1]) + (v0[2] * v0[2] + v0[3] * v0[3]) + (v1[0] * v1[0] + v1[1] * v1[1]) + (v1[2] * v1[2] + v1[3] * v1[3]);
                        s += __shfl_xor(s, 16); s += __shfl_xor(s, 32);
                        if (fq == 0) SS[((size_t)row * NHS + u.pn * 2 + bj) * 4 + wc] = s;
                        *(u32x4*)(rowp + (size_t)bj * 40960 * 128) = pack8(v0, v1); } }
        } else {
            const int col0 = (u.pn - 18) * BM + wc * 32 + 8 * fq;
#pragma unroll
            for (int ai = 0; ai < 2; ++ai)
#pragma unroll
                for (int m = 0; m < 4; ++m) { const int row = row0 + ai * HALF + m * 16; bf16_t* rowp = GATES + (size_t)row * GATE_LD + col0;
#pragma unroll
                    for (int bj = 0; bj < 2; ++bj) { f32x4 v0 = acc[ai][bj][m][0], v1 = acc[ai][bj][m][1];
#pragma unroll
                        for (int j = 0; j < 4; ++j) { v0[j] = sigmoidf_(v0[j]); v1[j] = sigmoidf_(v1[j]); }
                        *(u32x4*)(rowp + bj * HALF) = pack8(v0, v1); } }
        }
    }
};

struct EpiMerge {
    static constexpr bool PERM = true, AFTER_DRAIN = false, MID = true;
    const bf16_t* GATES; bf16_t* OUT;
    __device__ __forceinline__ void mid(f32x4 (&acc)[2][2][4][2], const Unit& u, int wr, int wc, int fr, int fq) const {
        const int row0 = u.pm * BM + wr * 64 + fr, col0 = u.pn * BM + wc * 32 + 8 * fq;
        const bf16_t* gp0 = GATES + (size_t)row0 * GATE_LD + col0;
        asm volatile("" : "+v"(gp0));
#pragma unroll
        for (int ai = 0; ai < 2; ++ai)
#pragma unroll
            for (int m = 0; m < 4; ++m)
#pragma unroll
                for (int bj = 0; bj < 2; ++bj) { const bf16_t* gp = gp0 + (size_t)(ai * HALF + m * 16) * GATE_LD + bj * HALF;
                    const u32x4 a = *(const u32x4*)gp, b = *(const u32x4*)(gp + DM);
                    f32x4& c0 = acc[ai][bj][m][0]; f32x4& c1 = acc[ai][bj][m][1];
                    c0[0] *= bf_lo(a.x) * __builtin_amdgcn_rcpf(bf_lo(b.x)); c0[1] *= bf_hi(a.x) * __builtin_amdgcn_rcpf(bf_hi(b.x));
                    c0[2] *= bf_lo(a.y) * __builtin_amdgcn_rcpf(bf_lo(b.y)); c0[3] *= bf_hi(a.y) * __builtin_amdgcn_rcpf(bf_hi(b.y));
                    c1[0] *= bf_lo(a.z) * __builtin_amdgcn_rcpf(bf_lo(b.z)); c1[1] *= bf_hi(a.z) * __builtin_amdgcn_rcpf(bf_hi(b.z));
                    c1[2] *= bf_lo(a.w) * __builtin_amdgcn_rcpf(bf_lo(b.w)); c1[3] *= bf_hi(a.w) * __builtin_amdgcn_rcpf(bf_hi(b.w));
                    asm volatile("" ::: "memory"); }
    }
    __device__ __forceinline__ void operator()(const f32x4 (&acc)[2][2][4][2], const Unit& u, int wr, int wc, int fr, int fq) const {
        const int row0 = u.pm * BM + wr * 64 + fr, col0 = u.pn * BM + wc * 32 + 8 * fq;
#pragma unroll
        for (int ai = 0; ai < 2; ++ai)
#pragma unroll
            for (int m = 0; m < 4; ++m) { const size_t row = (size_t)(row0 + ai * HALF + m * 16); const bf16_t* gp = GATES + row * GATE_LD + DM + col0; bf16_t* op = OUT + row * DM + col0;
#pragma unroll
                for (int bj = 0; bj < 2; ++bj) { const u32x4 b = *(const u32x4*)(gp + bj * HALF);
                    f32x4 v0 = acc[ai][bj][m][0], v1 = acc[ai][bj][m][1];
                    v0[0] *= bf_lo(b.x); v0[1] *= bf_hi(b.x); v0[2] *= bf_lo(b.y); v0[3] *= bf_hi(b.y);
                    v1[0] *= bf_lo(b.z); v1[1] *= bf_hi(b.z); v1[2] *= bf_lo(b.w); v1[3] *= bf_hi(b.w);
                    *(u32x4*)(op + bj * HALF) = pack8(v0, v1); }
                asm volatile("" ::: "memory"); }
    }
};

struct EpiOut1 {
    static constexpr bool PERM = true, AFTER_DRAIN = false, MID = false;
    const float* xp; const float* xs; float* OUT; bf16_t* X1B; float* SS2;
    __device__ __forceinline__ void operator()(const f32x4 (&acc)[2][2][4][2], const Unit& u, int wr, int wc, int fr, int fq) const {
        const int row0 = u.pm * BM + wr * 64 + fr, col0 = u.pn * BM + wc * 32 + 8 * fq;
        const float* xb = (u.pm * BM < NPROMPT_ROWS) ? xp : xs - (size_t)NPROMPT_ROWS * DM;
#pragma unroll
        for (int ai = 0; ai < 2; ++ai)
#pragma unroll
            for (int m = 0; m < 4; ++m) { const size_t row = (size_t)(row0 + ai * HALF + m * 16); const float* xr = xb + row * DM + col0; bf16_t* bp = X1B + row * DM + col0;
                float s = 0.f;
#pragma unroll
                for (int bj = 0; bj < 2; ++bj) { const f32x4 v0 = acc[ai][bj][m][0] + *(const f32x4*)(xr + bj * HALF), v1 = acc[ai][bj][m][1] + *(const f32x4*)(xr + bj * HALF + 4);
                    s += (v0[0] * v0[0] + v0[1] * v0[1]) + (v0[2] * v0[2] + v0[3] * v0[3]) + (v1[0] * v1[0] + v1[1] * v1[1]) + (v1[2] * v1[2] + v1[3] * v1[3]);
                    *(u32x4*)(bp + bj * HALF) = pack8(v0, v1); }
                s += __shfl_xor(s, 16); s += __shfl_xor(s, 32);
                if (fq == 0) SS2[row * 32 + u.pn * 4 + wc] = s;
                asm volatile("" ::: "memory"); }
    }
};

struct EpiUp {
    static constexpr bool PERM = true, AFTER_DRAIN = false, MID = false;
    const float* RSTD2; bf16_t* U;
    __device__ __forceinline__ void operator()(const f32x4 (&acc)[2][2][4][2], const Unit& u, int wr, int wc, int fr, int fq) const {
        const int row0 = u.pm * BM + wr * 64 + fr, col0 = u.pn * BM + wc * 32 + 8 * fq;
#pragma unroll
        for (int ai = 0; ai < 2; ++ai)
#pragma unroll
            for (int m = 0; m < 4; ++m) { const size_t row = (size_t)(row0 + ai * HALF + m * 16); const float rs = RSTD2[row]; bf16_t* op = U + row * FFD + col0;
#pragma unroll
                for (int bj = 0; bj < 2; ++bj) { f32x4 v0 = acc[ai][bj][m][0] * rs, v1 = acc[ai][bj][m][1] * rs;
#pragma unroll
                    for (int j = 0; j < 4; ++j) { const float a = fmaxf(v0[j], 0.f), b = fmaxf(v1[j], 0.f); v0[j] = a * a; v1[j] = b * b; }
                    *(u32x4*)(op + bj * HALF) = pack8(v0, v1); } }
    }
};

struct EpiDown {
    static constexpr bool PERM = true, AFTER_DRAIN = false, MID = false;
    float* OUT; const bf16_t* X1B;
    __device__ __forceinline__ void operator()(const f32x4 (&acc)[2][2][4][2], const Unit& u, int wr, int wc, int fr, int fq) const {
        const int row0 = u.pm * BM + wr * 64 + fr, col0 = u.pn * BM + wc * 32 + 8 * fq;
#pragma unroll
        for (int ai = 0; ai < 2; ++ai)
#pragma unroll
            for (int m = 0; m < 4; ++m) { float* op = OUT + (size_t)(row0 + ai * HALF + m * 16) * DM + col0; const bf16_t* xp_ = X1B + (size_t)(row0 + ai * HALF + m * 16) * DM + col0;
#pragma unroll
                for (int bj = 0; bj < 2; ++bj) { const u32x4 xw = *(const u32x4*)(xp_ + bj * HALF); f32x4 v0 = acc[ai][bj][m][0], v1 = acc[ai][bj][m][1];
                    v0[0] += bf_lo(xw.x); v0[1] += bf_hi(xw.x); v0[2] += bf_lo(xw.y); v0[3] += bf_hi(xw.y); v1[0] += bf_lo(xw.z); v1[1] += bf_hi(xw.z); v1[2] += bf_lo(xw.w); v1[3] += bf_hi(xw.w);
                    *(f32x4*)(op + bj * HALF) = v0; *(f32x4*)(op + bj * HALF + 4) = v1; }
                asm volatile("" ::: "memory"); }
    }
};

template <class Epi, class Sched, bool ALIGN_EPI = false, bool SP2 = false>
__device__ __forceinline__ void gemm_phase(PG8_LAS unsigned char* lds, const Gemm g, const Sched& S, const Epi& E) {
    const int tid = threadIdx.x, wid = __builtin_amdgcn_readfirstlane(tid >> 6), lane = tid & 63, wr = wid >> 2, wc = wid & 3, fr = lane & 15, fq = lane >> 4;
    const int K = g.K, nt = K / BK;
    unsigned voffA[2], voffB[2];
#pragma unroll
    for (int i = 0; i < 2; ++i) { int R, C; stage_rc(tid * 16 + i * 8192, R, C); const int Rb = Epi::PERM ? ((R & ~31) + perm32(R & 31)) : R;
        voffA[i] = (unsigned)(R * K + C) * 2u; voffB[i] = (unsigned)(Rb * K + C) * 2u; }
    const size_t kstep = (size_t)(BK * 2);
    const size_t hstep = (size_t)HALF * K * 2;
    const size_t tstep = 2 * hstep;
    const unsigned ldsw = (unsigned)wid * 1024u;
    const int aoff = lds_byte(wr * 64 + fr, fq * 8), boff = lds_byte(wc * 32 + fr, fq * 8);
#define PG8_SA(b, h) (((b) * 2 + (h)) * HTB)
#define PG8_SB(b, h) ((4 + (b) * 2 + (h)) * HTB)
#define PG8_STAGE(bufoff, gbase, voff) do { _Pragma("unroll") for (int _i = 0; _i < 2; ++_i) \
        __builtin_amdgcn_global_load_lds((const unsigned*)((const char*)(gbase) + (voff)[_i]), (PG8_LAS unsigned*)(lds + (bufoff) + ldsw + _i * 8192), 16, 0, 0); } while (0)
#define PG8_LDA(dst, b, h) do { _Pragma("unroll") for (int m = 0; m < 4; ++m) _Pragma("unroll") for (int k = 0; k < 2; ++k) dst[m][k] = *(const PG8_LAS bf16x8*)(lds + PG8_SA(b, h) + aoff + m * 2048 + k * 1024); } while (0)
#define PG8_LDB(dst, b, h) do { _Pragma("unroll") for (int n = 0; n < 2; ++n) _Pragma("unroll") for (int k = 0; k < 2; ++k) dst[n][k] = *(const PG8_LAS bf16x8*)(lds + PG8_SB(b, h) + boff + n * 2048 + k * 1024); } while (0)
#define PG8_MMA(ai, bj, At, Bt) do { __builtin_amdgcn_s_setprio(1); _Pragma("unroll") for (int m = 0; m < 4; ++m) _Pragma("unroll") for (int n = 0; n < 2; ++n) _Pragma("unroll") for (int k = 0; k < 2; ++k) \
        acc[ai][bj][m][n] = __builtin_amdgcn_mfma_f32_16x16x32_bf16(Bt[n][k], At[m][k], acc[ai][bj][m][n], 0, 0, 0); __builtin_amdgcn_s_setprio(0); } while (0)
#define PG8_WAIT_V(n) asm volatile("s_waitcnt vmcnt(" #n ")" ::: "memory")
#define PG8_WAIT_L(n) asm volatile("s_waitcnt lgkmcnt(" #n ")" ::: "memory")
#define PG8_BAR __builtin_amdgcn_s_barrier()
#define PG8_SCHED __builtin_amdgcn_sched_barrier(0)
    Unit cur, nxt; int ui = 0;
    if (!S.next(0, cur)) return;
    f32x4 acc[2][2][4][2];
#pragma unroll
    for (int a = 0; a < 2; ++a)
#pragma unroll
        for (int b = 0; b < 2; ++b)
#pragma unroll
            for (int m = 0; m < 4; ++m)
#pragma unroll
                for (int n = 0; n < 2; ++n) acc[a][b][m][n] = (f32x4){0.f, 0.f, 0.f, 0.f};
    bf16x8 At[4][2], B0[2][2], B1[2][2];
    const char* cA = (const char*)g.A + (size_t)cur.pm * tstep; const char* cB = (const char*)g.Bt + (size_t)cur.pn * tstep;
    S.a_ready(cur);
    if constexpr (SP2) {
        PG8_STAGE(PG8_SB(0, 0), cB, voffB); PG8_STAGE(PG8_SB(0, 1), cB + hstep, voffB); PG8_STAGE(PG8_SA(0, 0), cA, voffA); PG8_STAGE(PG8_SA(0, 1), cA + hstep, voffA);
        if (wr == 1) PG8_BAR;
        PG8_WAIT_V(2); PG8_BAR;
        PG8_STAGE(PG8_SB(1, 0), cB + kstep, voffB); PG8_STAGE(PG8_SA(1, 0), cA + kstep, voffA); PG8_STAGE(PG8_SB(1, 1), cB + hstep + kstep, voffB);
        PG8_WAIT_V(6); PG8_BAR;
    } else {
        PG8_STAGE(PG8_SB(0, 0), cB, voffB); PG8_STAGE(PG8_SA(0, 0), cA, voffA); PG8_STAGE(PG8_SB(0, 1), cB + hstep, voffB); PG8_STAGE(PG8_SA(0, 1), cA + hstep, voffA);
        if (wr == 1) PG8_BAR;
        PG8_WAIT_V(4); PG8_BAR;
        PG8_STAGE(PG8_SB(1, 0), cB + kstep, voffB); PG8_STAGE(PG8_SA(1, 0), cA + kstep, voffA); PG8_STAGE(PG8_SB(1, 1), cB + hstep + kstep, voffB);
        PG8_WAIT_V(6); PG8_BAR;
    }
    for (;;) {
        const bool has_next = S.next(ui + 1, nxt);
        const char* nA = has_next ? (const char*)g.A + (size_t)nxt.pm * tstep : cA; const char* nB = has_next ? (const char*)g.Bt + (size_t)nxt.pn * tstep : cB;
        constexpr int NSEG = Epi::MID ? 2 : 1; const int seglen = nt / NSEG;
        for (int seg = 0; seg < NSEG; ++seg) {
        if constexpr (Epi::MID) { if (seg == 1) E.mid(acc, cur, wr, wc, fr, fq); }
        for (int t = seg * seglen; t < (seg + 1) * seglen; t += 2) {
            const bool last = (t == nt - 2);
            const char* a1 = cA + (size_t)(t + 1) * kstep;
            const char* a2 = last ? nA : cA + (size_t)(t + 2) * kstep; const char* b2 = last ? nB : cB + (size_t)(t + 2) * kstep;
            const char* a3 = a2 + kstep; const char* b3 = b2 + kstep;
            if (last && has_next) S.a_ready(nxt);
            if constexpr (SP2) {
            PG8_LDB(B0, 0, 0); PG8_LDB(B1, 0, 1); PG8_SCHED; PG8_LDA(At, 0, 0); PG8_STAGE(PG8_SA(1, 1), a1 + hstep, voffA);
            PG8_WAIT_V(8); PG8_WAIT_L(0); PG8_BAR; PG8_MMA(0, 0, At, B0); PG8_MMA(0, 1, At, B1); PG8_BAR; PG8_SCHED;
            PG8_LDA(At, 0, 1); PG8_STAGE(PG8_SB(0, 0), b2, voffB); PG8_STAGE(PG8_SB(0, 1), b2 + hstep, voffB); PG8_STAGE(PG8_SA(0, 0), a2, voffA);
            PG8_WAIT_V(8); PG8_WAIT_L(0); PG8_BAR; PG8_MMA(1, 0, At, B0); PG8_MMA(1, 1, At, B1); PG8_BAR; PG8_SCHED;
            PG8_LDB(B0, 1, 0); PG8_LDB(B1, 1, 1); PG8_SCHED; PG8_LDA(At, 1, 0); PG8_STAGE(PG8_SA(0, 1), a2 + hstep, voffA);
            PG8_WAIT_V(8); PG8_WAIT_L(0); PG8_BAR; PG8_MMA(0, 0, At, B0); PG8_MMA(0, 1, At, B1); PG8_BAR; PG8_SCHED;
            PG8_LDA(At, 1, 1); PG8_STAGE(PG8_SB(1, 0), b3, voffB); PG8_STAGE(PG8_SB(1, 1), b3 + hstep, voffB); PG8_STAGE(PG8_SA(1, 0), a3, voffA);
            PG8_WAIT_V(8); PG8_WAIT_L(0); PG8_BAR; PG8_MMA(1, 0, At, B0); PG8_MMA(1, 1, At, B1); PG8_BAR; PG8_SCHED;
            } else {
            PG8_LDB(B0, 0, 0); PG8_SCHED; PG8_LDA(At, 0, 0); PG8_STAGE(PG8_SA(1, 1), a1 + hstep, voffA);
            PG8_WAIT_L(8); PG8_BAR; PG8_WAIT_L(0); PG8_MMA(0, 0, At, B0); PG8_BAR; PG8_SCHED;
            PG8_LDB(B1, 0, 1); PG8_STAGE(PG8_SB(0, 0), b2, voffB);
            PG8_BAR; PG8_WAIT_L(0); PG8_MMA(0, 1, At, B1); PG8_BAR;
            PG8_LDA(At, 0, 1); PG8_STAGE(PG8_SA(0, 0), a2, voffA);
            PG8_BAR; PG8_WAIT_L(0); PG8_MMA(1, 0, At, B0); PG8_BAR; PG8_SCHED;
            PG8_STAGE(PG8_SB(0, 1), b2 + hstep, voffB);
            PG8_WAIT_V(6); PG8_BAR; PG8_MMA(1, 1, At, B1); PG8_BAR;
            PG8_LDB(B0, 1, 0); PG8_SCHED; PG8_LDA(At, 1, 0); PG8_STAGE(PG8_SA(0, 1), a2 + hstep, voffA);
            PG8_WAIT_L(8); PG8_BAR; PG8_WAIT_L(0); PG8_MMA(0, 0, At, B0); PG8_BAR; PG8_SCHED;
            PG8_LDB(B1, 1, 1); PG8_STAGE(PG8_SB(1, 0), b3, voffB);
            PG8_BAR; PG8_WAIT_L(0); PG8_MMA(0, 1, At, B1); PG8_BAR;
            PG8_LDA(At, 1, 1); PG8_STAGE(PG8_SA(1, 0), a3, voffA);
            PG8_BAR; PG8_WAIT_L(0); PG8_MMA(1, 0, At, B0); PG8_BAR; PG8_SCHED;
            PG8_STAGE(PG8_SB(1, 1), b3 + hstep, voffB);
            PG8_WAIT_V(6); PG8_BAR; PG8_MMA(1, 1, At, B1); PG8_BAR;
            }
        }
        }
        if constexpr (ALIGN_EPI) { if (wr == 0) PG8_BAR; }
        if constexpr (!Epi::AFTER_DRAIN) { E(acc, cur, wr, wc, fr, fq); S.done(cur); }
        if (!has_next) break;
#pragma unroll
        for (int a = 0; a < 2; ++a)
#pragma unroll
            for (int b = 0; b < 2; ++b)
#pragma unroll
                for (int m = 0; m < 4; ++m)
#pragma unroll
                    for (int n = 0; n < 2; ++n) acc[a][b][m][n] = (f32x4){0.f, 0.f, 0.f, 0.f};
        cur = nxt; cA = nA; cB = nB; ++ui;
        if constexpr (ALIGN_EPI) { if (wr == 1) PG8_BAR; }
    }
    PG8_WAIT_V(0);
    if constexpr (!ALIGN_EPI) { if (wr == 0) PG8_BAR; }
    PG8_BAR;
    if constexpr (Epi::AFTER_DRAIN) { E.fused(acc, cur, wr, wc, fr, fq, lds, wid, lane); S.done(cur); }
#undef PG8_SA
#undef PG8_SB
#undef PG8_STAGE
#undef PG8_LDA
#undef PG8_LDB
#undef PG8_MMA
#undef PG8_WAIT_V
#undef PG8_WAIT_L
#undef PG8_BAR
#undef PG8_SCHED
}
}
#ifndef MK_N_LAUNCHES
#define MK_N_LAUNCHES 1
#endif
constexpr int NWAVES = 8;
constexpr int M_ROWS = 40960, NP_ROWS = 32768, D = 2048, FF = 8192, INW = 8704, QKVW = 4608, GW_ = 4096, HD = 128;
constexpr float EPS = 1e-6f;
constexpr size_t MiB = 1u << 20;
constexpr size_t WS_TAB = 0;
constexpr size_t WS_BAR = 128 * 1024;
constexpr size_t WS_RSTD2 = 1 * MiB;
constexpr size_t WS_SS2 = 2 * MiB;
constexpr size_t WS_SS = 8 * MiB;
constexpr size_t WS_WIN = 32 * MiB;
constexpr size_t WS_WBR = 66 * MiB;
constexpr size_t WS_WOUT = 74 * MiB;
constexpr size_t WS_WUP = 82 * MiB;
constexpr size_t WS_WDN = 114 * MiB;
constexpr size_t WS_BUFA = 146 * MiB;
constexpr size_t WS_QKV = 306 * MiB;
constexpr size_t WS_GATES = 666 * MiB;
constexpr size_t WS_END = 986 * MiB;
constexpr int LDS_BYTES = 147456;

#define LAS __attribute__((address_space(3)))
typedef unsigned short bf16;
typedef unsigned v4u __attribute__((ext_vector_type(4)));
typedef float f32x4 __attribute__((ext_vector_type(4)));
#define LDS_WAIT() asm volatile("s_waitcnt lgkmcnt(0)" ::: "memory")
__device__ __forceinline__ unsigned f2bf(float f) { unsigned u = __builtin_bit_cast(unsigned, f); return (u + 0x7fffu + ((u >> 16) & 1u)) >> 16; }
__device__ __forceinline__ unsigned pk2(float lo, float hi) { return f2bf(lo) | (f2bf(hi) << 16); }
__device__ __forceinline__ float bflo(unsigned w) { return __uint_as_float(w << 16); }
__device__ __forceinline__ float bfhi(unsigned w) { return __uint_as_float(w & 0xffff0000u); }
__device__ __forceinline__ float wave_sum(float v) {
#pragma unroll
    for (int o = 1; o < 64; o <<= 1) v += __shfl_xor(v, o);
    return v;
}
__device__ __forceinline__ float wave_max(float v) {
#pragma unroll
    for (int o = 1; o < 64; o <<= 1) v = fmaxf(v, __shfl_xor(v, o));
    return v;
}
__device__ __forceinline__ void wave_sync() { __builtin_amdgcn_fence(__ATOMIC_RELEASE, "wavefront"); __builtin_amdgcn_wave_barrier(); __builtin_amdgcn_fence(__ATOMIC_ACQUIRE, "wavefront"); }

__device__ __forceinline__ int t5_bucket_dev(int rel) {
    const int n = rel < 0 ? -rel : rel;
    const int b = n < 8 ? n : 8 + (n >= 12) + (n >= 16) + (n >= 23) + (n >= 32) + (n >= 46) + (n >= 64) + (n >= 91);
    return b + (rel > 0 ? 16 : 0);
}

struct Frame {
    unsigned char* lds; int tid, lane, wave, G, bid;
    const float *xp, *xs, *g1, *w_in, *gqa, *gka, *t5, *sink, *gqb, *gkb, *rpb, *wbra, *wbrb, *wout, *g2, *wup, *wdn;
    float* out; unsigned char* ws;
};
__device__ __forceinline__ const float* xrow_ptr(const Frame& F, int m) { return m < NP_ROWS ? F.xp + (size_t)m * D : F.xs + (size_t)(m - NP_ROWS) * D; }

__device__ __forceinline__ void p0_transpose_item(const float* W, int K, int N, bf16* WT, int ldk, int koff, const float* kscale, float* scr, int item, int lane) {
    const int nblk = N / 32, kb = item / nblk, nb = item % nblk, k0 = 64 * kb, n0 = 32 * nb;
    float wv[32];
#pragma unroll
    for (int i = 0; i < 32; ++i) { const int kk = 2 * i + (lane >> 5); wv[i] = W[(size_t)(k0 + kk) * N + n0 + (lane & 31)]; }
#pragma unroll
    for (int i = 0; i < 32; ++i) { const int kk = 2 * i + (lane >> 5); float w = wv[i]; if (kscale) w *= kscale[k0 + kk]; scr[kk * 33 + (lane & 31)] = w; }
    wave_sync();
    const int c = lane & 7;
#pragma unroll
    for (int j = 0; j < 4; ++j) { const int n = (lane >> 3) + 8 * j; const float* s = scr + (8 * c) * 33 + n;
        v4u o; o.x = pk2(s[0 * 33], s[1 * 33]); o.y = pk2(s[2 * 33], s[3 * 33]); o.z = pk2(s[4 * 33], s[5 * 33]); o.w = pk2(s[6 * 33], s[7 * 33]);
        *(v4u*)(WT + (size_t)(n0 + n) * ldk + koff + k0 + 8 * c) = o; }
    wave_sync();
}
__device__ __forceinline__ void p0_prologue(Frame& F) {
    float* scr = (float*)(F.lds + F.wave * 16384);
    const int gw = F.bid * NWAVES + F.wave, NGW = F.G * NWAVES;
    constexpr int I_IN = (D / 64) * (INW / 32), I_BR = (1024 / 64) * (D / 32), I_OUT = (D / 64) * (D / 32), I_UP = (D / 64) * (FF / 32), I_DN = (FF / 64) * (D / 32);
    constexpr int NITEMS = I_IN + 2 * I_BR + I_OUT + I_UP + I_DN;
    for (int it = gw; it < NITEMS; it += NGW) {
        int r = it;
        if (r < I_IN) { p0_transpose_item(F.w_in, D, INW, (bf16*)(F.ws + WS_WIN), D, 0, nullptr, scr, r, F.lane); continue; } r -= I_IN;
        if (r < I_BR) { p0_transpose_item(F.wbra, 1024, D, (bf16*)(F.ws + WS_WBR), D, 0, nullptr, scr, r, F.lane); continue; } r -= I_BR;
        if (r < I_BR) { p0_transpose_item(F.wbrb, 1024, D, (bf16*)(F.ws + WS_WBR), D, 1024, nullptr, scr, r, F.lane); continue; } r -= I_BR;
        if (r < I_OUT) { p0_transpose_item(F.wout, D, D, (bf16*)(F.ws + WS_WOUT), D, 0, nullptr, scr, r, F.lane); continue; } r -= I_OUT;
        if (r < I_UP) { p0_transpose_item(F.wup, D, FF, (bf16*)(F.ws + WS_WUP), D, 0, F.g2, scr, r, F.lane); continue; } r -= I_UP;
        p0_transpose_item(F.wdn, FF, D, (bf16*)(F.ws + WS_WDN), FF, 0, nullptr, scr, r, F.lane);
    }
    bf16* H = (bf16*)(F.ws + WS_BUFA);
    for (int m = gw; m < M_ROWS; m += NGW) {
        const f32x4* xr = (const f32x4*)xrow_ptr(F, m) + F.lane; f32x4 v[8]; float s = 0.f;
#pragma unroll
        for (int j = 0; j < 8; ++j) { v[j] = xr[64 * j]; s += (v[j].x * v[j].x + v[j].y * v[j].y) + (v[j].z * v[j].z + v[j].w * v[j].w); }
        const float rstd = 1.0f / sqrtf(wave_sum(s) * (1.f / D) + EPS);
        unsigned long long* o8 = (unsigned long long*)(H + (size_t)m * D) + F.lane; const f32x4* gp = (const f32x4*)F.g1 + F.lane;
#pragma unroll
        for (int j = 0; j < 8; ++j) { const f32x4 g = gp[64 * j]; o8[64 * j] = (unsigned long long)pk2(v[j].x * rstd * g.x, v[j].y * rstd * g.y) | ((unsigned long long)pk2(v[j].z * rstd * g.z, v[j].w * rstd * g.w) << 32); }
    }
    float* BA = (float*)(F.ws + WS_TAB);
    for (int i = F.bid * 512 + F.tid; i < 8 * 257; i += F.G * 512) { const int h = i / 257, rel = i % 257 - 128; BA[i] = F.t5[t5_bucket_dev(rel) * 8 + h]; }
}

struct SeqPos { int base, t, L; };
__device__ __forceinline__ SeqPos seq_of_row(int row) { SeqPos p; if (row < NP_ROWS) { p.base = row & ~4095; p.t = row & 4095; p.L = 4096; } else { const int r2 = row - NP_ROWS; p.base = NP_ROWS + (r2 & ~2047); p.t = r2 & 2047; p.L = 2048; } return p; }
__device__ __forceinline__ float rstd_ss(const float* SS, int row, int hs) { const f32x4 p = *(const f32x4*)(SS + ((size_t)row * 36 + hs) * 4); return 1.0f / sqrtf(((p.x + p.y) + (p.z + p.w)) * (1.f / HD) + EPS); }
__device__ __forceinline__ void naive_core(const Frame& F, float* qs, float* sc, int* kr, int nk, int row, int qoff, int koff, int voff, int hsq, int hsk, const float* gq, const float* gk, bool has_sink, float sinkv, int outcol) {
    const bf16* QKV = (const bf16*)(F.ws + WS_QKV); const float* SS = (const float*)(F.ws + WS_SS); bf16* ATT = (bf16*)(F.ws + WS_BUFA);
    const int lane = F.lane;
    { const unsigned w = *(const unsigned*)(QKV + (size_t)row * QKVW + qoff + 2 * lane); const float sc0 = 0.08838834764831845f;
      qs[2 * lane] = bflo(w) * gq[2 * lane] * gk[2 * lane] * sc0; qs[2 * lane + 1] = bfhi(w) * gq[2 * lane + 1] * gk[2 * lane + 1] * sc0; }
    const float rq = rstd_ss(SS, row, hsq);
    wave_sync();
    float sv[5]; float mx = -1e30f;
#pragma unroll
    for (int i = 0; i < 5; ++i) { const int j = lane + 64 * i; float s = -1e30f;
        if (j < nk && kr[j] >= 0) { const int k = kr[j]; const float rk = rstd_ss(SS, k, hsk); const v4u* kp = (const v4u*)(QKV + (size_t)k * QKVW + koff); float dot = 0.f;
            for (int c = 0; c < 16; ++c) { const v4u w = kp[c]; const float* q = qs + 8 * c;
                dot += q[0] * bflo(w.x) + q[1] * bfhi(w.x) + q[2] * bflo(w.y) + q[3] * bfhi(w.y) + q[4] * bflo(w.z) + q[5] * bfhi(w.z) + q[6] * bflo(w.w) + q[7] * bfhi(w.w); }
            s = dot * rq * rk + sc[j]; }
        sv[i] = s; mx = fmaxf(mx, s); }
    mx = wave_max(mx); if (has_sink) mx = fmaxf(mx, sinkv);
    float sum = 0.f;
#pragma unroll
    for (int i = 0; i < 5; ++i) { sv[i] = __expf(sv[i] - mx); sum += sv[i]; }
    sum = wave_sum(sum); if (has_sink) sum += __expf(sinkv - mx);
    const float inv = 1.0f / sum;
    wave_sync();
#pragma unroll
    for (int i = 0; i < 5; ++i) sc[lane + 64 * i] = sv[i] * inv;
    wave_sync();
    float a0 = 0.f, a1 = 0.f;
    for (int j = 0; j < nk; ++j) { const int k = kr[j]; if (k >= 0) { const float p = sc[j]; const unsigned w = *(const unsigned*)(QKV + (size_t)k * QKVW + voff + 2 * lane); a0 += p * bflo(w); a1 += p * bfhi(w); } }
    *(unsigned*)(ATT + (size_t)row * D + outcol + 2 * lane) = pk2(a0, a1);
    wave_sync();
}
__device__ __forceinline__ void naive_attention(Frame& F) {
    float* qs = (float*)(F.lds + F.wave * 4096); float* sc = qs + 128; int* kr = (int*)(sc + 320);
    const float* BA = (const float*)(F.ws + WS_TAB);
    const int gw = F.bid * NWAVES + F.wave, NGW = F.G * NWAVES, lane = F.lane;
    for (int it = gw; it < M_ROWS * 16; it += NGW) {
        const int row = it >> 4, hh = it & 15; const SeqPos sp = seq_of_row(row);
#ifdef PROBE_ZERO
        if ((PROBE_ZERO == 3) || (PROBE_ZERO == 1 && hh < 8) || (PROBE_ZERO == 2 && hh >= 8)) { *(unsigned*)((bf16*)(F.ws + WS_BUFA) + (size_t)row * D + hh * 128 + 2 * lane) = 0u; continue; }
#endif
        if (hh < 8) {
            const int h = hh, hk = h >> 2;
#pragma unroll
            for (int i = 0; i < 5; ++i) { const int j = lane + 64 * i; const int kt = sp.t - 128 + j; const bool ok = (j < 257) && kt >= 0 && kt < sp.L; kr[j] = ok ? sp.base + kt : -1; sc[j] = ok ? F.t5[t5_bucket_dev(j - 128) * 8 + h] : 0.f; }
            wave_sync();
            naive_core(F, qs, sc, kr, 257, row, h * 128, 1024 + hk * 128, 1280 + hk * 128, h, 8 + hk, F.gqa, F.gka, true, F.sink[h], h * 128);
        } else {
            const int h = hh - 8, rows = sp.L >> 6, r = sp.t >> 6, c = sp.t & 63;
            int rs = r - 4; rs = rs < 0 ? 0 : (rs > rows - 8 ? rows - 8 : rs);
            int cs = c - 8; cs = cs < 0 ? 0 : (cs > 48 ? 48 : cs);
#pragma unroll
            for (int i = 0; i < 5; ++i) { const int j = lane + 64 * i; const int kr_ = rs + (j >> 4), kc = cs + (j & 15); const bool ok = j < 128;
                int dcc = kc - c; dcc = (dcc < -15 ? -15 : (dcc > 15 ? 15 : dcc)) + 15; const int dr = kr_ - r + 7;
                kr[j] = ok ? sp.base + kr_ * 64 + kc : -1; sc[j] = ok ? F.rpb[(h * 15 + dr) * 31 + dcc] : 0.f; }
            wave_sync();
            naive_core(F, qs, sc, kr, 128, row, 1536 + h * 128, 2560 + h * 128, 3584 + h * 128, 12 + h, 20 + h, F.gqb, F.gkb, false, 0.f, 1024 + h * 128);
        }
    }
}


namespace att {
#define ALAS __attribute__((address_space(3)))
typedef short bf16x8 __attribute__((ext_vector_type(8)));
typedef short v4i16_t __attribute__((ext_vector_type(4)));
constexpr int TAB_OFF = 131072;
constexpr float LOG2E = 1.4426950408889634f;
__device__ __forceinline__ size_t hm(int hs, int row) { return ((size_t)hs * M_ROWS + (size_t)row) * 128; }
__device__ __forceinline__ unsigned img_off(int row, int chunk) { return (unsigned)(row * 256 + (((chunk ^ row) & 15) << 4)); }
__device__ __forceinline__ v4i16_t vtr(const ALAS unsigned char* p) { return __builtin_amdgcn_ds_read_tr16_b64_v4i16((ALAS v4i16_t*)p); }
__device__ __forceinline__ unsigned tr_off(int row, int dt, int i16) { const int ch = 2 * dt + ((i16 & 3) >> 1); return (unsigned)(row * 256 + (((ch ^ row) & 15) << 4) + (i16 & 1) * 8); }
__device__ __forceinline__ void load_q(bf16x8 (&qf)[4], const bf16* QKV, int qrow, int qhs, const float* gq, const float* gk, int g) {
#pragma unroll
    for (int ks = 0; ks < 4; ++ks) { const int d0 = 32 * ks + 8 * g; const v4u w = *(const v4u*)(QKV + hm(qhs, qrow) + d0);
        const f32x4 a0 = *(const f32x4*)(gq + d0), a1 = *(const f32x4*)(gq + d0 + 4), b0 = *(const f32x4*)(gk + d0), b1 = *(const f32x4*)(gk + d0 + 4); const float c = 0.08838834764831845f;
        v4u o; o.x = pk2(bflo(w.x) * a0.x * b0.x * c, bfhi(w.x) * a0.y * b0.y * c); o.y = pk2(bflo(w.y) * a0.z * b0.z * c, bfhi(w.y) * a0.w * b0.w * c);
        o.z = pk2(bflo(w.z) * a1.x * b1.x * c, bfhi(w.z) * a1.y * b1.y * c); o.w = pk2(bflo(w.w) * a1.z * b1.z * c, bfhi(w.w) * a1.w * b1.w * c);
        qf[ks] = __builtin_bit_cast(bf16x8, o); }
}
__device__ __forceinline__ bf16x8 pack_p(const f32x4 a, const f32x4 b) { v4u o; o.x = pk2(a[0], a[1]); o.y = pk2(a[2], a[3]); o.z = pk2(b[0], b[1]); o.w = pk2(b[2], b[3]); return __builtin_bit_cast(bf16x8, o); }

#define ATT_DMA(src, q) __builtin_amdgcn_global_load_lds((const unsigned*)(src), (ALAS unsigned*)(L + (q) * 1024), 16, 0, 0)
#define ATT_VMWAIT() asm volatile("s_waitcnt vmcnt(0)" ::: "memory")
struct UnitA { int base, n, Ls, h; };
__device__ __forceinline__ UnitA decode_a(int u) { UnitA x; x.h = u & 7; const int blk = u >> 3;
    if (blk < 256) { x.base = (blk >> 5) * 4096; x.n = blk & 31; x.Ls = 4096; } else { const int b2 = blk - 256; x.base = NP_ROWS + (b2 >> 4) * 2048; x.n = b2 & 15; x.Ls = 2048; } return x; }
__device__ __forceinline__ void stage_a(ALAS unsigned char* L, const bf16* QKV, const UnitA& x, int off, int w, int lane) {
    const int rl = lane >> 4, p = lane & 15, kpos0 = x.n * 128 - 128;
#pragma unroll
    for (int j = 0; j < 12; ++j) { const int q = w + 8 * j, row = 4 * q + rl; int kp = kpos0 + row; kp = kp < 0 ? 0 : (kp > x.Ls - 1 ? x.Ls - 1 : kp);
        ATT_DMA(QKV + hm(off, x.base + kp) + ((p ^ row) & 15) * 8, q); }
}
__device__ __forceinline__ void attn_a(const Frame& F, ALAS unsigned char* L) {
    ALAS float* rkT = (ALAS float*)(L + TAB_OFF); ALAS float* baT = (ALAS float*)(L + TAB_OFF + 2048);
    const bf16* QKV = (const bf16*)(F.ws + WS_QKV); const float* SS = (const float*)(F.ws + WS_SS); bf16* ATT = (bf16*)(F.ws + WS_BUFA);
    const int tid = F.tid, lane = F.lane, w = F.wave, g = lane >> 4, i16 = lane & 15;
    __syncthreads();
    if (F.bid < 2560) { const UnitA x0 = decode_a(F.bid); stage_a(L, QKV, x0, 8 + (x0.h >> 2), w, lane); }
    for (int u = F.bid; u < 2560; u += F.G) {
        const UnitA x = decode_a(u); const int h = x.h, base = x.base, n = x.n, Ls = x.Ls;
        const int hk = h >> 2, voff = 10 + hk, qoff = h, kpos0 = n * 128 - 128;
        if (tid < 384) { int kp = kpos0 + tid; kp = kp < 0 ? 0 : (kp > Ls - 1 ? Ls - 1 : kp); rkT[tid] = rstd_ss(SS, base + kp, 8 + hk); }
        if (tid < 257) baT[tid] = F.t5[t5_bucket_dev(tid - 128) * 8 + h] * LOG2E;
        const int qrow = base + n * 128 + 16 * w + i16; const float rq = rstd_ss(SS, qrow, h) * LOG2E;
        const float* gq_ = F.gqa; const float* gk_ = F.gka; asm volatile("" : "+s"(gq_), "+s"(gk_));
        bf16x8 qf[4]; load_q(qf, QKV, qrow, qoff, gq_, gk_, g);
        ATT_VMWAIT(); __syncthreads();
        f32x4 s[17];
        unsigned kb[4];
#pragma unroll
        for (int ks = 0; ks < 4; ++ks) kb[ks] = img_off(16 * w + i16, 4 * ks + g);
#pragma unroll
        for (int t = 0; t < 17; ++t) { f32x4 acc = {0.f, 0.f, 0.f, 0.f};
#pragma unroll
            for (int ks = 0; ks < 4; ++ks) { const bf16x8 kf = *(const ALAS bf16x8*)(L + kb[ks] + t * 4096); acc = __builtin_amdgcn_mfma_f32_16x16x32_bf16(kf, qf[ks], acc, 0, 0, 0); }
            s[t] = acc; }
        __syncthreads();
        stage_a(L, QKV, x, voff, w, lane);
        int bb = 4 * g - i16; asm volatile("" : "+v"(bb));
        float m = -1e30f;
#pragma unroll
        for (int t = 0; t < 17; ++t) { const int bi0 = 16 * (w + t) + 4 * g; const f32x4 rk4 = *(const ALAS f32x4*)(rkT + bi0);
#pragma unroll
            for (int r = 0; r < 4; ++r) { const int idx = 16 * t + r + bb, kp = kpos0 + bi0 + r; const bool valid = (unsigned)idx <= 256u && kp >= 0 && kp < Ls;
                const int idc = idx < 0 ? 0 : (idx > 256 ? 256 : idx);
                const float v = valid ? s[t][r] * rq * rk4[r] + baT[idc] : -1e30f; s[t][r] = v; m = fmaxf(m, v); } }
        m = fmaxf(m, __shfl_xor(m, 16)); m = fmaxf(m, __shfl_xor(m, 32));
        const float sk2 = F.sink[h] * LOG2E; m = fmaxf(m, sk2);
        float l = 0.f;
#pragma unroll
        for (int t = 0; t < 17; ++t)
#pragma unroll
            for (int r = 0; r < 4; ++r) { const float p = __builtin_amdgcn_exp2f(s[t][r] - m); s[t][r] = p; l += p; }
        l += __shfl_xor(l, 16); l += __shfl_xor(l, 32); l += __builtin_amdgcn_exp2f(sk2 - m);
        bf16x8 pk[9];
#pragma unroll
        for (int kk = 0; kk < 8; ++kk) pk[kk] = pack_p(s[2 * kk], s[2 * kk + 1]);
        pk[8] = pack_p(s[16], (f32x4){0.f, 0.f, 0.f, 0.f});
        ATT_VMWAIT(); __syncthreads();
        f32x4 o[8];
#pragma unroll
        for (int dt = 0; dt < 8; ++dt) o[dt] = (f32x4){0.f, 0.f, 0.f, 0.f};
        unsigned tb[8];
#pragma unroll
        for (int dt = 0; dt < 8; ++dt) tb[dt] = tr_off(16 * w + 4 * g + (i16 >> 2), dt, i16);
        const unsigned t17off = (unsigned)((w == 7 ? 16 : 17) * 4096);
#pragma unroll
        for (int kk = 0; kk < 9; ++kk) { const unsigned offb = kk < 8 ? (unsigned)((2 * kk + 1) * 4096) : t17off;
#pragma unroll
            for (int dt = 0; dt < 8; ++dt) { const v4i16_t lo = vtr(L + tb[dt] + 2 * kk * 4096), hi = vtr(L + tb[dt] + offb);
                const bf16x8 vf = {lo[0], lo[1], lo[2], lo[3], hi[0], hi[1], hi[2], hi[3]};
                o[dt] = __builtin_amdgcn_mfma_f32_16x16x32_bf16(vf, pk[kk], o[dt], 0, 0, 0); } }
        __syncthreads();
        if (u + F.G < 2560) { const UnitA xn = decode_a(u + F.G); stage_a(L, QKV, xn, 8 + (xn.h >> 2), w, lane); }
        const float inv = 1.0f / l; bf16* op = ATT + (size_t)qrow * D + h * 128 + 4 * g;
#pragma unroll
        for (int dt = 0; dt < 8; ++dt) { const unsigned long long v = (unsigned long long)pk2(o[dt][0] * inv, o[dt][1] * inv) | ((unsigned long long)pk2(o[dt][2] * inv, o[dt][3] * inv) << 32); *(unsigned long long*)(op + 16 * dt) = v; }
    }
    ATT_VMWAIT();
}

struct UnitB { int base, r0, rows, kr0, h, half; };
__device__ __forceinline__ UnitB decode_b(int u) { UnitB x; x.h = u & 7; x.half = (u >> 3) & 1; const int rg = u >> 4;
    if (rg < 128) { x.base = (rg >> 4) * 4096; x.r0 = (rg & 15) * 4; x.rows = 64; } else { const int r2 = rg - 128; x.base = NP_ROWS + (r2 >> 3) * 2048; x.r0 = (r2 & 7) * 4; x.rows = 32; }
    int k = x.r0 - 4; x.kr0 = k < 0 ? 0 : (k > x.rows - 11 ? x.rows - 11 : k); return x; }
__device__ __forceinline__ void stage_b(ALAS unsigned char* L, const bf16* QKV, const UnitB& x, int off, int w, int lane) {
    const int rl = lane >> 4, p = lane & 15, col0 = x.half ? 24 : 0;
#pragma unroll
    for (int j = 0; j < 14; ++j) { const int q = w + 8 * j;
        if (q < 110) { const int row = 4 * q + rl, kr = row / 40, kc = row - kr * 40;
            ATT_DMA(QKV + hm(off, x.base + (x.kr0 + kr) * 64 + col0 + kc) + ((p ^ row) & 15) * 8, q); } }
}
__device__ __forceinline__ void attn_b(const Frame& F, ALAS unsigned char* L) {
    ALAS float* rkT = (ALAS float*)(L + TAB_OFF); ALAS float* bT = (ALAS float*)(L + TAB_OFF + 2048);
    const bf16* QKV = (const bf16*)(F.ws + WS_QKV); const float* SS = (const float*)(F.ws + WS_SS); bf16* ATT = (bf16*)(F.ws + WS_BUFA);
    int tid = F.tid, w = F.wave; asm volatile("" : "+v"(tid), "+s"(w));
    const int lane = tid & 63, g = lane >> 4, i16 = lane & 15;
    __syncthreads();
    if (F.bid < 2560) { const UnitB x0 = decode_b(F.bid); stage_b(L, QKV, x0, 20 + x0.h, w, lane); }
    for (int u = F.bid; u < 2560; u += F.G) {
        const UnitB x = decode_b(u); const int h = x.h, half = x.half, base = x.base, r0 = x.r0, rows = x.rows, kr0 = x.kr0;
        const int col0 = half ? 24 : 0, qoff = 12 + h, voff = 28 + h;
        const int r = r0 + (w >> 1), cb = 2 * half + (w & 1), c = 16 * cb + i16;
        int rs = r - 4; rs = rs < 0 ? 0 : (rs > rows - 8 ? rows - 8 : rs);
        int reg = 16 * cb - 8; reg = reg < 0 ? 0 : (reg > 32 ? 32 : reg); int cs = c - 8; cs = cs < 0 ? 0 : (cs > 48 ? 48 : cs);
        const int q0 = (rs - kr0) * 40 + (reg - col0);
        if (tid < 440) { const int kr = tid / 40, kc = tid - kr * 40; rkT[tid] = rstd_ss(SS, base + (kr0 + kr) * 64 + col0 + kc, 20 + h); }
        bT[tid] = tid < 465 ? F.rpb[h * 465 + tid] * LOG2E : 0.f;
        const int qrow = base + r * 64 + c; const float rq = rstd_ss(SS, qrow, 12 + h) * LOG2E;
        const float* gq_ = F.gqb; const float* gk_ = F.gkb; asm volatile("" : "+s"(gq_), "+s"(gk_));
        bf16x8 qf[4]; load_q(qf, QKV, qrow, qoff, gq_, gk_, g);
        ATT_VMWAIT(); __syncthreads();
        f32x4 s[16];
        unsigned kb[4];
#pragma unroll
        for (int ks = 0; ks < 4; ++ks) kb[ks] = img_off(q0 + i16, 4 * ks + g);
#pragma unroll
        for (int t = 0; t < 16; ++t) { f32x4 acc = {0.f, 0.f, 0.f, 0.f};
#pragma unroll
            for (int ks = 0; ks < 4; ++ks) { const bf16x8 kf = *(const ALAS bf16x8*)(L + (kb[ks] ^ (unsigned)(((t >> 1) & 1) << 7)) + (40 * (t >> 1) + 16 * (t & 1)) * 256); acc = __builtin_amdgcn_mfma_f32_16x16x32_bf16(kf, qf[ks], acc, 0, 0, 0); }
            s[t] = acc; }
        __syncthreads();
        stage_b(L, QKV, x, voff, w, lane);
        float m = -1e30f;
#pragma unroll
        for (int t = 0; t < 16; ++t) { const int i = t >> 1, R0 = q0 + 40 * i + 16 * (t & 1) + 4 * g; const f32x4 rk4 = *(const ALAS f32x4*)(rkT + R0); const int kc0 = reg + 16 * (t & 1) + 4 * g, brow = (rs + i - r + 7) * 31 + 15 - c;
#pragma unroll
            for (int rr = 0; rr < 4; ++rr) { const int kc = kc0 + rr; const bool valid = kc >= cs && kc < cs + 16; int bi = brow + kc; bi = bi < 0 ? 0 : (bi > 464 ? 464 : bi);
                const float v = valid ? s[t][rr] * rq * rk4[rr] + bT[bi] : -1e30f; s[t][rr] = v; m = fmaxf(m, v); } }
        m = fmaxf(m, __shfl_xor(m, 16)); m = fmaxf(m, __shfl_xor(m, 32));
        float l = 0.f;
#pragma unroll
        for (int t = 0; t < 16; ++t)
#pragma unroll
            for (int rr = 0; rr < 4; ++rr) { const float p = __builtin_amdgcn_exp2f(s[t][rr] - m); s[t][rr] = p; l += p; }
        l += __shfl_xor(l, 16); l += __shfl_xor(l, 32);
        bf16x8 pk[8];
#pragma unroll
        for (int kk = 0; kk < 8; ++kk) pk[kk] = pack_p(s[2 * kk], s[2 * kk + 1]);
        ATT_VMWAIT(); __syncthreads();
        f32x4 o[8];
#pragma unroll
        for (int d = 0; d < 8; ++d) o[d] = (f32x4){0.f, 0.f, 0.f, 0.f};
        unsigned tb[8];
#pragma unroll
        for (int d = 0; d < 8; ++d) tb[d] = tr_off(q0 + 4 * g + (i16 >> 2), d, i16);
#pragma unroll
        for (int kk = 0; kk < 8; ++kk) {
#pragma unroll
            for (int d = 0; d < 8; ++d) { const unsigned a = (tb[d] ^ (unsigned)((kk & 1) << 7)) + kk * 40 * 256; const v4i16_t lo = vtr(L + a), hi = vtr(L + a + 4096);
                const bf16x8 vf = {lo[0], lo[1], lo[2], lo[3], hi[0], hi[1], hi[2], hi[3]};
                o[d] = __builtin_amdgcn_mfma_f32_16x16x32_bf16(vf, pk[kk], o[d], 0, 0, 0); } }
        __syncthreads();
        if (u + F.G < 2560) { const UnitB xn = decode_b(u + F.G); stage_b(L, QKV, xn, 20 + xn.h, w, lane); }
        const float inv = 1.0f / l; bf16* op = ATT + (size_t)qrow * D + 1024 + h * 128 + 4 * g;
#pragma unroll
        for (int d = 0; d < 8; ++d) { const unsigned long long v = (unsigned long long)pk2(o[d][0] * inv, o[d][1] * inv) | ((unsigned long long)pk2(o[d][2] * inv, o[d][3] * inv) << 32); *(unsigned long long*)(op + 16 * d) = v; }
    }
    ATT_VMWAIT();
}
}

#define XB_TMO      128
#define XB_XCNT(j)  (256  + 64 * (j))
#define XB_XSUB(j)  (1280 + 64 * (j))
#define XB_XGEN(j)  (2304 + 64 * (j))
#define XB_TOP      3328
#define XB_TOPGEN   3392
#define XCD_BAR_WORDS 3456
#define XB_SPIN_CAP (1u << 18)

__device__ __forceinline__ unsigned xb_ld(unsigned* p)              { return __hip_atomic_load(p, __ATOMIC_RELAXED, __HIP_MEMORY_SCOPE_AGENT); }
__device__ __forceinline__ unsigned xb_add(unsigned* p, unsigned v) { return __hip_atomic_fetch_add(p, v, __ATOMIC_RELAXED, __HIP_MEMORY_SCOPE_AGENT); }
__device__ __forceinline__ unsigned xb_xcc_id() { return (unsigned)__builtin_amdgcn_s_getreg((3 << 11) | 20) & 0xFu; }
#define XB_SPIN(cond, bar) do { unsigned _sp = 0; while (cond) { __builtin_amdgcn_s_sleep(1); \
    if ((++_sp & 255u) == 0u) { if (xb_ld(&(bar)[XB_TMO])) break; if (_sp > XB_SPIN_CAP) { atomicAdd(&(bar)[XB_TMO], 1u); break; } } } } while (0)

struct XcdBarrier {
    unsigned* bar; unsigned x;
    volatile LAS unsigned* st;
};

__device__ __forceinline__ XcdBarrier xcd_barrier_post(unsigned* bar, volatile LAS unsigned* st) {
    XcdBarrier b; b.bar = bar; b.x = xb_xcc_id(); b.st = st;
    if (threadIdx.x == 0) (void)xb_add(&bar[XB_XCNT(b.x)], 1u);
    return b;
}
__device__ __forceinline__ void xcd_barrier_complete(unsigned* bar, unsigned x, unsigned& nloc, unsigned& nx) {
    const unsigned G = gridDim.x * gridDim.y * gridDim.z;
    unsigned sum, cnt, mine, sp = 0u;
    for (;;) {
        sum = 0u; cnt = 0u; mine = 0u;
#pragma unroll
        for (unsigned j = 0; j < 16; ++j) { const unsigned c = xb_ld(&bar[XB_XCNT(j)]); sum += c; cnt += (c > 0u) ? 1u : 0u; mine = (j == x) ? c : mine; }
        if (sum == G) break;
        __builtin_amdgcn_s_sleep(1);
        if ((++sp & 255u) == 0u) { if (xb_ld(&bar[XB_TMO])) break; if (sp > XB_SPIN_CAP) { atomicAdd(&bar[XB_TMO], 1u); break; } }
    }
    nloc = mine > 0u ? mine : 1u; nx = cnt > 0u ? cnt : 1u;
}

__device__ __forceinline__ void xcd_barrier(const XcdBarrier& b) {
    asm volatile("s_waitcnt vmcnt(0)" ::: "memory");
    __syncthreads();
    if (threadIdx.x == 0) {
        unsigned* bar = b.bar;
        __builtin_amdgcn_s_waitcnt(0);
        unsigned nloc = b.st[0], nx = b.st[1];
        if (nloc == 0u) { xcd_barrier_complete(bar, b.x, nloc, nx); b.st[0] = nloc; b.st[1] = nx; }
        const unsigned old = xb_add(&bar[XB_XSUB(b.x)], 1u);
        const unsigned gen = old / nloc;
        if (old + 1u == (gen + 1u) * nloc) {
            __builtin_amdgcn_fence(__ATOMIC_RELEASE, "agent");
            asm volatile("s_waitcnt vmcnt(0)" ::: "memory");
            const unsigned og = xb_add(&bar[XB_TOP], 1u);
            const unsigned tg = og / nx;
            if (og + 1u == (tg + 1u) * nx) xb_add(&bar[XB_TOPGEN], 1u);
            else XB_SPIN(xb_ld(&bar[XB_TOPGEN]) == tg, bar);
            __builtin_amdgcn_fence(__ATOMIC_ACQUIRE, "agent");
            xb_add(&bar[XB_XGEN(b.x)], 1u);
            asm volatile("s_waitcnt vmcnt(0)" ::: "memory");
        } else {
            XB_SPIN(xb_ld(&bar[XB_XGEN(b.x)]) == gen, bar);
            __builtin_amdgcn_fence(__ATOMIC_ACQUIRE, "agent");
            asm volatile("s_waitcnt vmcnt(0)" ::: "memory");
        }
    }
    __syncthreads();
}

struct Args { const float* in[17]; float* out; unsigned char* ws; int ph_lo, ph_hi; };
constexpr int N_PHASES = 8;
__global__ void __launch_bounds__(NWAVES * 64, 2) fwd_megakernel(Args args) {
    extern __shared__ __attribute__((aligned(16))) unsigned char lds[];
    cg::grid_group grid = cg::this_grid();
    Frame F;
    F.lds = lds; F.tid = threadIdx.x; F.lane = F.tid & 63; F.wave = __builtin_amdgcn_readfirstlane(F.tid >> 6); F.G = gridDim.x; F.bid = blockIdx.x;
    F.xp = args.in[0]; F.xs = args.in[1]; F.g1 = args.in[2]; F.w_in = args.in[3]; F.gqa = args.in[4]; F.gka = args.in[5]; F.t5 = args.in[6]; F.sink = args.in[7];
    F.gqb = args.in[8]; F.gkb = args.in[9]; F.rpb = args.in[10]; F.wbra = args.in[11]; F.wbrb = args.in[12]; F.wout = args.in[13]; F.g2 = args.in[14]; F.wup = args.in[15]; F.wdn = args.in[16];
    F.out = args.out; F.ws = args.ws;
    unsigned char* ws = args.ws;
    PG8_LAS unsigned char* ldsl = (PG8_LAS unsigned char*)lds;
    const int lo = args.ph_lo, hi = args.ph_hi;
#ifndef PHASE_MASK
#define PHASE_MASK 0xff
#endif
#define IN(k) (((PHASE_MASK >> (k)) & 1) && lo <= (k) && (k) < hi)
#ifdef TSTAMP
    volatile unsigned long long* ts_ = (volatile unsigned long long*)(lds + 139264); int nts_ = 0;
#define STAMP() do { if (F.tid == 0) ts_[nts_] = __builtin_amdgcn_s_memrealtime(); ++nts_; } while (0)
#else
#define STAMP() do {} while (0)
#endif
#define SEAM(k) do { if (IN(k) && IN((k) + 1)) { if ((k) == 0) grid.sync(); else xcd_barrier(xbar); } STAMP(); } while (0)
    bf16* BUFA = (bf16*)(ws + WS_BUFA); bf16* QKV = (bf16*)(ws + WS_QKV); bf16* GATES = (bf16*)(ws + WS_GATES);
    float* SS = (float*)(ws + WS_SS); float* SS2 = (float*)(ws + WS_SS2); float* RSTD2 = (float*)(ws + WS_RSTD2);

    STAMP();
    { volatile LAS unsigned* st_ = (volatile LAS unsigned*)((LAS unsigned char*)lds + 139264 + 256); if (F.tid < 2) st_[F.tid] = 0u; __syncthreads(); }
    XcdBarrier xbar = xcd_barrier_post((unsigned*)(ws + WS_BAR), (volatile LAS unsigned*)((LAS unsigned char*)lds + 139264 + 256));
    if (IN(0)) { p0_prologue(F); __syncthreads(); }
    SEAM(0);
    if (IN(1)) {
        pg8::Gemm g{BUFA, (const bf16*)(ws + WS_WIN), M_ROWS, INW, D}; pg8::StaticOrder S; S.init(M_ROWS, INW, F.G, F.bid);
        pg8::EpiProj E{QKV, GATES, SS};
        pg8::gemm_phase<pg8::EpiProj, pg8::StaticOrder, true, true>(ldsl, g, S, E);
    }
    SEAM(1);
#ifdef NAIVE_ATTN
    if (IN(2)) { naive_attention(F); __syncthreads(); }
#else
    if (IN(2)) { att::attn_a(F, (ALAS unsigned char*)lds); att::attn_b(F, (ALAS unsigned char*)lds); __syncthreads(); }
#endif
    SEAM(2);
    if (IN(3)) {
        pg8::Gemm g{BUFA, (const bf16*)(ws + WS_WBR), M_ROWS, D, D}; pg8::StaticOrder S; S.init(M_ROWS, D, F.G, F.bid);
        pg8::EpiMerge E{GATES, QKV};
        pg8::gemm_phase<pg8::EpiMerge, pg8::StaticOrder, true, true>(ldsl, g, S, E);
    }
    SEAM(3);
    if (IN(4)) {
        pg8::Gemm g{QKV, (const bf16*)(ws + WS_WOUT), M_ROWS, D, D}; pg8::StaticOrder S; S.init(M_ROWS, D, F.G, F.bid);
        pg8::EpiOut1 E{F.xp, F.xs, F.out, BUFA, SS2};
        pg8::gemm_phase<pg8::EpiOut1, pg8::StaticOrder, true, true>(ldsl, g, S, E);
    }
    SEAM(4);
    if (IN(5)) {
        for (int m = F.bid * 512 + F.tid; m < M_ROWS; m += F.G * 512) { const f32x4* p = (const f32x4*)(SS2 + (size_t)m * 32); float s = 0.f;
#pragma unroll
            for (int j = 0; j < 8; ++j) { const f32x4 v = p[j]; s += (v.x + v.y) + (v.z + v.w); }
            RSTD2[m] = 1.0f / sqrtf(s * (1.f / D) + EPS); }
    }
    SEAM(5);
    if (IN(6)) {
        pg8::Gemm g{BUFA, (const bf16*)(ws + WS_WUP), M_ROWS, FF, D}; pg8::StaticOrder S; S.init(M_ROWS, FF, F.G, F.bid);
        pg8::EpiUp E{RSTD2, QKV};
        pg8::gemm_phase<pg8::EpiUp, pg8::StaticOrder, true, true>(ldsl, g, S, E);
    }
    SEAM(6);
    if (IN(7)) {
        pg8::Gemm g{QKV, (const bf16*)(ws + WS_WDN), M_ROWS, D, FF}; pg8::StaticOrder S; S.init(M_ROWS, D, F.G, F.bid);
        pg8::EpiDown E{F.out, BUFA};
        pg8::gemm_phase<pg8::EpiDown, pg8::StaticOrder, true, true>(ldsl, g, S, E);
    }
#ifdef TSTAMP
    grid.sync();
    __syncthreads();
    if (F.bid == 0) { const float spanA = (float)(ts_[TS_A1] - ts_[TS_A0]) * 0.01f, spanB = (float)(ts_[TS_B1] - ts_[TS_B0]) * 0.01f;
        if (F.tid == 0) F.out[8] += 0.1f * spanA;
        for (int i = F.tid; i < 1024; i += 512) F.out[2048 + i] += 0.01f * spanB; }
#endif
#undef IN
#undef SEAM
}


#ifdef SELFCHECK
__device__ __forceinline__ float bf1(const bf16* p) { return __uint_as_float(((unsigned)*p) << 16); }
__device__ __forceinline__ float rbf(float f) { return __uint_as_float(f2bf(f) << 16); }
__global__ void chk_kernel(Args a, int which) {
    const int lane = threadIdx.x, e = blockIdx.x; unsigned char* ws = a.ws; unsigned* flags = (unsigned*)(ws + WS_TAB + 65536);
    const bf16* BUFA = (const bf16*)(ws + WS_BUFA); const bf16* QKV = (const bf16*)(ws + WS_QKV); const bf16* GATES = (const bf16*)(ws + WS_GATES);
    const float* SS = (const float*)(ws + WS_SS); const float* RSTD2 = (const float*)(ws + WS_RSTD2);
    unsigned h1 = (unsigned)e * 2654435761u + 12345u; h1 ^= h1 >> 15; h1 *= 2246822519u; h1 ^= h1 >> 13; h1 *= 3266489917u; h1 ^= h1 >> 16;
    unsigned h2 = ((unsigned)e + 777u) * 2246822519u; h2 ^= h2 >> 13; h2 *= 2654435761u; h2 ^= h2 >> 16; h2 *= 668265263u; h2 ^= h2 >> 15;
    const int row = (int)(h1 % (unsigned)M_ROWS);
    bool bad = false;
    if (which == 0) { const int col = (int)(h2 % (unsigned)INW); float s = 0.f;
        for (int k = lane; k < D; k += 64) s += bf1(BUFA + (size_t)row * D + k) * rbf(a.in[3][(size_t)k * INW + col]);
        s = wave_sum(s);
        float got, ref; if (col < QKVW) { got = bf1(QKV + (size_t)row * QKVW + col); ref = s; } else { got = bf1(GATES + (size_t)row * GW_ + col - QKVW); ref = 1.f / (1.f + expf(-s)); }
        bad = false; if (fabsf(got - ref) > 0.02f + 0.01f * fabsf(ref) && lane == 0) atomicOr(flags, (col < QKVW ? 1u : 2u) | ((col & 7) < 4 ? 4u : 8u) | ((row & 15) < 8 ? 16u : 32u));
    } else if (which == 1) { const int hs = (int)(h2 % 36u); float s = 0.f;
        for (int c = lane; c < 128; c += 64) { const float v = bf1(QKV + (size_t)row * QKVW + hs * 128 + c); s += v * v; }
        s = wave_sum(s); const float* p = SS + ((size_t)row * 36 + hs) * 4; const float got = p[0] + p[1] + p[2] + p[3];
        bad = fabsf(got - s) > 0.02f * s + 1e-3f;
    } else if (which == 2) { const int col = (int)(h2 % (unsigned)D); float ya = 0.f, yb = 0.f;
        for (int k = lane; k < 1024; k += 64) { ya += bf1(BUFA + (size_t)row * D + k) * rbf(a.in[11][(size_t)k * D + col]); yb += bf1(BUFA + (size_t)row * D + 1024 + k) * rbf(a.in[12][(size_t)k * D + col]); }
        ya = wave_sum(ya); yb = wave_sum(yb);
        const float ref = bf1(GATES + (size_t)row * GW_ + col) * ya + bf1(GATES + (size_t)row * GW_ + 2048 + col) * yb; const float got = bf1(QKV + (size_t)row * D + col);
        bad = fabsf(got - ref) > 0.004f + 0.02f * fabsf(ref);
    } else if (which == 3) { const int col = (int)(h2 % (unsigned)D); float s = 0.f;
        for (int k = lane; k < D; k += 64) s += bf1(QKV + (size_t)row * D + k) * rbf(a.in[13][(size_t)k * D + col]);
        s = wave_sum(s); const float xv = row < NP_ROWS ? a.in[0][(size_t)row * D + col] : a.in[1][(size_t)(row - NP_ROWS) * D + col];
        const float ref = xv + s, got = a.out[(size_t)row * D + col], gotb = bf1(BUFA + (size_t)row * D + col);
        bad = fabsf(got - ref) > 0.004f + 0.002f * fabsf(ref) || fabsf(gotb - ref) > 0.004f + 0.01f * fabsf(ref);
    } else if (which == 4) { float s = 0.f;
        for (int k = lane; k < D; k += 64) { const float v = a.out[(size_t)row * D + k]; s += v * v; }
        s = wave_sum(s); const float ref = 1.f / sqrtf(s / D + EPS); bad = fabsf(RSTD2[row] - ref) > 0.001f * ref;
    } else if (which == 5) { const int col = (int)(h2 % (unsigned)FF); float s = 0.f;
        for (int k = lane; k < D; k += 64) s += bf1(BUFA + (size_t)row * D + k) * rbf(a.in[14][k] * a.in[15][(size_t)k * FF + col]);
        s = wave_sum(s) * RSTD2[row]; const float r = fmaxf(s, 0.f) * fmaxf(s, 0.f); const float got = bf1(QKV + (size_t)row * FF + col);
        bad = fabsf(got - r) > 0.01f + 0.03f * fabsf(r);
    }
    else if (which == 8) { const int col = (int)(h2 % (unsigned)D); float s = 0.f;
        for (int k = lane; k < FF; k += 64) s += bf1(QKV + (size_t)row * FF + k) * rbf(a.in[16][(size_t)k * D + col]);
        s = wave_sum(s); const float ref = bf1(BUFA + (size_t)row * D + col) + s, got = a.out[(size_t)row * D + col];
        bad = fabsf(got - ref) > 0.03f + 0.01f * fabsf(ref);
    }
    else if (which == 6 || which == 7) {
        __shared__ float sh_s[320]; __shared__ int sh_k[320];
        const int h = (int)(h2 % 8u); const bool isA = (which == 6); const SeqPos sp = seq_of_row(row);
        const int qoff = isA ? h * 128 : 1536 + h * 128, koff = isA ? 1024 + (h / 4) * 128 : 2560 + h * 128, voff = isA ? 1280 + (h / 4) * 128 : 3584 + h * 128;
        const float* gq = isA ? a.in[4] : a.in[8]; const float* gk = isA ? a.in[5] : a.in[9];
        float qn[2]; { float q0 = bf1(QKV + (size_t)row * QKVW + qoff + lane), q1 = bf1(QKV + (size_t)row * QKVW + qoff + 64 + lane);
            const float ssq = wave_sum(q0 * q0 + q1 * q1); const float r = 1.f / sqrtf(ssq / 128.f + EPS); qn[0] = q0 * r * gq[lane] * 0.08838834764831845f; qn[1] = q1 * r * gq[64 + lane] * 0.08838834764831845f; }
        int nk = 0;
        if (isA) { nk = 257; for (int j = lane; j < 320; j += 64) { const int kt = sp.t - 128 + j; sh_k[j] = (j < 257 && kt >= 0 && kt < sp.L) ? sp.base + kt : -1; } }
        else { nk = 256; const int rows = sp.L / 64, r = sp.t / 64, c = sp.t % 64; int rs = r - 4; if (rs < 0) rs = 0; if (rs > rows - 8) rs = rows - 8; const int cb = c / 16; int reg = cb * 16 - 8; if (reg < 0) reg = 0; if (reg > 32) reg = 32;
            int sc_ = c - 8; if (sc_ < 0) sc_ = 0; if (sc_ > 48) sc_ = 48;
            for (int j = lane; j < 320; j += 64) { const int kc = reg + (j & 31), kr_ = rs + (j >> 5); sh_k[j] = (j < 256 && kc >= sc_ && kc < sc_ + 16) ? sp.base + kr_ * 64 + kc : -1; } }
        __syncthreads();
        for (int j = 0; j < nk; ++j) { const int k = sh_k[j]; float sv = -1e30f;
            if (k >= 0) { const float k0 = bf1(QKV + (size_t)k * QKVW + koff + lane), k1 = bf1(QKV + (size_t)k * QKVW + koff + 64 + lane);
                const float ssk = wave_sum(k0 * k0 + k1 * k1); const float rk = 1.f / sqrtf(ssk / 128.f + EPS);
                float d = wave_sum(qn[0] * k0 * rk * gk[lane] + qn[1] * k1 * rk * gk[64 + lane]);
                float bias;
                if (isA) { const int rel = (k - sp.base) - sp.t; bias = a.in[6][t5_bucket_dev(rel) * 8 + h]; }
                else { const int kt = k - sp.base, kr_ = kt / 64, kc = kt % 64, r = sp.t / 64, c = sp.t % 64; int dcc = kc - c; if (dcc < -15) dcc = -15; if (dcc > 15) dcc = 15; bias = a.in[10][(h * 15 + (kr_ - r + 7)) * 31 + dcc + 15]; }
                sv = d + bias; }
            if (lane == 0) sh_s[j] = sv; }
        __syncthreads();
        float m = -1e30f; for (int j = 0; j < nk; ++j) m = fmaxf(m, sh_s[j]);
        if (isA) m = fmaxf(m, a.in[7][h]);
        float den = 0.f; for (int j = 0; j < nk; ++j) den += expf(sh_s[j] - m);
        if (isA) den += expf(a.in[7][h] - m);
        float o0 = 0.f, o1 = 0.f;
        for (int j = 0; j < nk; ++j) { const int k = sh_k[j]; if (k >= 0) { const float p = expf(sh_s[j] - m) / den; o0 += p * bf1(QKV + (size_t)k * QKVW + voff + lane); o1 += p * bf1(QKV + (size_t)k * QKVW + voff + 64 + lane); } }
        const int oc = isA ? h * 128 : 1024 + h * 128;
        const float g0 = bf1(BUFA + (size_t)row * D + oc + lane), g1 = bf1(BUFA + (size_t)row * D + oc + 64 + lane);
        const bool b2 = fabsf(g0 - o0) > 0.004f + 0.015f * fabsf(o0) || fabsf(g1 - o1) > 0.004f + 0.015f * fabsf(o1);
        bad = __any(b2);
    }
    if (which == 10) { const float* xr = row < NP_ROWS ? a.in[0] + (size_t)row * D : a.in[1] + (size_t)(row - NP_ROWS) * D; float ss = 0.f;
        for (int k = lane; k < D; k += 64) ss += xr[k] * xr[k];
        ss = wave_sum(ss); const float r = 1.f / sqrtf(ss / D + EPS); bool b2 = false;
        for (int k = lane; k < D; k += 64) { const float ref = xr[k] * r * a.in[2][k], got = bf1(BUFA + (size_t)row * D + k); b2 = b2 || fabsf(got - ref) > 0.002f + 0.006f * fabsf(ref); }
        bad = __any(b2); }
    if (lane == 0 && bad && which == 0) atomicOr(flags, 1u << which);
}
__global__ void chk_final(Args a) { const unsigned f = *(const unsigned*)(a.ws + WS_TAB + 65536); const int i = blockIdx.x * 256 + threadIdx.x; if (i < 4096) { a.out[i] += 100.f * (float)f; a.out[4096 + i] += 30.f; } }
#endif
extern "C" void kernel_launch(void* const* d_in, const int* in_sizes, int n_in, void* d_out, int out_size, void* d_ws, size_t ws_size, hipStream_t stream) {
    static int grid = 0;
    if (grid == 0) {
        if (n_in != 17 || in_sizes[0] != NP_ROWS * D || in_sizes[1] != (M_ROWS - NP_ROWS) * D || out_size != M_ROWS * D || ws_size < WS_END) {
            fprintf(stderr, "kernel_launch: shape/workspace mismatch (n_in %d, in0 %d, out %d, ws %zu < %zu); nothing launched\n", n_in, n_in > 0 ? in_sizes[0] : -1, out_size, ws_size, (size_t)WS_END); grid = -1; return; }
        int dev = 0, cus = 0, per_cu = 0;
        if (hipGetDevice(&dev) != hipSuccess || hipDeviceGetAttribute(&cus, hipDeviceAttributeMultiprocessorCount, dev) != hipSuccess) { fprintf(stderr, "kernel_launch: device query failed\n"); grid = -1; return; }
        if (hipFuncSetAttribute((const void*)fwd_megakernel, hipFuncAttributeMaxDynamicSharedMemorySize, LDS_BYTES) != hipSuccess) { fprintf(stderr, "kernel_launch: hipFuncSetAttribute failed\n"); grid = -1; return; }
        if (hipOccupancyMaxActiveBlocksPerMultiprocessor(&per_cu, (const void*)fwd_megakernel, NWAVES * 64, LDS_BYTES) != hipSuccess || per_cu < 1) { fprintf(stderr, "kernel_launch: occupancy query says %d blocks per CU\n", per_cu); per_cu = 1; }
        (void)hipGetLastError();
        grid = cus * 1;
    }
    if (grid < 0) return;
    Args a{};
    for (int i = 0; i < 17; ++i) a.in[i] = (const float*)d_in[i];
    a.out = (float*)d_out; a.ws = (unsigned char*)d_ws;
#if MK_N_LAUNCHES == 1
    if (hipMemsetAsync((char*)d_ws + WS_BAR, 0, XCD_BAR_WORDS * 4, stream) != hipSuccess) { fprintf(stderr, "kernel_launch: memset of the barrier words failed\n"); return; }
    a.ph_lo = 0; a.ph_hi = N_PHASES;
    void* kargs[] = {&a};
    hipError_t e = hipLaunchCooperativeKernel((const void*)fwd_megakernel, dim3(grid), dim3(NWAVES * 64), kargs, LDS_BYTES, stream);
    if (e != hipSuccess) fprintf(stderr, "kernel_launch: cooperative launch failed: %s (grid %d)\n", hipGetErrorString(e), grid);
#else
#ifdef SELFCHECK
    hipMemsetAsync((char*)d_ws + WS_TAB + 65536, 0, 64, stream);
#endif
    for (int ph = 0; ph < N_PHASES; ++ph) {
        a.ph_lo = ph; a.ph_hi = ph + 1;
        hipLaunchKernelGGL(fwd_megakernel, dim3(grid), dim3(NWAVES * 64), LDS_BYTES, stream, a);
        const hipError_t le = hipPeekAtLastError();
        if (le != hipSuccess) { fprintf(stderr, "kernel_launch: launch %d failed: %s\n", ph, hipGetErrorName(le)); break; }
#ifdef SELFCHECK
        if (ph == 0) hipLaunchKernelGGL(chk_kernel, dim3(65536), dim3(64), 0, stream, a, 10);
        if (ph == 1) { hipLaunchKernelGGL(chk_kernel, dim3(65536), dim3(64), 0, stream, a, 0); hipLaunchKernelGGL(chk_kernel, dim3(65536), dim3(64), 0, stream, a, 1); }
        if (ph == 2) { hipLaunchKernelGGL(chk_kernel, dim3(65536), dim3(64), 0, stream, a, 6); hipLaunchKernelGGL(chk_kernel, dim3(65536), dim3(64), 0, stream, a, 7); }
        if (ph == 3) hipLaunchKernelGGL(chk_kernel, dim3(65536), dim3(64), 0, stream, a, 2);
        if (ph == 4) hipLaunchKernelGGL(chk_kernel, dim3(65536), dim3(64), 0, stream, a, 3);
        if (ph == 5) hipLaunchKernelGGL(chk_kernel, dim3(65536), dim3(64), 0, stream, a, 4);
        if (ph == 6) hipLaunchKernelGGL(chk_kernel, dim3(65536), dim3(64), 0, stream, a, 5);
        if (ph == 7) { hipLaunchKernelGGL(chk_kernel, dim3(65536), dim3(64), 0, stream, a, 8); }
        if (ph == 7) hipLaunchKernelGGL(chk_final, dim3(16), dim3(256), 0, stream, a);
#endif
    }
#endif
}
```

```cpp
#include <hip/hip_runtime.h>
#include <hip/hip_cooperative_groups.h>
#include <cstdio>
#include <cstdint>
namespace cg = cooperative_groups;
#define MK_N_LAUNCHES 1
namespace pg8 {
#define PG8_LAS __attribute__((address_space(3)))
typedef unsigned short bf16_t;
typedef short bf16x8 __attribute__((ext_vector_type(8)));
typedef float f32x4 __attribute__((ext_vector_type(4)));
typedef unsigned u32x4 __attribute__((ext_vector_type(4)));
constexpr int BM = 256, BK = 64, HALF = 128, HTB = HALF * BK * 2  , STAGE_BYTES = 8 * HTB, NXCD = 8, WGM = 8;

__host__ __device__ __forceinline__ int lds_byte(int r, int c) { const int st = (r >> 4) * 2 + (c >> 5), rr = r & 15, cc = c & 31, ob = rr * 64 + cc * 2; return st * 1024 + (ob ^ (((ob >> 9) & 1) << 5)); }
__host__ __device__ __forceinline__ void stage_rc(int b, int& R, int& C) { const int st = b / 1024, sb = b % 1024, swz = sb ^ (((sb >> 9) & 1) << 5); R = (st >> 1) * 16 + swz / 64; C = (st & 1) * 32 + (swz % 64) / 2; }
__host__ __device__ __forceinline__ int perm32(int rho) { const int n = rho >> 4, i = rho & 15; return 8 * (i >> 2) + 4 * n + (i & 3); }

struct Unit { int pm, pn; };
struct Gemm { const bf16_t* A; const bf16_t* Bt; int M, N, K; };

struct StaticOrder {
    int nM, nN, nwg, G, c;
    __host__ __device__ void init(int M, int N, int G_, int c_) { nM = M / BM; nN = N / BM; nwg = nM * nN; G = G_; c = c_; }
    __host__ __device__ bool next(int i, Unit& u) const {
        const long L = (long)i * G + c; if (L >= nwg) return false;
        int wgid = (int)L; { const int q = nwg / NXCD, r = nwg % NXCD, xcd = wgid % NXCD, off = wgid / NXCD; wgid = (xcd < r ? xcd * (q + 1) : r * (q + 1) + (xcd - r) * q) + off; }
        const int nig = WGM * nN, gid = wgid / nig, fm = gid * WGM, gsz = (nM - fm) < WGM ? (nM - fm) : WGM;
        u.pm = fm + ((wgid % nig) % gsz); u.pn = (wgid % nig) / gsz; return true;
    }
    __device__ __forceinline__ void a_ready(const Unit&) const {}
    __device__ __forceinline__ void done(const Unit&) const {}
};

__device__ __forceinline__ unsigned cvt_pk_bf16(float lo, float hi) { unsigned r; asm volatile("s_nop 0\n\tv_cvt_pk_bf16_f32 %0, %1, %2" : "=v"(r) : "v"(lo), "v"(hi)); return r; }
typedef float f32x2 __attribute__((ext_vector_type(2)));
typedef unsigned u32x2 __attribute__((ext_vector_type(2)));
__device__ __forceinline__ float bf_lo(unsigned w) { return __uint_as_float(w << 16); }
__device__ __forceinline__ float bf_hi(unsigned w) { return __uint_as_float(w & 0xffff0000u); }
__device__ __forceinline__ u32x4 pack8(const f32x4 v0, const f32x4 v1) { u32x4 w; w.x = cvt_pk_bf16(v0[0], v0[1]); w.y = cvt_pk_bf16(v0[2], v0[3]); w.z = cvt_pk_bf16(v1[0], v1[1]); w.w = cvt_pk_bf16(v1[2], v1[3]); return w; }
__device__ __forceinline__ float sigmoidf_(float x) { return __builtin_amdgcn_rcpf(1.0f + __builtin_amdgcn_exp2f(-1.44269504089f * x)); }
constexpr int QKV_LD = 4608, GATE_LD = 4096, DM = 2048, FFD = 8192, NHS = 36, NPROMPT_ROWS = 32768;

struct EpiProj {
    static constexpr bool PERM = true, AFTER_DRAIN = false, MID = false;
    bf16_t* QKV; bf16_t* GATES; float* SS;
    __device__ __forceinline__ void operator()(const f32x4 (&acc)[2][2][4][2], const Unit& u, int wr, int wc, int fr, int fq) const {
        const int row0 = u.pm * BM + wr * 64 + fr;
        if (u.pn < 18) {
            const int col0 = u.pn * BM + wc * 32 + 8 * fq;
#pragma unroll
            for (int ai = 0; ai < 2; ++ai)
#pragma unroll
                for (int m = 0; m < 4; ++m) { const int row = row0 + ai * HALF + m * 16; bf16_t* rowp = QKV + ((size_t)(u.pn * 2) * 40960 + (size_t)row) * 128 + wc * 32 + 8 * fq;
#pragma unroll
                    for (int bj = 0; bj < 2; ++bj) { const f32x4 v0 = acc[ai][bj][m][0], v1 = acc[ai][bj][m][1];
                        float s = (v0[0] * v0[0] + v0[1] * v0[1]) + (v0[2] * v0[2] + v0[3] * v0[3]) + (v1[0] * v1[0] + v1[1] * v1[1]) + (v1[2] * v1[2] + v1[3] * v1[3]);
                        s += __shfl_xor(s, 16); s += __shfl_xor(s, 32);
                        if (fq == 0) SS[((size_t)row * NHS + u.pn * 2 + bj) * 4 + wc] = s;
                        *(u32x4*)(rowp + (size_t)bj * 40960 * 128) = pack8(v0, v1); } }
        } else {
            const int col0 = (u.pn - 18) * BM + wc * 32 + 8 * fq;
#pragma unroll
            for (int ai = 0; ai < 2; ++ai)
#pragma unroll
                for (int m = 0; m < 4; ++m) { const int row = row0 + ai * HALF + m * 16; bf16_t* rowp = GATES + (size_t)row * GATE_LD + col0;
#pragma unroll
                    for (int bj = 0; bj < 2; ++bj) { f32x4 v0 = acc[ai][bj][m][0], v1 = acc[ai][bj][m][1];
#pragma unroll
                        for (int j = 0; j < 4; ++j) { v0[j] = sigmoidf_(v0[j]); v1[j] = sigmoidf_(v1[j]); }
                        *(u32x4*)(rowp + bj * HALF) = pack8(v0, v1); } }
        }
    }
};

struct EpiMerge {
    static constexpr bool PERM = true, AFTER_DRAIN = false, MID = true;
    const bf16_t* GATES; bf16_t* OUT;
    __device__ __forceinline__ void mid(f32x4 (&acc)[2][2][4][2], const Unit& u, int wr, int wc, int fr, int fq) const {
        const int row0 = u.pm * BM + wr * 64 + fr, col0 = u.pn * BM + wc * 32 + 8 * fq;
        const bf16_t* gp0 = GATES + (size_t)row0 * GATE_LD + col0;
        asm volatile("" : "+v"(gp0));
#pragma unroll
        for (int ai = 0; ai < 2; ++ai) { u32x4 ga[4][2], gb[4][2];
#pragma unroll
            for (int m = 0; m < 4; ++m)
#pragma unroll
                for (int bj = 0; bj < 2; ++bj) { const bf16_t* gp = gp0 + (size_t)(ai * HALF + m * 16) * GATE_LD + bj * HALF; ga[m][bj] = *(const u32x4*)gp; gb[m][bj] = *(const u32x4*)(gp + DM); }
#pragma unroll
            for (int m = 0; m < 4; ++m)
#pragma unroll
                for (int bj = 0; bj < 2; ++bj) { const u32x4 a = ga[m][bj], b = gb[m][bj]; f32x4& c0 = acc[ai][bj][m][0]; f32x4& c1 = acc[ai][bj][m][1];
                    c0[0] *= bf_lo(a.x) * __builtin_amdgcn_rcpf(bf_lo(b.x)); c0[1] *= bf_hi(a.x) * __builtin_amdgcn_rcpf(bf_hi(b.x));
                    c0[2] *= bf_lo(a.y) * __builtin_amdgcn_rcpf(bf_lo(b.y)); c0[3] *= bf_hi(a.y) * __builtin_amdgcn_rcpf(bf_hi(b.y));
                    c1[0] *= bf_lo(a.z) * __builtin_amdgcn_rcpf(bf_lo(b.z)); c1[1] *= bf_hi(a.z) * __builtin_amdgcn_rcpf(bf_hi(b.z));
                    c1[2] *= bf_lo(a.w) * __builtin_amdgcn_rcpf(bf_lo(b.w)); c1[3] *= bf_hi(a.w) * __builtin_amdgcn_rcpf(bf_hi(b.w)); }
            asm volatile("" ::: "memory"); }
    }
    __device__ __forceinline__ void operator()(const f32x4 (&acc)[2][2][4][2], const Unit& u, int wr, int wc, int fr, int fq) const {
        const int row0 = u.pm * BM + wr * 64 + fr, col0 = u.pn * BM + wc * 32 + 8 * fq;
        u32x4 gb[2][4][2];
#pragma unroll
        for (int ai = 0; ai < 2; ++ai)
#pragma unroll
            for (int m = 0; m < 4; ++m)
#pragma unroll
                for (int bj = 0; bj < 2; ++bj) gb[ai][m][bj] = *(const u32x4*)(GATES + (size_t)(row0 + ai * HALF + m * 16) * GATE_LD + DM + col0 + bj * HALF);
#pragma unroll
        for (int ai = 0; ai < 2; ++ai)
#pragma unroll
            for (int m = 0; m < 4; ++m) { bf16_t* op = OUT + (size_t)(row0 + ai * HALF + m * 16) * DM + col0;
#pragma unroll
                for (int bj = 0; bj < 2; ++bj) { const u32x4 b = gb[ai][m][bj];
                    f32x4 v0 = acc[ai][bj][m][0], v1 = acc[ai][bj][m][1];
                    v0[0] *= bf_lo(b.x); v0[1] *= bf_hi(b.x); v0[2] *= bf_lo(b.y); v0[3] *= bf_hi(b.y);
                    v1[0] *= bf_lo(b.z); v1[1] *= bf_hi(b.z); v1[2] *= bf_lo(b.w); v1[3] *= bf_hi(b.w);
                    *(u32x4*)(op + bj * HALF) = pack8(v0, v1); } }
    }
};

struct EpiOut1 {
    static constexpr bool PERM = true, AFTER_DRAIN = false, MID = false;
    const float* xp; const float* xs; float* OUT; bf16_t* X1B; float* SS2;
    __device__ __forceinline__ void operator()(const f32x4 (&acc)[2][2][4][2], const Unit& u, int wr, int wc, int fr, int fq) const {
        const int row0 = u.pm * BM + wr * 64 + fr, col0 = u.pn * BM + wc * 32 + 8 * fq;
        const float* xb = (u.pm * BM < NPROMPT_ROWS) ? xp : xs - (size_t)NPROMPT_ROWS * DM;
#pragma unroll
        for (int ai = 0; ai < 2; ++ai) { f32x4 xv[4][2][2];
#pragma unroll
            for (int m = 0; m < 4; ++m)
#pragma unroll
                for (int bj = 0; bj < 2; ++bj) { const float* xr = xb + (size_t)(row0 + ai * HALF + m * 16) * DM + col0 + bj * HALF; xv[m][bj][0] = *(const f32x4*)xr; xv[m][bj][1] = *(const f32x4*)(xr + 4); }
#pragma unroll
            for (int m = 0; m < 4; ++m) { const size_t row = (size_t)(row0 + ai * HALF + m * 16); bf16_t* bp = X1B + row * DM + col0;
                float s = 0.f;
#pragma unroll
                for (int bj = 0; bj < 2; ++bj) { const f32x4 v0 = acc[ai][bj][m][0] + xv[m][bj][0], v1 = acc[ai][bj][m][1] + xv[m][bj][1];
                    s += (v0[0] * v0[0] + v0[1] * v0[1]) + (v0[2] * v0[2] + v0[3] * v0[3]) + (v1[0] * v1[0] + v1[1] * v1[1]) + (v1[2] * v1[2] + v1[3] * v1[3]);
                    *(u32x4*)(bp + bj * HALF) = pack8(v0, v1); }
                s += __shfl_xor(s, 16); s += __shfl_xor(s, 32);
                if (fq == 0) SS2[row * 32 + u.pn * 4 + wc] = s; }
            asm volatile("" ::: "memory"); }
    }
};

struct EpiUp {
    static constexpr bool PERM = true, AFTER_DRAIN = false, MID = false;
    const float* RSTD2; bf16_t* U;
    __device__ __forceinline__ void operator()(const f32x4 (&acc)[2][2][4][2], const Unit& u, int wr, int wc, int fr, int fq) const {
        const int row0 = u.pm * BM + wr * 64 + fr, col0 = u.pn * BM + wc * 32 + 8 * fq;
#pragma unroll
        for (int ai = 0; ai < 2; ++ai)
#pragma unroll
            for (int m = 0; m < 4; ++m) { const size_t row = (size_t)(row0 + ai * HALF + m * 16); const float rs = RSTD2[row]; bf16_t* op = U + row * FFD + col0;
#pragma unroll
                for (int bj = 0; bj < 2; ++bj) { f32x4 v0 = acc[ai][bj][m][0] * rs, v1 = acc[ai][bj][m][1] * rs;
#pragma unroll
                    for (int j = 0; j < 4; ++j) { const float a = fmaxf(v0[j], 0.f), b = fmaxf(v1[j], 0.f); v0[j] = a * a; v1[j] = b * b; }
                    *(u32x4*)(op + bj * HALF) = pack8(v0, v1); } }
    }
};

struct EpiDown {
    static constexpr bool PERM = true, AFTER_DRAIN = false, MID = false;
    float* OUT; const bf16_t* X1B;
    __device__ __forceinline__ void operator()(const f32x4 (&acc)[2][2][4][2], const Unit& u, int wr, int wc, int fr, int fq) const {
        const int row0 = u.pm * BM + wr * 64 + fr, col0 = u.pn * BM + wc * 32 + 8 * fq;
        u32x4 xw[2][4][2];
#pragma unroll
        for (int ai = 0; ai < 2; ++ai)
#pragma unroll
            for (int m = 0; m < 4; ++m)
#pragma unroll
                for (int bj = 0; bj < 2; ++bj) xw[ai][m][bj] = *(const u32x4*)(X1B + (size_t)(row0 + ai * HALF + m * 16) * DM + col0 + bj * HALF);
#pragma unroll
        for (int ai = 0; ai < 2; ++ai)
#pragma unroll
            for (int m = 0; m < 4; ++m) { float* op = OUT + (size_t)(row0 + ai * HALF + m * 16) * DM + col0;
#pragma unroll
                for (int bj = 0; bj < 2; ++bj) { const u32x4 x = xw[ai][m][bj]; f32x4 v0 = acc[ai][bj][m][0], v1 = acc[ai][bj][m][1];
                    v0[0] += bf_lo(x.x); v0[1] += bf_hi(x.x); v0[2] += bf_lo(x.y); v0[3] += bf_hi(x.y); v1[0] += bf_lo(x.z); v1[1] += bf_hi(x.z); v1[2] += bf_lo(x.w); v1[3] += bf_hi(x.w);
                    *(f32x4*)(op + bj * HALF) = v0; *(f32x4*)(op + bj * HALF + 4) = v1; } }
    }
};

template <class Epi, class Sched, bool ALIGN_EPI = false, bool SP2 = false>
__device__ __forceinline__ void gemm_phase(PG8_LAS unsigned char* lds, const Gemm g, const Sched& S, const Epi& E) {
    const int tid = threadIdx.x, wid = __builtin_amdgcn_readfirstlane(tid >> 6), lane = tid & 63, wr = wid >> 2, wc = wid & 3, fr = lane & 15, fq = lane >> 4;
    const int K = g.K, nt = K / BK;
    unsigned voffA[2], voffB[2];
#pragma unroll
    for (int i = 0; i < 2; ++i) { int R, C; stage_rc(tid * 16 + i * 8192, R, C); const int Rb = Epi::PERM ? ((R & ~31) + perm32(R & 31)) : R;
        voffA[i] = (unsigned)(R * K + C) * 2u; voffB[i] = (unsigned)(Rb * K + C) * 2u; }
    const size_t kstep = (size_t)(BK * 2);
    const size_t hstep = (size_t)HALF * K * 2;
    const size_t tstep = 2 * hstep;
    const unsigned ldsw = (unsigned)wid * 1024u;
    const int aoff = lds_byte(wr * 64 + fr, fq * 8), boff = lds_byte(wc * 32 + fr, fq * 8);
#define PG8_SA(b, h) (((b) * 2 + (h)) * HTB)
#define PG8_SB(b, h) ((4 + (b) * 2 + (h)) * HTB)
#define PG8_STAGE(bufoff, gbase, voff) do { _Pragma("unroll") for (int _i = 0; _i < 2; ++_i) \
        __builtin_amdgcn_global_load_lds((const unsigned*)((const char*)(gbase) + (voff)[_i]), (PG8_LAS unsigned*)(lds + (bufoff) + ldsw + _i * 8192), 16, 0, 0); } while (0)
#define PG8_LDA(dst, b, h) do { _Pragma("unroll") for (int m = 0; m < 4; ++m) _Pragma("unroll") for (int k = 0; k < 2; ++k) dst[m][k] = *(const PG8_LAS bf16x8*)(lds + PG8_SA(b, h) + aoff + m * 2048 + k * 1024); } while (0)
#define PG8_LDB(dst, b, h) do { _Pragma("unroll") for (int n = 0; n < 2; ++n) _Pragma("unroll") for (int k = 0; k < 2; ++k) dst[n][k] = *(const PG8_LAS bf16x8*)(lds + PG8_SB(b, h) + boff + n * 2048 + k * 1024); } while (0)
#define PG8_MMA(ai, bj, At, Bt) do { __builtin_amdgcn_s_setprio(1); _Pragma("unroll") for (int m = 0; m < 4; ++m) _Pragma("unroll") for (int n = 0; n < 2; ++n) _Pragma("unroll") for (int k = 0; k < 2; ++k) \
        acc[ai][bj][m][n] = __builtin_amdgcn_mfma_f32_16x16x32_bf16(Bt[n][k], At[m][k], acc[ai][bj][m][n], 0, 0, 0); __builtin_amdgcn_s_setprio(0); } while (0)
#define PG8_WAIT_V(n) asm volatile("s_waitcnt vmcnt(" #n ")" ::: "memory")
#define PG8_WAIT_L(n) asm volatile("s_waitcnt lgkmcnt(" #n ")" ::: "memory")
#define PG8_BAR __builtin_amdgcn_s_barrier()
#define PG8_SCHED __builtin_amdgcn_sched_barrier(0)
    Unit cur, nxt; int ui = 0;
    if (!S.next(0, cur)) return;
    f32x4 acc[2][2][4][2];
#pragma unroll
    for (int a = 0; a < 2; ++a)
#pragma unroll
        for (int b = 0; b < 2; ++b)
#pragma unroll
            for (int m = 0; m < 4; ++m)
#pragma unroll
                for (int n = 0; n < 2; ++n) acc[a][b][m][n] = (f32x4){0.f, 0.f, 0.f, 0.f};
    bf16x8 At[4][2], B0[2][2], B1[2][2];
    const char* cA = (const char*)g.A + (size_t)cur.pm * tstep; const char* cB = (const char*)g.Bt + (size_t)cur.pn * tstep;
    S.a_ready(cur);
    if constexpr (SP2) {
        PG8_STAGE(PG8_SB(0, 0), cB, voffB); PG8_STAGE(PG8_SB(0, 1), cB + hstep, voffB); PG8_STAGE(PG8_SA(0, 0), cA, voffA); PG8_STAGE(PG8_SA(0, 1), cA + hstep, voffA);
        if (wr == 1) PG8_BAR;
        PG8_WAIT_V(2); PG8_BAR;
        PG8_STAGE(PG8_SB(1, 0), cB + kstep, voffB); PG8_STAGE(PG8_SA(1, 0), cA + kstep, voffA); PG8_STAGE(PG8_SB(1, 1), cB + hstep + kstep, voffB);
        PG8_WAIT_V(6); PG8_BAR;
    } else {
        PG8_STAGE(PG8_SB(0, 0), cB, voffB); PG8_STAGE(PG8_SA(0, 0), cA, voffA); PG8_STAGE(PG8_SB(0, 1), cB + hstep, voffB); PG8_STAGE(PG8_SA(0, 1), cA + hstep, voffA);
        if (wr == 1) PG8_BAR;
        PG8_WAIT_V(4); PG8_BAR;
        PG8_STAGE(PG8_SB(1, 0), cB + kstep, voffB); PG8_STAGE(PG8_SA(1, 0), cA + kstep, voffA); PG8_STAGE(PG8_SB(1, 1), cB + hstep + kstep, voffB);
        PG8_WAIT_V(6); PG8_BAR;
    }
    for (;;) {
        const bool has_next = S.next(ui + 1, nxt);
        const char* nA = has_next ? (const char*)g.A + (size_t)nxt.pm * tstep : cA; const char* nB = has_next ? (const char*)g.Bt + (size_t)nxt.pn * tstep : cB;
        constexpr int NSEG = Epi::MID ? 2 : 1; const int seglen = nt / NSEG;
        for (int seg = 0; seg < NSEG; ++seg) {
        if constexpr (Epi::MID) { if (seg == 1) E.mid(acc, cur, wr, wc, fr, fq); }
        for (int t = seg * seglen; t < (seg + 1) * seglen; t += 2) {
            const bool last = (t == nt - 2);
            const char* a1 = cA + (size_t)(t + 1) * kstep;
            const char* a2 = last ? nA : cA + (size_t)(t + 2) * kstep; const char* b2 = last ? nB : cB + (size_t)(t + 2) * kstep;
            const char* a3 = a2 + kstep; const char* b3 = b2 + kstep;
            if (last && has_next) S.a_ready(nxt);
            if constexpr (SP2) {
            PG8_LDB(B0, 0, 0); PG8_LDB(B1, 0, 1); PG8_SCHED; PG8_LDA(At, 0, 0); PG8_STAGE(PG8_SA(1, 1), a1 + hstep, voffA);
            PG8_WAIT_V(8); PG8_WAIT_L(0); PG8_BAR; PG8_MMA(0, 0, At, B0); PG8_MMA(0, 1, At, B1); PG8_BAR; PG8_SCHED;
            PG8_LDA(At, 0, 1); PG8_STAGE(PG8_SB(0, 0), b2, voffB); PG8_STAGE(PG8_SB(0, 1), b2 + hstep, voffB); PG8_STAGE(PG8_SA(0, 0), a2, voffA);
            PG8_WAIT_V(8); PG8_WAIT_L(0); PG8_BAR; PG8_MMA(1, 0, At, B0); PG8_MMA(1, 1, At, B1); PG8_BAR; PG8_SCHED;
            PG8_LDB(B0, 1, 0); PG8_LDB(B1, 1, 1); PG8_SCHED; PG8_LDA(At, 1, 0); PG8_STAGE(PG8_SA(0, 1), a2 + hstep, voffA);
            PG8_WAIT_V(8); PG8_WAIT_L(0); PG8_BAR; PG8_MMA(0, 0, At, B0); PG8_MMA(0, 1, At, B1); PG8_BAR; PG8_SCHED;
            PG8_LDA(At, 1, 1); PG8_STAGE(PG8_SB(1, 0), b3, voffB); PG8_STAGE(PG8_SB(1, 1), b3 + hstep, voffB); PG8_STAGE(PG8_SA(1, 0), a3, voffA);
            PG8_WAIT_V(8); PG8_WAIT_L(0); PG8_BAR; PG8_MMA(1, 0, At, B0); PG8_MMA(1, 1, At, B1); PG8_BAR; PG8_SCHED;
            } else {
            PG8_LDB(B0, 0, 0); PG8_SCHED; PG8_LDA(At, 0, 0); PG8_STAGE(PG8_SA(1, 1), a1 + hstep, voffA);
            PG8_WAIT_L(8); PG8_BAR; PG8_WAIT_L(0); PG8_MMA(0, 0, At, B0); PG8_BAR; PG8_SCHED;
            PG8_LDB(B1, 0, 1); PG8_STAGE(PG8_SB(0, 0), b2, voffB);
            PG8_BAR; PG8_WAIT_L(0); PG8_MMA(0, 1, At, B1); PG8_BAR;
            PG8_LDA(At, 0, 1); PG8_STAGE(PG8_SA(0, 0), a2, voffA);
            PG8_BAR; PG8_WAIT_L(0); PG8_MMA(1, 0, At, B0); PG8_BAR; PG8_SCHED;
            PG8_STAGE(PG8_SB(0, 1), b2 + hstep, voffB);
            PG8_WAIT_V(6); PG8_BAR; PG8_MMA(1, 1, At, B1); PG8_BAR;
            PG8_LDB(B0, 1, 0); PG8_SCHED; PG8_LDA(At, 1, 0); PG8_STAGE(PG8_SA(0, 1), a2 + hstep, voffA);
            PG8_WAIT_L(8); PG8_BAR; PG8_WAIT_L(0); PG8_MMA(0, 0, At, B0); PG8_BAR; PG8_SCHED;
            PG8_LDB(B1, 1, 1); PG8_STAGE(PG8_SB(1, 0), b3, voffB);
            PG8_BAR; PG8_WAIT_L(0); PG8_MMA(0, 1, At, B1); PG8_BAR;
            PG8_LDA(At, 1, 1); PG8_STAGE(PG8_SA(1, 0), a3, voffA);
            PG8_BAR; PG8_WAIT_L(0); PG8_MMA(1, 0, At, B0); PG8_BAR; PG8_SCHED;
            PG8_STAGE(PG8_SB(1, 1), b3 + hstep, voffB);
            PG8_WAIT_V(6); PG8_BAR; PG8_MMA(1, 1, At, B1); PG8_BAR;
            }
        }
        }
        if constexpr (ALIGN_EPI) { if (wr == 0) PG8_BAR; }
        if constexpr (!Epi::AFTER_DRAIN) { E(acc, cur, wr, wc, fr, fq); S.done(cur); }
        if (!has_next) break;
#pragma unroll
        for (int a = 0; a < 2; ++a)
#pragma unroll
            for (int b = 0; b < 2; ++b)
#pragma unroll
                for (int m = 0; m < 4; ++m)
#pragma unroll
                    for (int n = 0; n < 2; ++n) acc[a][b][m][n] = (f32x4){0.f, 0.f, 0.f, 0.f};
        cur = nxt; cA = nA; cB = nB; ++ui;
        if constexpr (ALIGN_EPI) { if (wr == 1) PG8_BAR; }
    }
    PG8_WAIT_V(0);
    if constexpr (!ALIGN_EPI) { if (wr == 0) PG8_BAR; }
    PG8_BAR;
    if constexpr (Epi::AFTER_DRAIN) { E.fused(acc, cur, wr, wc, fr, fq, lds, wid, lane); S.done(cur); }
#undef PG8_SA
#undef PG8_SB
#undef PG8_STAGE
#undef PG8_LDA
#undef PG8_LDB
#undef PG8_MMA
#undef PG8_WAIT_V
#undef PG8_WAIT_L
#undef PG8_BAR
#undef PG8_SCHED
}
}
#ifndef MK_N_LAUNCHES
#define MK_N_LAUNCHES 1
#endif
constexpr int NWAVES = 8;
constexpr int M_ROWS = 40960, NP_ROWS = 32768, D = 2048, FF = 8192, INW = 8704, QKVW = 4608, GW_ = 4096, HD = 128;
constexpr float EPS = 1e-6f;
constexpr size_t MiB = 1u << 20;
constexpr size_t WS_TAB = 0;
constexpr size_t WS_BAR = 128 * 1024;
constexpr size_t WS_RSTD2 = 1 * MiB;
constexpr size_t WS_SS2 = 2 * MiB;
constexpr size_t WS_SS = 8 * MiB;
constexpr size_t WS_WIN = 32 * MiB;
constexpr size_t WS_WBR = 66 * MiB;
constexpr size_t WS_WOUT = 74 * MiB;
constexpr size_t WS_WUP = 82 * MiB;
constexpr size_t WS_WDN = 114 * MiB;
constexpr size_t WS_BUFA = 146 * MiB;
constexpr size_t WS_QKV = 306 * MiB;
constexpr size_t WS_GATES = 666 * MiB;
constexpr size_t WS_END = 986 * MiB;
constexpr int LDS_BYTES = 147456;

#define LAS __attribute__((address_space(3)))
typedef unsigned short bf16;
typedef unsigned v4u __attribute__((ext_vector_type(4)));
typedef float f32x4 __attribute__((ext_vector_type(4)));
#define LDS_WAIT() asm volatile("s_waitcnt lgkmcnt(0)" ::: "memory")
__device__ __forceinline__ unsigned f2bf(float f) { unsigned u = __builtin_bit_cast(unsigned, f); return (u + 0x7fffu + ((u >> 16) & 1u)) >> 16; }
__device__ __forceinline__ unsigned pk2(float lo, float hi) { return f2bf(lo) | (f2bf(hi) << 16); }
__device__ __forceinline__ float bflo(unsigned w) { return __uint_as_float(w << 16); }
__device__ __forceinline__ float bfhi(unsigned w) { return __uint_as_float(w & 0xffff0000u); }
__device__ __forceinline__ float wave_sum(float v) {
#pragma unroll
    for (int o = 1; o < 64; o <<= 1) v += __shfl_xor(v, o);
    return v;
}
__device__ __forceinline__ float wave_max(float v) {
#pragma unroll
    for (int o = 1; o < 64; o <<= 1) v = fmaxf(v, __shfl_xor(v, o));
    return v;
}
__device__ __forceinline__ void wave_sync() { __builtin_amdgcn_fence(__ATOMIC_RELEASE, "wavefront"); __builtin_amdgcn_wave_barrier(); __builtin_amdgcn_fence(__ATOMIC_ACQUIRE, "wavefront"); }

__device__ __forceinline__ int t5_bucket_dev(int rel) {
    const int n = rel < 0 ? -rel : rel;
    const int b = n < 8 ? n : 8 + (n >= 12) + (n >= 16) + (n >= 23) + (n >= 32) + (n >= 46) + (n >= 64) + (n >= 91);
    return b + (rel > 0 ? 16 : 0);
}

struct Frame {
    unsigned char* lds; int tid, lane, wave, G, bid;
    const float *xp, *xs, *g1, *w_in, *gqa, *gka, *t5, *sink, *gqb, *gkb, *rpb, *wbra, *wbrb, *wout, *g2, *wup, *wdn;
    float* out; unsigned char* ws;
};
__device__ __forceinline__ const float* xrow_ptr(const Frame& F, int m) { return m < NP_ROWS ? F.xp + (size_t)m * D : F.xs + (size_t)(m - NP_ROWS) * D; }

__device__ __forceinline__ void p0_transpose_item(const float* W, int K, int N, bf16* WT, int ldk, int koff, const float* kscale, float* scr, int item, int lane) {
    const int nblk = N / 32, kb = item / nblk, nb = item % nblk, k0 = 64 * kb, n0 = 32 * nb;
    float wv[32];
#pragma unroll
    for (int i = 0; i < 32; ++i) { const int kk = 2 * i + (lane >> 5); wv[i] = W[(size_t)(k0 + kk) * N + n0 + (lane & 31)]; }
#pragma unroll
    for (int i = 0; i < 32; ++i) { const int kk = 2 * i + (lane >> 5); float w = wv[i]; if (kscale) w *= kscale[k0 + kk]; scr[kk * 33 + (lane & 31)] = w; }
    wave_sync();
    const int c = lane & 7;
#pragma unroll
    for (int j = 0; j < 4; ++j) { const int n = (lane >> 3) + 8 * j; const float* s = scr + (8 * c) * 33 + n;
        v4u o; o.x = pk2(s[0 * 33], s[1 * 33]); o.y = pk2(s[2 * 33], s[3 * 33]); o.z = pk2(s[4 * 33], s[5 * 33]); o.w = pk2(s[6 * 33], s[7 * 33]);
        *(v4u*)(WT + (size_t)(n0 + n) * ldk + koff + k0 + 8 * c) = o; }
    wave_sync();
}
__device__ __forceinline__ void p0_prologue(Frame& F) {
    float* scr = (float*)(F.lds + F.wave * 16384);
    const int gw = F.bid * NWAVES + F.wave, NGW = F.G * NWAVES;
    constexpr int I_IN = (D / 64) * (INW / 32), I_BR = (1024 / 64) * (D / 32), I_OUT = (D / 64) * (D / 32), I_UP = (D / 64) * (FF / 32), I_DN = (FF / 64) * (D / 32);
    constexpr int NITEMS = I_IN + 2 * I_BR + I_OUT + I_UP + I_DN;
    for (int it = gw; it < NITEMS; it += NGW) {
        int r = it;
        if (r < I_IN) { p0_transpose_item(F.w_in, D, INW, (bf16*)(F.ws + WS_WIN), D, 0, nullptr, scr, r, F.lane); continue; } r -= I_IN;
        if (r < I_BR) { p0_transpose_item(F.wbra, 1024, D, (bf16*)(F.ws + WS_WBR), D, 0, nullptr, scr, r, F.lane); continue; } r -= I_BR;
        if (r < I_BR) { p0_transpose_item(F.wbrb, 1024, D, (bf16*)(F.ws + WS_WBR), D, 1024, nullptr, scr, r, F.lane); continue; } r -= I_BR;
        if (r < I_OUT) { p0_transpose_item(F.wout, D, D, (bf16*)(F.ws + WS_WOUT), D, 0, nullptr, scr, r, F.lane); continue; } r -= I_OUT;
        if (r < I_UP) { p0_transpose_item(F.wup, D, FF, (bf16*)(F.ws + WS_WUP), D, 0, F.g2, scr, r, F.lane); continue; } r -= I_UP;
        p0_transpose_item(F.wdn, FF, D, (bf16*)(F.ws + WS_WDN), FF, 0, nullptr, scr, r, F.lane);
    }
    bf16* H = (bf16*)(F.ws + WS_BUFA);
    for (int m = gw; m < M_ROWS; m += NGW) {
        const f32x4* xr = (const f32x4*)xrow_ptr(F, m) + F.lane; f32x4 v[8]; float s = 0.f;
#pragma unroll
        for (int j = 0; j < 8; ++j) { v[j] = xr[64 * j]; s += (v[j].x * v[j].x + v[j].y * v[j].y) + (v[j].z * v[j].z + v[j].w * v[j].w); }
        const float rstd = 1.0f / sqrtf(wave_sum(s) * (1.f / D) + EPS);
        unsigned long long* o8 = (unsigned long long*)(H + (size_t)m * D) + F.lane; const f32x4* gp = (const f32x4*)F.g1 + F.lane;
#pragma unroll
        for (int j = 0; j < 8; ++j) { const f32x4 g = gp[64 * j]; o8[64 * j] = (unsigned long long)pk2(v[j].x * rstd * g.x, v[j].y * rstd * g.y) | ((unsigned long long)pk2(v[j].z * rstd * g.z, v[j].w * rstd * g.w) << 32); }
    }
    float* BA = (float*)(F.ws + WS_TAB);
    for (int i = F.bid * 512 + F.tid; i < 8 * 257; i += F.G * 512) { const int h = i / 257, rel = i % 257 - 128; BA[i] = F.t5[t5_bucket_dev(rel) * 8 + h]; }
}

struct SeqPos { int base, t, L; };
__device__ __forceinline__ SeqPos seq_of_row(int row) { SeqPos p; if (row < NP_ROWS) { p.base = row & ~4095; p.t = row & 4095; p.L = 4096; } else { const int r2 = row - NP_ROWS; p.base = NP_ROWS + (r2 & ~2047); p.t = r2 & 2047; p.L = 2048; } return p; }
__device__ __forceinline__ float rstd_ss(const float* SS, int row, int hs) { const f32x4 p = *(const f32x4*)(SS + ((size_t)row * 36 + hs) * 4); return 1.0f / sqrtf(((p.x + p.y) + (p.z + p.w)) * (1.f / HD) + EPS); }
__device__ __forceinline__ void naive_core(const Frame& F, float* qs, float* sc, int* kr, int nk, int row, int qoff, int koff, int voff, int hsq, int hsk, const float* gq, const float* gk, bool has_sink, float sinkv, int outcol) {
    const bf16* QKV = (const bf16*)(F.ws + WS_QKV); const float* SS = (const float*)(F.ws + WS_SS); bf16* ATT = (bf16*)(F.ws + WS_BUFA);
    const int lane = F.lane;
    { const unsigned w = *(const unsigned*)(QKV + (size_t)row * QKVW + qoff + 2 * lane); const float sc0 = 0.08838834764831845f;
      qs[2 * lane] = bflo(w) * gq[2 * lane] * gk[2 * lane] * sc0; qs[2 * lane + 1] = bfhi(w) * gq[2 * lane + 1] * gk[2 * lane + 1] * sc0; }
    const float rq = rstd_ss(SS, row, hsq);
    wave_sync();
    float sv[5]; float mx = -1e30f;
#pragma unroll
    for (int i = 0; i < 5; ++i) { const int j = lane + 64 * i; float s = -1e30f;
        if (j < nk && kr[j] >= 0) { const int k = kr[j]; const float rk = rstd_ss(SS, k, hsk); const v4u* kp = (const v4u*)(QKV + (size_t)k * QKVW + koff); float dot = 0.f;
            for (int c = 0; c < 16; ++c) { const v4u w = kp[c]; const float* q = qs + 8 * c;
                dot += q[0] * bflo(w.x) + q[1] * bfhi(w.x) + q[2] * bflo(w.y) + q[3] * bfhi(w.y) + q[4] * bflo(w.z) + q[5] * bfhi(w.z) + q[6] * bflo(w.w) + q[7] * bfhi(w.w); }
            s = dot * rq * rk + sc[j]; }
        sv[i] = s; mx = fmaxf(mx, s); }
    mx = wave_max(mx); if (has_sink) mx = fmaxf(mx, sinkv);
    float sum = 0.f;
#pragma unroll
    for (int i = 0; i < 5; ++i) { sv[i] = __expf(sv[i] - mx); sum += sv[i]; }
    sum = wave_sum(sum); if (has_sink) sum += __expf(sinkv - mx);
    const float inv = 1.0f / sum;
    wave_sync();
#pragma unroll
    for (int i = 0; i < 5; ++i) sc[lane + 64 * i] = sv[i] * inv;
    wave_sync();
    float a0 = 0.f, a1 = 0.f;
    for (int j = 0; j < nk; ++j) { const int k = kr[j]; if (k >= 0) { const float p = sc[j]; const unsigned w = *(const unsigned*)(QKV + (size_t)k * QKVW + voff + 2 * lane); a0 += p * bflo(w); a1 += p * bfhi(w); } }
    *(unsigned*)(ATT + (size_t)row * D + outcol + 2 * lane) = pk2(a0, a1);
    wave_sync();
}
__device__ __forceinline__ void naive_attention(Frame& F) {
    float* qs = (float*)(F.lds + F.wave * 4096); float* sc = qs + 128; int* kr = (int*)(sc + 320);
    const float* BA = (const float*)(F.ws + WS_TAB);
    const int gw = F.bid * NWAVES + F.wave, NGW = F.G * NWAVES, lane = F.lane;
    for (int it = gw; it < M_ROWS * 16; it += NGW) {
        const int row = it >> 4, hh = it & 15; const SeqPos sp = seq_of_row(row);
#ifdef PROBE_ZERO
        if ((PROBE_ZERO == 3) || (PROBE_ZERO == 1 && hh < 8) || (PROBE_ZERO == 2 && hh >= 8)) { *(unsigned*)((bf16*)(F.ws + WS_BUFA) + (size_t)row * D + hh * 128 + 2 * lane) = 0u; continue; }
#endif
        if (hh < 8) {
            const int h = hh, hk = h >> 2;
#pragma unroll
            for (int i = 0; i < 5; ++i) { const int j = lane + 64 * i; const int kt = sp.t - 128 + j; const bool ok = (j < 257) && kt >= 0 && kt < sp.L; kr[j] = ok ? sp.base + kt : -1; sc[j] = ok ? F.t5[t5_bucket_dev(j - 128) * 8 + h] : 0.f; }
            wave_sync();
            naive_core(F, qs, sc, kr, 257, row, h * 128, 1024 + hk * 128, 1280 + hk * 128, h, 8 + hk, F.gqa, F.gka, true, F.sink[h], h * 128);
        } else {
            const int h = hh - 8, rows = sp.L >> 6, r = sp.t >> 6, c = sp.t & 63;
            int rs = r - 4; rs = rs < 0 ? 0 : (rs > rows - 8 ? rows - 8 : rs);
            int cs = c - 8; cs = cs < 0 ? 0 : (cs > 48 ? 48 : cs);
#pragma unroll
            for (int i = 0; i < 5; ++i) { const int j = lane + 64 * i; const int kr_ = rs + (j >> 4), kc = cs + (j & 15); const bool ok = j < 128;
                int dcc = kc - c; dcc = (dcc < -15 ? -15 : (dcc > 15 ? 15 : dcc)) + 15; const int dr = kr_ - r + 7;
                kr[j] = ok ? sp.base + kr_ * 64 + kc : -1; sc[j] = ok ? F.rpb[(h * 15 + dr) * 31 + dcc] : 0.f; }
            wave_sync();
            naive_core(F, qs, sc, kr, 128, row, 1536 + h * 128, 2560 + h * 128, 3584 + h * 128, 12 + h, 20 + h, F.gqb, F.gkb, false, 0.f, 1024 + h * 128);
        }
    }
}


namespace att {
#define ALAS __attribute__((address_space(3)))
typedef short bf16x8 __attribute__((ext_vector_type(8)));
typedef short v4i16_t __attribute__((ext_vector_type(4)));
constexpr int TAB_OFF = 131072;
constexpr float LOG2E = 1.4426950408889634f;
__device__ __forceinline__ size_t hm(int hs, int row) { return ((size_t)hs * M_ROWS + (size_t)row) * 128; }
__device__ __forceinline__ unsigned img_off(int row, int chunk) { return (unsigned)(row * 256 + (((chunk ^ row) & 15) << 4)); }
__device__ __forceinline__ v4i16_t vtr(const ALAS unsigned char* p) { return __builtin_amdgcn_ds_read_tr16_b64_v4i16((ALAS v4i16_t*)p); }
__device__ __forceinline__ unsigned tr_off(int row, int dt, int i16) { const int ch = 2 * dt + ((i16 & 3) >> 1); return (unsigned)(row * 256 + (((ch ^ row) & 15) << 4) + (i16 & 1) * 8); }
__device__ __forceinline__ void load_q(bf16x8 (&qf)[4], const bf16* QKV, int qrow, int qhs, const float* gq, const float* gk, int g) {
#pragma unroll
    for (int ks = 0; ks < 4; ++ks) { const int d0 = 32 * ks + 8 * g; const v4u w = *(const v4u*)(QKV + hm(qhs, qrow) + d0);
        const f32x4 a0 = *(const f32x4*)(gq + d0), a1 = *(const f32x4*)(gq + d0 + 4), b0 = *(const f32x4*)(gk + d0), b1 = *(const f32x4*)(gk + d0 + 4); const float c = 0.08838834764831845f;
        v4u o; o.x = pk2(bflo(w.x) * a0.x * b0.x * c, bfhi(w.x) * a0.y * b0.y * c); o.y = pk2(bflo(w.y) * a0.z * b0.z * c, bfhi(w.y) * a0.w * b0.w * c);
        o.z = pk2(bflo(w.z) * a1.x * b1.x * c, bfhi(w.z) * a1.y * b1.y * c); o.w = pk2(bflo(w.w) * a1.z * b1.z * c, bfhi(w.w) * a1.w * b1.w * c);
        qf[ks] = __builtin_bit_cast(bf16x8, o); }
}
__device__ __forceinline__ bf16x8 pack_p(const f32x4 a, const f32x4 b) { v4u o; o.x = pk2(a[0], a[1]); o.y = pk2(a[2], a[3]); o.z = pk2(b[0], b[1]); o.w = pk2(b[2], b[3]); return __builtin_bit_cast(bf16x8, o); }

#define ATT_DMA(src, q) __builtin_amdgcn_global_load_lds((const unsigned*)(src), (ALAS unsigned*)(L + (q) * 1024), 16, 0, 0)
#define ATT_VMWAIT() asm volatile("s_waitcnt vmcnt(0)" ::: "memory")
struct UnitA { int base, n, Ls, h; };
__device__ __forceinline__ UnitA decode_a(int u) { UnitA x; x.h = u & 7; const int blk = u >> 3;
    if (blk < 256) { x.base = (blk >> 5) * 4096; x.n = blk & 31; x.Ls = 4096; } else { const int b2 = blk - 256; x.base = NP_ROWS + (b2 >> 4) * 2048; x.n = b2 & 15; x.Ls = 2048; } return x; }
__device__ __forceinline__ void stage_a(ALAS unsigned char* L, const bf16* QKV, const UnitA& x, int off, int w, int lane) {
    const int rl = lane >> 4, p = lane & 15, kpos0 = x.n * 128 - 128;
#pragma unroll
    for (int j = 0; j < 12; ++j) { const int q = w + 8 * j, row = 4 * q + rl; int kp = kpos0 + row; kp = kp < 0 ? 0 : (kp > x.Ls - 1 ? x.Ls - 1 : kp);
        ATT_DMA(QKV + hm(off, x.base + kp) + ((p ^ row) & 15) * 8, q); }
}
__device__ __forceinline__ void attn_a(const Frame& F, ALAS unsigned char* L) {
    ALAS float* rkT = (ALAS float*)(L + TAB_OFF); ALAS float* baT = (ALAS float*)(L + TAB_OFF + 2048);
    const bf16* QKV = (const bf16*)(F.ws + WS_QKV); const float* SS = (const float*)(F.ws + WS_SS); bf16* ATT = (bf16*)(F.ws + WS_BUFA);
    const int tid = F.tid, lane = F.lane, w = F.wave, g = lane >> 4, i16 = lane & 15;
    __syncthreads();
    if (F.bid < 2560) { const UnitA x0 = decode_a(F.bid); stage_a(L, QKV, x0, 8 + (x0.h >> 2), w, lane); }
    for (int u = F.bid; u < 2560; u += F.G) {
        const UnitA x = decode_a(u); const int h = x.h, base = x.base, n = x.n, Ls = x.Ls;
        const int hk = h >> 2, voff = 10 + hk, qoff = h, kpos0 = n * 128 - 128;
        if (tid < 384) { int kp = kpos0 + tid; kp = kp < 0 ? 0 : (kp > Ls - 1 ? Ls - 1 : kp); rkT[tid] = rstd_ss(SS, base + kp, 8 + hk); }
        if (tid < 257) baT[tid] = F.t5[t5_bucket_dev(tid - 128) * 8 + h] * LOG2E;
        const int qrow = base + n * 128 + 16 * w + i16; const float rq = rstd_ss(SS, qrow, h) * LOG2E;
        const float* gq_ = F.gqa; const float* gk_ = F.gka; asm volatile("" : "+s"(gq_), "+s"(gk_));
        bf16x8 qf[4]; load_q(qf, QKV, qrow, qoff, gq_, gk_, g);
        ATT_VMWAIT(); __syncthreads();
        f32x4 s[17];
        unsigned kb[4];
#pragma unroll
        for (int ks = 0; ks < 4; ++ks) kb[ks] = img_off(16 * w + i16, 4 * ks + g);
#pragma unroll
        for (int t = 0; t < 17; ++t) { f32x4 acc = {0.f, 0.f, 0.f, 0.f};
#pragma unroll
            for (int ks = 0; ks < 4; ++ks) { const bf16x8 kf = *(const ALAS bf16x8*)(L + kb[ks] + t * 4096); acc = __builtin_amdgcn_mfma_f32_16x16x32_bf16(kf, qf[ks], acc, 0, 0, 0); }
            s[t] = acc; }
        __syncthreads();
        stage_a(L, QKV, x, voff, w, lane);
        int bb = 4 * g - i16; asm volatile("" : "+v"(bb));
        float m = -1e30f;
#pragma unroll
        for (int t = 0; t < 17; ++t) { const int bi0 = 16 * (w + t) + 4 * g; const f32x4 rk4 = *(const ALAS f32x4*)(rkT + bi0);
#pragma unroll
            for (int r = 0; r < 4; ++r) { const int idx = 16 * t + r + bb, kp = kpos0 + bi0 + r; const bool valid = (unsigned)idx <= 256u && kp >= 0 && kp < Ls;
                const int idc = idx < 0 ? 0 : (idx > 256 ? 256 : idx);
                const float v = valid ? s[t][r] * rq * rk4[r] + baT[idc] : -1e30f; s[t][r] = v; m = fmaxf(m, v); } }
        m = fmaxf(m, __shfl_xor(m, 16)); m = fmaxf(m, __shfl_xor(m, 32));
        const float sk2 = F.sink[h] * LOG2E; m = fmaxf(m, sk2);
        float l = 0.f;
#pragma unroll
        for (int t = 0; t < 17; ++t)
#pragma unroll
            for (int r = 0; r < 4; ++r) { const float p = __builtin_amdgcn_exp2f(s[t][r] - m); s[t][r] = p; l += p; }
        l += __shfl_xor(l, 16); l += __shfl_xor(l, 32); l += __builtin_amdgcn_exp2f(sk2 - m);
        bf16x8 pk[9];
#pragma unroll
        for (int kk = 0; kk < 8; ++kk) pk[kk] = pack_p(s[2 * kk], s[2 * kk + 1]);
        pk[8] = pack_p(s[16], (f32x4){0.f, 0.f, 0.f, 0.f});
        ATT_VMWAIT(); __syncthreads();
        f32x4 o[8];
#pragma unroll
        for (int dt = 0; dt < 8; ++dt) o[dt] = (f32x4){0.f, 0.f, 0.f, 0.f};
        unsigned tb[8];
#pragma unroll
        for (int dt = 0; dt < 8; ++dt) tb[dt] = tr_off(16 * w + 4 * g + (i16 >> 2), dt, i16);
        const unsigned t17off = (unsigned)((w == 7 ? 16 : 17) * 4096);
#pragma unroll
        for (int kk = 0; kk < 9; ++kk) { const unsigned offb = kk < 8 ? (unsigned)((2 * kk + 1) * 4096) : t17off;
#pragma unroll
            for (int dt = 0; dt < 8; ++dt) { const v4i16_t lo = vtr(L + tb[dt] + 2 * kk * 4096), hi = vtr(L + tb[dt] + offb);
                const bf16x8 vf = {lo[0], lo[1], lo[2], lo[3], hi[0], hi[1], hi[2], hi[3]};
                o[dt] = __builtin_amdgcn_mfma_f32_16x16x32_bf16(vf, pk[kk], o[dt], 0, 0, 0); } }
        __syncthreads();
        if (u + F.G < 2560) { const UnitA xn = decode_a(u + F.G); stage_a(L, QKV, xn, 8 + (xn.h >> 2), w, lane); }
        const float inv = 1.0f / l; bf16* op = ATT + (size_t)qrow * D + h * 128 + 4 * g;
#pragma unroll
        for (int dt = 0; dt < 8; ++dt) { const unsigned long long v = (unsigned long long)pk2(o[dt][0] * inv, o[dt][1] * inv) | ((unsigned long long)pk2(o[dt][2] * inv, o[dt][3] * inv) << 32); *(unsigned long long*)(op + 16 * dt) = v; }
    }
    ATT_VMWAIT();
}

struct UnitB { int base, r0, rows, kr0, h, half; };
__device__ __forceinline__ UnitB decode_b(int u) { UnitB x; x.h = u & 7; x.half = (u >> 3) & 1; const int rg = u >> 4;
    if (rg < 128) { x.base = (rg >> 4) * 4096; x.r0 = (rg & 15) * 4; x.rows = 64; } else { const int r2 = rg - 128; x.base = NP_ROWS + (r2 >> 3) * 2048; x.r0 = (r2 & 7) * 4; x.rows = 32; }
    int k = x.r0 - 4; x.kr0 = k < 0 ? 0 : (k > x.rows - 11 ? x.rows - 11 : k); return x; }
__device__ __forceinline__ void stage_b(ALAS unsigned char* L, const bf16* QKV, const UnitB& x, int off, int w, int lane) {
    const int rl = lane >> 4, p = lane & 15, col0 = x.half ? 24 : 0;
#pragma unroll
    for (int j = 0; j < 14; ++j) { const int q = w + 8 * j;
        if (q < 110) { const int row = 4 * q + rl, kr = row / 40, kc = row - kr * 40;
            ATT_DMA(QKV + hm(off, x.base + (x.kr0 + kr) * 64 + col0 + kc) + ((p ^ row) & 15) * 8, q); } }
}
__device__ __forceinline__ void attn_b(const Frame& F, ALAS unsigned char* L) {
    ALAS float* rkT = (ALAS float*)(L + TAB_OFF); ALAS float* bT = (ALAS float*)(L + TAB_OFF + 2048);
    const bf16* QKV = (const bf16*)(F.ws + WS_QKV); const float* SS = (const float*)(F.ws + WS_SS); bf16* ATT = (bf16*)(F.ws + WS_BUFA);
    int tid = F.tid, w = F.wave; asm volatile("" : "+v"(tid), "+s"(w));
    const int lane = tid & 63, g = lane >> 4, i16 = lane & 15;
    __syncthreads();
    if (F.bid < 2560) { const UnitB x0 = decode_b(F.bid); stage_b(L, QKV, x0, 20 + x0.h, w, lane); }
    for (int u = F.bid; u < 2560; u += F.G) {
        const UnitB x = decode_b(u); const int h = x.h, half = x.half, base = x.base, r0 = x.r0, rows = x.rows, kr0 = x.kr0;
        const int col0 = half ? 24 : 0, qoff = 12 + h, voff = 28 + h;
        const int r = r0 + (w >> 1), cb = 2 * half + (w & 1), c = 16 * cb + i16;
        int rs = r - 4; rs = rs < 0 ? 0 : (rs > rows - 8 ? rows - 8 : rs);
        int reg = 16 * cb - 8; reg = reg < 0 ? 0 : (reg > 32 ? 32 : reg); int cs = c - 8; cs = cs < 0 ? 0 : (cs > 48 ? 48 : cs);
        const int q0 = (rs - kr0) * 40 + (reg - col0);
        if (tid < 440) { const int kr = tid / 40, kc = tid - kr * 40; rkT[tid] = rstd_ss(SS, base + (kr0 + kr) * 64 + col0 + kc, 20 + h); }
        bT[tid] = tid < 465 ? F.rpb[h * 465 + tid] * LOG2E : 0.f;
        const int qrow = base + r * 64 + c; const float rq = rstd_ss(SS, qrow, 12 + h) * LOG2E;
        const float* gq_ = F.gqb; const float* gk_ = F.gkb; asm volatile("" : "+s"(gq_), "+s"(gk_));
        bf16x8 qf[4]; load_q(qf, QKV, qrow, qoff, gq_, gk_, g);
        ATT_VMWAIT(); __syncthreads();
        f32x4 s[16];
        unsigned kb[4];
#pragma unroll
        for (int ks = 0; ks < 4; ++ks) kb[ks] = img_off(q0 + i16, 4 * ks + g);
#pragma unroll
        for (int t = 0; t < 16; ++t) { f32x4 acc = {0.f, 0.f, 0.f, 0.f};
#pragma unroll
            for (int ks = 0; ks < 4; ++ks) { const bf16x8 kf = *(const ALAS bf16x8*)(L + (kb[ks] ^ (unsigned)(((t >> 1) & 1) << 7)) + (40 * (t >> 1) + 16 * (t & 1)) * 256); acc = __builtin_amdgcn_mfma_f32_16x16x32_bf16(kf, qf[ks], acc, 0, 0, 0); }
            s[t] = acc; }
        __syncthreads();
        stage_b(L, QKV, x, voff, w, lane);
        float m = -1e30f;
#pragma unroll
        for (int t = 0; t < 16; ++t) { const int i = t >> 1, R0 = q0 + 40 * i + 16 * (t & 1) + 4 * g; const f32x4 rk4 = *(const ALAS f32x4*)(rkT + R0); const int kc0 = reg + 16 * (t & 1) + 4 * g, brow = (rs + i - r + 7) * 31 + 15 - c;
#pragma unroll
            for (int rr = 0; rr < 4; ++rr) { const int kc = kc0 + rr; const bool valid = kc >= cs && kc < cs + 16; int bi = brow + kc; bi = bi < 0 ? 0 : (bi > 464 ? 464 : bi);
                const float v = valid ? s[t][rr] * rq * rk4[rr] + bT[bi] : -1e30f; s[t][rr] = v; m = fmaxf(m, v); } }
        m = fmaxf(m, __shfl_xor(m, 16)); m = fmaxf(m, __shfl_xor(m, 32));
        float l = 0.f;
#pragma unroll
        for (int t = 0; t < 16; ++t)
#pragma unroll
            for (int rr = 0; rr < 4; ++rr) { const float p = __builtin_amdgcn_exp2f(s[t][rr] - m); s[t][rr] = p; l += p; }
        l += __shfl_xor(l, 16); l += __shfl_xor(l, 32);
        bf16x8 pk[8];
#pragma unroll
        for (int kk = 0; kk < 8; ++kk) pk[kk] = pack_p(s[2 * kk], s[2 * kk + 1]);
        ATT_VMWAIT(); __syncthreads();
        f32x4 o[8];
#pragma unroll
        for (int d = 0; d < 8; ++d) o[d] = (f32x4){0.f, 0.f, 0.f, 0.f};
        unsigned tb[8];
#pragma unroll
        for (int d = 0; d < 8; ++d) tb[d] = tr_off(q0 + 4 * g + (i16 >> 2), d, i16);
#pragma unroll
        for (int kk = 0; kk < 8; ++kk) {
#pragma unroll
            for (int d = 0; d < 8; ++d) { const unsigned a = (tb[d] ^ (unsigned)((kk & 1) << 7)) + kk * 40 * 256; const v4i16_t lo = vtr(L + a), hi = vtr(L + a + 4096);
                const bf16x8 vf = {lo[0], lo[1], lo[2], lo[3], hi[0], hi[1], hi[2], hi[3]};
                o[d] = __builtin_amdgcn_mfma_f32_16x16x32_bf16(vf, pk[kk], o[d], 0, 0, 0); } }
        __syncthreads();
        if (u + F.G < 2560) { const UnitB xn = decode_b(u + F.G); stage_b(L, QKV, xn, 20 + xn.h, w, lane); }
        const float inv = 1.0f / l; bf16* op = ATT + (size_t)qrow * D + 1024 + h * 128 + 4 * g;
#pragma unroll
        for (int d = 0; d < 8; ++d) { const unsigned long long v = (unsigned long long)pk2(o[d][0] * inv, o[d][1] * inv) | ((unsigned long long)pk2(o[d][2] * inv, o[d][3] * inv) << 32); *(unsigned long long*)(op + 16 * d) = v; }
    }
    ATT_VMWAIT();
}
}

#define XB_TMO      128
#define XB_XCNT(j)  (256  + 64 * (j))
#define XB_XSUB(j)  (1280 + 64 * (j))
#define XB_XGEN(j)  (2304 + 64 * (j))
#define XB_TOP      3328
#define XB_TOPGEN   3392
#define XCD_BAR_WORDS 3456
#define XB_SPIN_CAP (1u << 18)

__device__ __forceinline__ unsigned xb_ld(unsigned* p)              { return __hip_atomic_load(p, __ATOMIC_RELAXED, __HIP_MEMORY_SCOPE_AGENT); }
__device__ __forceinline__ unsigned xb_add(unsigned* p, unsigned v) { return __hip_atomic_fetch_add(p, v, __ATOMIC_RELAXED, __HIP_MEMORY_SCOPE_AGENT); }
__device__ __forceinline__ unsigned xb_xcc_id() { return (unsigned)__builtin_amdgcn_s_getreg((3 << 11) | 20) & 0xFu; }
#define XB_SPIN(cond, bar) do { unsigned _sp = 0; while (cond) { __builtin_amdgcn_s_sleep(1); \
    if ((++_sp & 255u) == 0u) { if (xb_ld(&(bar)[XB_TMO])) break; if (_sp > XB_SPIN_CAP) { atomicAdd(&(bar)[XB_TMO], 1u); break; } } } } while (0)

struct XcdBarrier {
    unsigned* bar; unsigned x;
    volatile LAS unsigned* st;
};

__device__ __forceinline__ XcdBarrier xcd_barrier_post(unsigned* bar, volatile LAS unsigned* st) {
    XcdBarrier b; b.bar = bar; b.x = xb_xcc_id(); b.st = st;
    if (threadIdx.x == 0) (void)xb_add(&bar[XB_XCNT(b.x)], 1u);
    return b;
}
__device__ __forceinline__ void xcd_barrier_complete(unsigned* bar, unsigned x, unsigned& nloc, unsigned& nx) {
    const unsigned G = gridDim.x * gridDim.y * gridDim.z;
    unsigned sum, cnt, mine, sp = 0u;
    for (;;) {
        sum = 0u; cnt = 0u; mine = 0u;
#pragma unroll
        for (unsigned j = 0; j < 16; ++j) { const unsigned c = xb_ld(&bar[XB_XCNT(j)]); sum += c; cnt += (c > 0u) ? 1u : 0u; mine = (j == x) ? c : mine; }
        if (sum == G) break;
        __builtin_amdgcn_s_sleep(1);
        if ((++sp & 255u) == 0u) { if (xb_ld(&bar[XB_TMO])) break; if (sp > XB_SPIN_CAP) { atomicAdd(&bar[XB_TMO], 1u); break; } }
    }
    nloc = mine > 0u ? mine : 1u; nx = cnt > 0u ? cnt : 1u;
}

__device__ __forceinline__ void xcd_barrier(const XcdBarrier& b) {
    asm volatile("s_waitcnt vmcnt(0)" ::: "memory");
    __syncthreads();
    if (threadIdx.x == 0) {
        unsigned* bar = b.bar;
        __builtin_amdgcn_s_waitcnt(0);
        unsigned nloc = b.st[0], nx = b.st[1];
        if (nloc == 0u) { xcd_barrier_complete(bar, b.x, nloc, nx); b.st[0] = nloc; b.st[1] = nx; }
        const unsigned old = xb_add(&bar[XB_XSUB(b.x)], 1u);
        const unsigned gen = old / nloc;
        if (old + 1u == (gen + 1u) * nloc) {
            __builtin_amdgcn_fence(__ATOMIC_RELEASE, "agent");
            asm volatile("s_waitcnt vmcnt(0)" ::: "memory");
            const unsigned og = xb_add(&bar[XB_TOP], 1u);
            const unsigned tg = og / nx;
            if (og + 1u == (tg + 1u) * nx) xb_add(&bar[XB_TOPGEN], 1u);
            else XB_SPIN(xb_ld(&bar[XB_TOPGEN]) == tg, bar);
            __builtin_amdgcn_fence(__ATOMIC_ACQUIRE, "agent");
            xb_add(&bar[XB_XGEN(b.x)], 1u);
            asm volatile("s_waitcnt vmcnt(0)" ::: "memory");
        } else {
            XB_SPIN(xb_ld(&bar[XB_XGEN(b.x)]) == gen, bar);
            __builtin_amdgcn_fence(__ATOMIC_ACQUIRE, "agent");
            asm volatile("s_waitcnt vmcnt(0)" ::: "memory");
        }
    }
    __syncthreads();
}

struct Args { const float* in[17]; float* out; unsigned char* ws; int ph_lo, ph_hi; };
constexpr int N_PHASES = 8;
__global__ void __launch_bounds__(NWAVES * 64, 2) fwd_megakernel(Args args) {
    extern __shared__ __attribute__((aligned(16))) unsigned char lds[];
    cg::grid_group grid = cg::this_grid();
    Frame F;
    F.lds = lds; F.tid = threadIdx.x; F.lane = F.tid & 63; F.wave = __builtin_amdgcn_readfirstlane(F.tid >> 6); F.G = gridDim.x; F.bid = blockIdx.x;
    F.xp = args.in[0]; F.xs = args.in[1]; F.g1 = args.in[2]; F.w_in = args.in[3]; F.gqa = args.in[4]; F.gka = args.in[5]; F.t5 = args.in[6]; F.sink = args.in[7];
    F.gqb = args.in[8]; F.gkb = args.in[9]; F.rpb = args.in[10]; F.wbra = args.in[11]; F.wbrb = args.in[12]; F.wout = args.in[13]; F.g2 = args.in[14]; F.wup = args.in[15]; F.wdn = args.in[16];
    F.out = args.out; F.ws = args.ws;
    unsigned char* ws = args.ws;
    PG8_LAS unsigned char* ldsl = (PG8_LAS unsigned char*)lds;
    const int lo = args.ph_lo, hi = args.ph_hi;
#ifndef PHASE_MASK
#define PHASE_MASK 0xff
#endif
#define IN(k) (((PHASE_MASK >> (k)) & 1) && lo <= (k) && (k) < hi)
#ifdef TSTAMP
    volatile unsigned long long* ts_ = (volatile unsigned long long*)(lds + 139264); int nts_ = 0;
#define STAMP() do { if (F.tid == 0) ts_[nts_] = __builtin_amdgcn_s_memrealtime(); ++nts_; } while (0)
#else
#define STAMP() do {} while (0)
#endif
#define SEAM(k) do { if (IN(k) && IN((k) + 1)) { if ((k) == 0) grid.sync(); else xcd_barrier(xbar); } STAMP(); } while (0)
    bf16* BUFA = (bf16*)(ws + WS_BUFA); bf16* QKV = (bf16*)(ws + WS_QKV); bf16* GATES = (bf16*)(ws + WS_GATES);
    float* SS = (float*)(ws + WS_SS); float* SS2 = (float*)(ws + WS_SS2); float* RSTD2 = (float*)(ws + WS_RSTD2);

    STAMP();
    { volatile LAS unsigned* st_ = (volatile LAS unsigned*)((LAS unsigned char*)lds + 139264 + 256); if (F.tid < 2) st_[F.tid] = 0u; __syncthreads(); }
    XcdBarrier xbar; xbar.bar = (unsigned*)(ws + WS_BAR); xbar.x = 0u; xbar.st = (volatile LAS unsigned*)((LAS unsigned char*)lds + 139264 + 256);
    if (IN(0)) { if (F.bid == 0) for (int i = F.tid; i < XCD_BAR_WORDS; i += NWAVES * 64) ((unsigned*)(ws + WS_BAR))[i] = 0u;
        p0_prologue(F); __syncthreads(); }
    SEAM(0);
    xbar = xcd_barrier_post((unsigned*)(ws + WS_BAR), (volatile LAS unsigned*)((LAS unsigned char*)lds + 139264 + 256));
    if (IN(1)) {
        pg8::Gemm g{BUFA, (const bf16*)(ws + WS_WIN), M_ROWS, INW, D}; pg8::StaticOrder S; S.init(M_ROWS, INW, F.G, F.bid);
        pg8::EpiProj E{QKV, GATES, SS};
        pg8::gemm_phase<pg8::EpiProj, pg8::StaticOrder, true, true>(ldsl, g, S, E);
    }
    SEAM(1);
#ifdef NAIVE_ATTN
    if (IN(2)) { naive_attention(F); __syncthreads(); }
#else
    if (IN(2)) { att::attn_a(F, (ALAS unsigned char*)lds); att::attn_b(F, (ALAS unsigned char*)lds); __syncthreads(); }
#endif
    SEAM(2);
    if (IN(3)) {
        pg8::Gemm g{BUFA, (const bf16*)(ws + WS_WBR), M_ROWS, D, D}; pg8::StaticOrder S; S.init(M_ROWS, D, F.G, F.bid);
        pg8::EpiMerge E{GATES, QKV};
        pg8::gemm_phase<pg8::EpiMerge, pg8::StaticOrder, true, true>(ldsl, g, S, E);
    }
    SEAM(3);
    if (IN(4)) {
        pg8::Gemm g{QKV, (const bf16*)(ws + WS_WOUT), M_ROWS, D, D}; pg8::StaticOrder S; S.init(M_ROWS, D, F.G, F.bid);
        pg8::EpiOut1 E{F.xp, F.xs, F.out, BUFA, SS2};
        pg8::gemm_phase<pg8::EpiOut1, pg8::StaticOrder, true, true>(ldsl, g, S, E);
    }
    SEAM(4);
    if (IN(5)) {
        for (int m = F.bid * 512 + F.tid; m < M_ROWS; m += F.G * 512) { const f32x4* p = (const f32x4*)(SS2 + (size_t)m * 32); float s = 0.f;
#pragma unroll
            for (int j = 0; j < 8; ++j) { const f32x4 v = p[j]; s += (v.x + v.y) + (v.z + v.w); }
            RSTD2[m] = 1.0f / sqrtf(s * (1.f / D) + EPS); }
    }
    SEAM(5);
    if (IN(6)) {
        pg8::Gemm g{BUFA, (const bf16*)(ws + WS_WUP), M_ROWS, FF, D}; pg8::StaticOrder S; S.init(M_ROWS, FF, F.G, F.bid);
        pg8::EpiUp E{RSTD2, QKV};
        pg8::gemm_phase<pg8::EpiUp, pg8::StaticOrder, true, true>(ldsl, g, S, E);
    }
    SEAM(6);
    if (IN(7)) {
        pg8::Gemm g{QKV, (const bf16*)(ws + WS_WDN), M_ROWS, D, FF}; pg8::StaticOrder S; S.init(M_ROWS, D, F.G, F.bid);
        pg8::EpiDown E{F.out, BUFA};
        pg8::gemm_phase<pg8::EpiDown, pg8::StaticOrder, true, true>(ldsl, g, S, E);
    }
#ifdef TSTAMP
    grid.sync();
    __syncthreads();
    if (F.bid == 0) { const float spanA = (float)(ts_[TS_A1] - ts_[TS_A0]) * 0.01f, spanB = (float)(ts_[TS_B1] - ts_[TS_B0]) * 0.01f;
        if (F.tid == 0) F.out[8] += 0.1f * spanA;
        for (int i = F.tid; i < 1024; i += 512) F.out[2048 + i] += 0.01f * spanB; }
#endif
#undef IN
#undef SEAM
}


#ifdef SELFCHECK
__device__ __forceinline__ float bf1(const bf16* p) { return __uint_as_float(((unsigned)*p) << 16); }
__device__ __forceinline__ float rbf(float f) { return __uint_as_float(f2bf(f) << 16); }
__global__ void chk_kernel(Args a, int which) {
    const int lane = threadIdx.x, e = blockIdx.x; unsigned char* ws = a.ws; unsigned* flags = (unsigned*)(ws + WS_TAB + 65536);
    const bf16* BUFA = (const bf16*)(ws + WS_BUFA); const bf16* QKV = (const bf16*)(ws + WS_QKV); const bf16* GATES = (const bf16*)(ws + WS_GATES);
    const float* SS = (const float*)(ws + WS_SS); const float* RSTD2 = (const float*)(ws + WS_RSTD2);
    unsigned h1 = (unsigned)e * 2654435761u + 12345u; h1 ^= h1 >> 15; h1 *= 2246822519u; h1 ^= h1 >> 13; h1 *= 3266489917u; h1 ^= h1 >> 16;
    unsigned h2 = ((unsigned)e + 777u) * 2246822519u; h2 ^= h2 >> 13; h2 *= 2654435761u; h2 ^= h2 >> 16; h2 *= 668265263u; h2 ^= h2 >> 15;
    const int row = (int)(h1 % (unsigned)M_ROWS);
    bool bad = false;
    if (which == 0) { const int col = (int)(h2 % (unsigned)INW); float s = 0.f;
        for (int k = lane; k < D; k += 64) s += bf1(BUFA + (size_t)row * D + k) * rbf(a.in[3][(size_t)k * INW + col]);
        s = wave_sum(s);
        float got, ref; if (col < QKVW) { got = bf1(QKV + (size_t)row * QKVW + col); ref = s; } else { got = bf1(GATES + (size_t)row * GW_ + col - QKVW); ref = 1.f / (1.f + expf(-s)); }
        bad = false; if (fabsf(got - ref) > 0.02f + 0.01f * fabsf(ref) && lane == 0) atomicOr(flags, (col < QKVW ? 1u : 2u) | ((col & 7) < 4 ? 4u : 8u) | ((row & 15) < 8 ? 16u : 32u));
    } else if (which == 1) { const int hs = (int)(h2 % 36u); float s = 0.f;
        for (int c = lane; c < 128; c += 64) { const float v = bf1(QKV + (size_t)row * QKVW + hs * 128 + c); s += v * v; }
        s = wave_sum(s); const float* p = SS + ((size_t)row * 36 + hs) * 4; const float got = p[0] + p[1] + p[2] + p[3];
        bad = fabsf(got - s) > 0.02f * s + 1e-3f;
    } else if (which == 2) { const int col = (int)(h2 % (unsigned)D); float ya = 0.f, yb = 0.f;
        for (int k = lane; k < 1024; k += 64) { ya += bf1(BUFA + (size_t)row * D + k) * rbf(a.in[11][(size_t)k * D + col]); yb += bf1(BUFA + (size_t)row * D + 1024 + k) * rbf(a.in[12][(size_t)k * D + col]); }
        ya = wave_sum(ya); yb = wave_sum(yb);
        const float ref = bf1(GATES + (size_t)row * GW_ + col) * ya + bf1(GATES + (size_t)row * GW_ + 2048 + col) * yb; const float got = bf1(QKV + (size_t)row * D + col);
        bad = fabsf(got - ref) > 0.004f + 0.02f * fabsf(ref);
    } else if (which == 3) { const int col = (int)(h2 % (unsigned)D); float s = 0.f;
        for (int k = lane; k < D; k += 64) s += bf1(QKV + (size_t)row * D + k) * rbf(a.in[13][(size_t)k * D + col]);
        s = wave_sum(s); const float xv = row < NP_ROWS ? a.in[0][(size_t)row * D + col] : a.in[1][(size_t)(row - NP_ROWS) * D + col];
        const float ref = xv + s, got = a.out[(size_t)row * D + col], gotb = bf1(BUFA + (size_t)row * D + col);
        bad = fabsf(got - ref) > 0.004f + 0.002f * fabsf(ref) || fabsf(gotb - ref) > 0.004f + 0.01f * fabsf(ref);
    } else if (which == 4) { float s = 0.f;
        for (int k = lane; k < D; k += 64) { const float v = a.out[(size_t)row * D + k]; s += v * v; }
        s = wave_sum(s); const float ref = 1.f / sqrtf(s / D + EPS); bad = fabsf(RSTD2[row] - ref) > 0.001f * ref;
    } else if (which == 5) { const int col = (int)(h2 % (unsigned)FF); float s = 0.f;
        for (int k = lane; k < D; k += 64) s += bf1(BUFA + (size_t)row * D + k) * rbf(a.in[14][k] * a.in[15][(size_t)k * FF + col]);
        s = wave_sum(s) * RSTD2[row]; const float r = fmaxf(s, 0.f) * fmaxf(s, 0.f); const float got = bf1(QKV + (size_t)row * FF + col);
        bad = fabsf(got - r) > 0.01f + 0.03f * fabsf(r);
    }
    else if (which == 8) { const int col = (int)(h2 % (unsigned)D); float s = 0.f;
        for (int k = lane; k < FF; k += 64) s += bf1(QKV + (size_t)row * FF + k) * rbf(a.in[16][(size_t)k * D + col]);
        s = wave_sum(s); const float ref = bf1(BUFA + (size_t)row * D + col) + s, got = a.out[(size_t)row * D + col];
        bad = fabsf(got - ref) > 0.03f + 0.01f * fabsf(ref);
    }
    else if (which == 6 || which == 7) {
        __shared__ float sh_s[320]; __shared__ int sh_k[320];
        const int h = (int)(h2 % 8u); const bool isA = (which == 6); const SeqPos sp = seq_of_row(row);
        const int qoff = isA ? h * 128 : 1536 + h * 128, koff = isA ? 1024 + (h / 4) * 128 : 2560 + h * 128, voff = isA ? 1280 + (h / 4) * 128 : 3584 + h * 128;
        const float* gq = isA ? a.in[4] : a.in[8]; const float* gk = isA ? a.in[5] : a.in[9];
        float qn[2]; { float q0 = bf1(QKV + (size_t)row * QKVW + qoff + lane), q1 = bf1(QKV + (size_t)row * QKVW + qoff + 64 + lane);
            const float ssq = wave_sum(q0 * q0 + q1 * q1); const float r = 1.f / sqrtf(ssq / 128.f + EPS); qn[0] = q0 * r * gq[lane] * 0.08838834764831845f; qn[1] = q1 * r * gq[64 + lane] * 0.08838834764831845f; }
        int nk = 0;
        if (isA) { nk = 257; for (int j = lane; j < 320; j += 64) { const int kt = sp.t - 128 + j; sh_k[j] = (j < 257 && kt >= 0 && kt < sp.L) ? sp.base + kt : -1; } }
        else { nk = 256; const int rows = sp.L / 64, r = sp.t / 64, c = sp.t % 64; int rs = r - 4; if (rs < 0) rs = 0; if (rs > rows - 8) rs = rows - 8; const int cb = c / 16; int reg = cb * 16 - 8; if (reg < 0) reg = 0; if (reg > 32) reg = 32;
            int sc_ = c - 8; if (sc_ < 0) sc_ = 0; if (sc_ > 48) sc_ = 48;
            for (int j = lane; j < 320; j += 64) { const int kc = reg + (j & 31), kr_ = rs + (j >> 5); sh_k[j] = (j < 256 && kc >= sc_ && kc < sc_ + 16) ? sp.base + kr_ * 64 + kc : -1; } }
        __syncthreads();
        for (int j = 0; j < nk; ++j) { const int k = sh_k[j]; float sv = -1e30f;
            if (k >= 0) { const float k0 = bf1(QKV + (size_t)k * QKVW + koff + lane), k1 = bf1(QKV + (size_t)k * QKVW + koff + 64 + lane);
                const float ssk = wave_sum(k0 * k0 + k1 * k1); const float rk = 1.f / sqrtf(ssk / 128.f + EPS);
                float d = wave_sum(qn[0] * k0 * rk * gk[lane] + qn[1] * k1 * rk * gk[64 + lane]);
                float bias;
                if (isA) { const int rel = (k - sp.base) - sp.t; bias = a.in[6][t5_bucket_dev(rel) * 8 + h]; }
                else { const int kt = k - sp.base, kr_ = kt / 64, kc = kt % 64, r = sp.t / 64, c = sp.t % 64; int dcc = kc - c; if (dcc < -15) dcc = -15; if (dcc > 15) dcc = 15; bias = a.in[10][(h * 15 + (kr_ - r + 7)) * 31 + dcc + 15]; }
                sv = d + bias; }
            if (lane == 0) sh_s[j] = sv; }
        __syncthreads();
        float m = -1e30f; for (int j = 0; j < nk; ++j) m = fmaxf(m, sh_s[j]);
        if (isA) m = fmaxf(m, a.in[7][h]);
        float den = 0.f; for (int j = 0; j < nk; ++j) den += expf(sh_s[j] - m);
        if (isA) den += expf(a.in[7][h] - m);
        float o0 = 0.f, o1 = 0.f;
        for (int j = 0; j < nk; ++j) { const int k = sh_k[j]; if (k >= 0) { const float p = expf(sh_s[j] - m) / den; o0 += p * bf1(QKV + (size_t)k * QKVW + voff + lane); o1 += p * bf1(QKV + (size_t)k * QKVW + voff + 64 + lane); } }
        const int oc = isA ? h * 128 : 1024 + h * 128;
        const float g0 = bf1(BUFA + (size_t)row * D + oc + lane), g1 = bf1(BUFA + (size_t)row * D + oc + 64 + lane);
        const bool b2 = fabsf(g0 - o0) > 0.004f + 0.015f * fabsf(o0) || fabsf(g1 - o1) > 0.004f + 0.015f * fabsf(o1);
        bad = __any(b2);
    }
    if (which == 10) { const float* xr = row < NP_ROWS ? a.in[0] + (size_t)row * D : a.in[1] + (size_t)(row - NP_ROWS) * D; float ss = 0.f;
        for (int k = lane; k < D; k += 64) ss += xr[k] * xr[k];
        ss = wave_sum(ss); const float r = 1.f / sqrtf(ss / D + EPS); bool b2 = false;
        for (int k = lane; k < D; k += 64) { const float ref = xr[k] * r * a.in[2][k], got = bf1(BUFA + (size_t)row * D + k); b2 = b2 || fabsf(got - ref) > 0.002f + 0.006f * fabsf(ref); }
        bad = __any(b2); }
    if (lane == 0 && bad && which == 0) atomicOr(flags, 1u << which);
}
__global__ void chk_final(Args a) { const unsigned f = *(const unsigned*)(a.ws + WS_TAB + 65536); const int i = blockIdx.x * 256 + threadIdx.x; if (i < 4096) { a.out[i] += 100.f * (float)f; a.out[4096 + i] += 30.f; } }
#endif
extern "C" void kernel_launch(void* const* d_in, const int* in_sizes, int n_in, void* d_out, int out_size, void* d_ws, size_t ws_size, hipStream_t stream) {
    static int grid = 0;
    if (grid == 0) {
        if (n_in != 17 || in_sizes[0] != NP_ROWS * D || in_sizes[1] != (M_ROWS - NP_ROWS) * D || out_size != M_ROWS * D || ws_size < WS_END) {
            fprintf(stderr, "kernel_launch: shape/workspace mismatch (n_in %d, in0 %d, out %d, ws %zu < %zu); nothing launched\n", n_in, n_in > 0 ? in_sizes[0] : -1, out_size, ws_size, (size_t)WS_END); grid = -1; return; }
        int dev = 0, cus = 0, per_cu = 0;
        if (hipGetDevice(&dev) != hipSuccess || hipDeviceGetAttribute(&cus, hipDeviceAttributeMultiprocessorCount, dev) != hipSuccess) { fprintf(stderr, "kernel_launch: device query failed\n"); grid = -1; return; }
        if (hipFuncSetAttribute((const void*)fwd_megakernel, hipFuncAttributeMaxDynamicSharedMemorySize, LDS_BYTES) != hipSuccess) { fprintf(stderr, "kernel_launch: hipFuncSetAttribute failed\n"); grid = -1; return; }
        if (hipOccupancyMaxActiveBlocksPerMultiprocessor(&per_cu, (const void*)fwd_megakernel, NWAVES * 64, LDS_BYTES) != hipSuccess || per_cu < 1) { fprintf(stderr, "kernel_launch: occupancy query says %d blocks per CU\n", per_cu); per_cu = 1; }
        (void)hipGetLastError();
        grid = cus * 1;
    }
    if (grid < 0) return;
    Args a{};
    for (int i = 0; i < 17; ++i) a.in[i] = (const float*)d_in[i];
    a.out = (float*)d_out; a.ws = (unsigned char*)d_ws;
#if MK_N_LAUNCHES == 1
    a.ph_lo = 0; a.ph_hi = N_PHASES;
    void* kargs[] = {&a};
    hipError_t e = hipLaunchCooperativeKernel((const void*)fwd_megakernel, dim3(grid), dim3(NWAVES * 64), kargs, LDS_BYTES, stream);
    if (e != hipSuccess) fprintf(stderr, "kernel_launch: cooperative launch failed: %s (grid %d)\n", hipGetErrorString(e), grid);
#else
#ifdef SELFCHECK
    hipMemsetAsync((char*)d_ws + WS_TAB + 65536, 0, 64, stream);
#endif
    for (int ph = 0; ph < N_PHASES; ++ph) {
        a.ph_lo = ph; a.ph_hi = ph + 1;
        hipLaunchKernelGGL(fwd_megakernel, dim3(grid), dim3(NWAVES * 64), LDS_BYTES, stream, a);
        const hipError_t le = hipPeekAtLastError();
        if (le != hipSuccess) { fprintf(stderr, "kernel_launch: launch %d failed: %s\n", ph, hipGetErrorName(le)); break; }
#ifdef SELFCHECK
        if (ph == 0) hipLaunchKernelGGL(chk_kernel, dim3(65536), dim3(64), 0, stream, a, 10);
        if (ph == 1) { hipLaunchKernelGGL(chk_kernel, dim3(65536), dim3(64), 0, stream, a, 0); hipLaunchKernelGGL(chk_kernel, dim3(65536), dim3(64), 0, stream, a, 1); }
        if (ph == 2) { hipLaunchKernelGGL(chk_kernel, dim3(65536), dim3(64), 0, stream, a, 6); hipLaunchKernelGGL(chk_kernel, dim3(65536), dim3(64), 0, stream, a, 7); }
        if (ph == 3) hipLaunchKernelGGL(chk_kernel, dim3(65536), dim3(64), 0, stream, a, 2);
        if (ph == 4) hipLaunchKernelGGL(chk_kernel, dim3(65536), dim3(64), 0, stream, a, 3);
        if (ph == 5) hipLaunchKernelGGL(chk_kernel, dim3(65536), dim3(64), 0, stream, a, 4);
        if (ph == 6) hipLaunchKernelGGL(chk_kernel, dim3(65536), dim3(64), 0, stream, a, 5);
        if (ph == 7) { hipLaunchKernelGGL(chk_kernel, dim3(65536), dim3(64), 0, stream, a, 8); }
        if (ph == 7) hipLaunchKernelGGL(chk_final, dim3(16), dim3(256), 0, stream, a);
#endif
    }
#endif
}
```

```cpp
#include <hip/hip_runtime.h>
#include <hip/hip_cooperative_groups.h>
#include <cstdio>
#include <cstdint>
namespace cg = cooperative_groups;
#define MK_N_LAUNCHES 1
namespace pg8 {
#define PG8_LAS __attribute__((address_space(3)))
typedef unsigned short bf16_t;
typedef short bf16x8 __attribute__((ext_vector_type(8)));
typedef float f32x4 __attribute__((ext_vector_type(4)));
typedef unsigned u32x4 __attribute__((ext_vector_type(4)));
constexpr int BM = 256, BK = 64, HALF = 128, HTB = HALF * BK * 2  , STAGE_BYTES = 8 * HTB, NXCD = 8, WGM = 8;

__host__ __device__ __forceinline__ int lds_byte(int r, int c) { const int st = (r >> 4) * 2 + (c >> 5), rr = r & 15, cc = c & 31, ob = rr * 64 + cc * 2; return st * 1024 + (ob ^ (((ob >> 9) & 1) << 5)); }
__host__ __device__ __forceinline__ void stage_rc(int b, int& R, int& C) { const int st = b / 1024, sb = b % 1024, swz = sb ^ (((sb >> 9) & 1) << 5); R = (st >> 1) * 16 + swz / 64; C = (st & 1) * 32 + (swz % 64) / 2; }
__host__ __device__ __forceinline__ int perm32(int rho) { const int n = rho >> 4, i = rho & 15; return 8 * (i >> 2) + 4 * n + (i & 3); }

struct Unit { int pm, pn; };
struct Gemm { const bf16_t* A; const bf16_t* Bt; int M, N, K; };

struct StaticOrder {
    int nM, nN, nwg, G, c;
    __host__ __device__ void init(int M, int N, int G_, int c_) { nM = M / BM; nN = N / BM; nwg = nM * nN; G = G_; c = c_; }
    __host__ __device__ bool next(int i, Unit& u) const {
        const long L = (long)i * G + c; if (L >= nwg) return false;
        int wgid = (int)L; { const int q = nwg / NXCD, r = nwg % NXCD, xcd = wgid % NXCD, off = wgid / NXCD; wgid = (xcd < r ? xcd * (q + 1) : r * (q + 1) + (xcd - r) * q) + off; }
        const int nig = WGM * nN, gid = wgid / nig, fm = gid * WGM, gsz = (nM - fm) < WGM ? (nM - fm) : WGM;
        u.pm = fm + ((wgid % nig) % gsz); u.pn = (wgid % nig) / gsz; return true;
    }
    __device__ __forceinline__ void a_ready(const Unit&) const {}
    __device__ __forceinline__ void done(const Unit&) const {}
};

__device__ __forceinline__ unsigned cvt_pk_bf16(float lo, float hi) { unsigned r; asm volatile("s_nop 0\n\tv_cvt_pk_bf16_f32 %0, %1, %2" : "=v"(r) : "v"(lo), "v"(hi)); return r; }
typedef float f32x2 __attribute__((ext_vector_type(2)));
typedef unsigned u32x2 __attribute__((ext_vector_type(2)));
__device__ __forceinline__ float bf_lo(unsigned w) { return __uint_as_float(w << 16); }
__device__ __forceinline__ float bf_hi(unsigned w) { return __uint_as_float(w & 0xffff0000u); }
__device__ __forceinline__ u32x4 pack8(const f32x4 v0, const f32x4 v1) { u32x4 w; w.x = cvt_pk_bf16(v0[0], v0[1]); w.y = cvt_pk_bf16(v0[2], v0[3]); w.z = cvt_pk_bf16(v1[0], v1[1]); w.w = cvt_pk_bf16(v1[2], v1[3]); return w; }
__device__ __forceinline__ float sigmoidf_(float x) { return __builtin_amdgcn_rcpf(1.0f + __builtin_amdgcn_exp2f(-1.44269504089f * x)); }
constexpr int QKV_LD = 4608, GATE_LD = 4096, DM = 2048, FFD = 8192, NHS = 36, NPROMPT_ROWS = 32768;

struct EpiProj {
    static constexpr bool PERM = true, AFTER_DRAIN = false, MID = false;
    bf16_t* QKV; bf16_t* GATES; float* SS;
    __device__ __forceinline__ void operator()(const f32x4 (&acc)[2][2][4][2], const Unit& u, int wr, int wc, int fr, int fq) const {
        const int row0 = u.pm * BM + wr * 64 + fr;
        asm volatile("s_nop 15\n\ts_nop 15" ::: "memory");
        if (u.pn < 18) {
            const int col0 = u.pn * BM + wc * 32 + 8 * fq;
#pragma unroll
            for (int ai = 0; ai < 2; ++ai)
#pragma unroll
                for (int m = 0; m < 4; ++m) { const int row = row0 + ai * HALF + m * 16; bf16_t* rowp = QKV + ((size_t)(u.pn * 2) * 40960 + (size_t)row) * 128 + wc * 32 + 8 * fq;
#pragma unroll
                    for (int bj = 0; bj < 2; ++bj) { const f32x4 v0 = acc[ai][bj][m][0], v1 = acc[ai][bj][m][1];
                        float s = (v0[0] * v0[0] + v0[1] * v0[1]) + (v0[2] * v0[2] + v0[3] * v0[3]) + (v1[0] * v1[0] + v1[1] * v1[1]) + (v1[2] * v1[2] + v1[3] * v1[3]);
                        s += __shfl_xor(s, 16); s += __shfl_xor(s, 32);
                        if (fq == 0) SS[((size_t)row * NHS + u.pn * 2 + bj) * 4 + wc] = s;
                        *(u32x4*)(rowp + (size_t)bj * 40960 * 128) = pack8(v0, v1); } }
        } else {
            const int col0 = (u.pn - 18) * BM + wc * 32 + 8 * fq;
#pragma unroll
            for (int ai = 0; ai < 2; ++ai)
#pragma unroll
                for (int m = 0; m < 4; ++m) { const int row = row0 + ai * HALF + m * 16; bf16_t* rowp = GATES + (size_t)row * GATE_LD + col0;
#pragma unroll
                    for (int bj = 0; bj < 2; ++bj) { f32x4 v0 = acc[ai][bj][m][0], v1 = acc[ai][bj][m][1];
#pragma unroll
                        for (int j = 0; j < 4; ++j) { v0[j] = sigmoidf_(v0[j]); v1[j] = sigmoidf_(v1[j]); }
                        *(u32x4*)(rowp + bj * HALF) = pack8(v0, v1); } }
        }
    }
};

struct EpiMerge {
    static constexpr bool PERM = true, AFTER_DRAIN = false, MID = true;
    const bf16_t* GATES; bf16_t* OUT;
    __device__ __forceinline__ void mid(f32x4 (&acc)[2][2][4][2], const Unit& u, int wr, int wc, int fr, int fq) const {
        const int row0 = u.pm * BM + wr * 64 + fr, col0 = u.pn * BM + wc * 32 + 8 * fq;
        const bf16_t* gp0 = GATES + (size_t)row0 * GATE_LD + col0;
        asm volatile("" : "+v"(gp0));
#pragma unroll
        for (int ai = 0; ai < 2; ++ai) { u32x4 ga[4][2], gb[4][2];
#pragma unroll
            for (int m = 0; m < 4; ++m)
#pragma unroll
                for (int bj = 0; bj < 2; ++bj) { const bf16_t* gp = gp0 + (size_t)(ai * HALF + m * 16) * GATE_LD + bj * HALF; ga[m][bj] = *(const u32x4*)gp; gb[m][bj] = *(const u32x4*)(gp + DM); }
#pragma unroll
            for (int m = 0; m < 4; ++m)
#pragma unroll
                for (int bj = 0; bj < 2; ++bj) { const u32x4 a = ga[m][bj], b = gb[m][bj]; f32x4& c0 = acc[ai][bj][m][0]; f32x4& c1 = acc[ai][bj][m][1];
                    c0[0] *= bf_lo(a.x) * __builtin_amdgcn_rcpf(bf_lo(b.x)); c0[1] *= bf_hi(a.x) * __builtin_amdgcn_rcpf(bf_hi(b.x));
                    c0[2] *= bf_lo(a.y) * __builtin_amdgcn_rcpf(bf_lo(b.y)); c0[3] *= bf_hi(a.y) * __builtin_amdgcn_rcpf(bf_hi(b.y));
                    c1[0] *= bf_lo(a.z) * __builtin_amdgcn_rcpf(bf_lo(b.z)); c1[1] *= bf_hi(a.z) * __builtin_amdgcn_rcpf(bf_hi(b.z));
                    c1[2] *= bf_lo(a.w) * __builtin_amdgcn_rcpf(bf_lo(b.w)); c1[3] *= bf_hi(a.w) * __builtin_amdgcn_rcpf(bf_hi(b.w)); }
            asm volatile("" ::: "memory"); }
    }
    __device__ __forceinline__ void operator()(const f32x4 (&acc)[2][2][4][2], const Unit& u, int wr, int wc, int fr, int fq) const {
        const int row0 = u.pm * BM + wr * 64 + fr, col0 = u.pn * BM + wc * 32 + 8 * fq;
        u32x4 gb[2][4][2];
#pragma unroll
        for (int ai = 0; ai < 2; ++ai)
#pragma unroll
            for (int m = 0; m < 4; ++m)
#pragma unroll
                for (int bj = 0; bj < 2; ++bj) gb[ai][m][bj] = *(const u32x4*)(GATES + (size_t)(row0 + ai * HALF + m * 16) * GATE_LD + DM + col0 + bj * HALF);
#pragma unroll
        for (int ai = 0; ai < 2; ++ai)
#pragma unroll
            for (int m = 0; m < 4; ++m) { bf16_t* op = OUT + (size_t)(row0 + ai * HALF + m * 16) * DM + col0;
#pragma unroll
                for (int bj = 0; bj < 2; ++bj) { const u32x4 b = gb[ai][m][bj];
                    f32x4 v0 = acc[ai][bj][m][0], v1 = acc[ai][bj][m][1];
                    v0[0] *= bf_lo(b.x); v0[1] *= bf_hi(b.x); v0[2] *= bf_lo(b.y); v0[3] *= bf_hi(b.y);
                    v1[0] *= bf_lo(b.z); v1[1] *= bf_hi(b.z); v1[2] *= bf_lo(b.w); v1[3] *= bf_hi(b.w);
                    *(u32x4*)(op + bj * HALF) = pack8(v0, v1); } }
    }
};

struct EpiOut1 {
    static constexpr bool PERM = true, AFTER_DRAIN = false, MID = false;
    const float* xp; const float* xs; float* OUT; bf16_t* X1B; float* SS2;
    __device__ __forceinline__ void operator()(const f32x4 (&acc)[2][2][4][2], const Unit& u, int wr, int wc, int fr, int fq) const {
        const int row0 = u.pm * BM + wr * 64 + fr, col0 = u.pn * BM + wc * 32 + 8 * fq;
        const float* xb = (u.pm * BM < NPROMPT_ROWS) ? xp : xs - (size_t)NPROMPT_ROWS * DM;
#pragma unroll
        for (int ai = 0; ai < 2; ++ai) { f32x4 xv[4][2][2];
#pragma unroll
            for (int m = 0; m < 4; ++m)
#pragma unroll
                for (int bj = 0; bj < 2; ++bj) { const float* xr = xb + (size_t)(row0 + ai * HALF + m * 16) * DM + col0 + bj * HALF; xv[m][bj][0] = *(const f32x4*)xr; xv[m][bj][1] = *(const f32x4*)(xr + 4); }
#pragma unroll
            for (int m = 0; m < 4; ++m) { const size_t row = (size_t)(row0 + ai * HALF + m * 16); bf16_t* bp = X1B + row * DM + col0;
                float s = 0.f;
#pragma unroll
                for (int bj = 0; bj < 2; ++bj) { const f32x4 v0 = acc[ai][bj][m][0] + xv[m][bj][0], v1 = acc[ai][bj][m][1] + xv[m][bj][1];
                    s += (v0[0] * v0[0] + v0[1] * v0[1]) + (v0[2] * v0[2] + v0[3] * v0[3]) + (v1[0] * v1[0] + v1[1] * v1[1]) + (v1[2] * v1[2] + v1[3] * v1[3]);
                    *(u32x4*)(bp + bj * HALF) = pack8(v0, v1); }
                s += __shfl_xor(s, 16); s += __shfl_xor(s, 32);
                if (fq == 0) SS2[row * 32 + u.pn * 4 + wc] = s; }
            asm volatile("" ::: "memory"); }
    }
};

struct EpiUp {
    static constexpr bool PERM = true, AFTER_DRAIN = false, MID = false;
    const float* RSTD2; bf16_t* U;
    __device__ __forceinline__ void operator()(const f32x4 (&acc)[2][2][4][2], const Unit& u, int wr, int wc, int fr, int fq) const {
        const int row0 = u.pm * BM + wr * 64 + fr, col0 = u.pn * BM + wc * 32 + 8 * fq;
#pragma unroll
        for (int ai = 0; ai < 2; ++ai)
#pragma unroll
            for (int m = 0; m < 4; ++m) { const size_t row = (size_t)(row0 + ai * HALF + m * 16); const float rs = RSTD2[row]; bf16_t* op = U + row * FFD + col0;
#pragma unroll
                for (int bj = 0; bj < 2; ++bj) { f32x4 v0 = acc[ai][bj][m][0] * rs, v1 = acc[ai][bj][m][1] * rs;
#pragma unroll
                    for (int j = 0; j < 4; ++j) { const float a = fmaxf(v0[j], 0.f), b = fmaxf(v1[j], 0.f); v0[j] = a * a; v1[j] = b * b; }
                    *(u32x4*)(op + bj * HALF) = pack8(v0, v1); } }
    }
};

struct EpiDown {
    static constexpr bool PERM = true, AFTER_DRAIN = false, MID = false;
    float* OUT; const bf16_t* X1B;
    __device__ __forceinline__ void operator()(const f32x4 (&acc)[2][2][4][2], const Unit& u, int wr, int wc, int fr, int fq) const {
        const int row0 = u.pm * BM + wr * 64 + fr, col0 = u.pn * BM + wc * 32 + 8 * fq;
        u32x4 xw[2][4][2];
#pragma unroll
        for (int ai = 0; ai < 2; ++ai)
#pragma unroll
            for (int m = 0; m < 4; ++m)
#pragma unroll
                for (int bj = 0; bj < 2; ++bj) xw[ai][m][bj] = *(const u32x4*)(X1B + (size_t)(row0 + ai * HALF + m * 16) * DM + col0 + bj * HALF);
#pragma unroll
        for (int ai = 0; ai < 2; ++ai)
#pragma unroll
            for (int m = 0; m < 4; ++m) { float* op = OUT + (size_t)(row0 + ai * HALF + m * 16) * DM + col0;
#pragma unroll
                for (int bj = 0; bj < 2; ++bj) { const u32x4 x = xw[ai][m][bj]; f32x4 v0 = acc[ai][bj][m][0], v1 = acc[ai][bj][m][1];
                    v0[0] += bf_lo(x.x); v0[1] += bf_hi(x.x); v0[2] += bf_lo(x.y); v0[3] += bf_hi(x.y); v1[0] += bf_lo(x.z); v1[1] += bf_hi(x.z); v1[2] += bf_lo(x.w); v1[3] += bf_hi(x.w);
                    *(f32x4*)(op + bj * HALF) = v0; *(f32x4*)(op + bj * HALF + 4) = v1; } }
    }
};

template <class Epi, class Sched, bool ALIGN_EPI = false, bool SP2 = false>
__device__ __forceinline__ void gemm_phase(PG8_LAS unsigned char* lds, const Gemm g, const Sched& S, const Epi& E) {
    const int tid = threadIdx.x, wid = __builtin_amdgcn_readfirstlane(tid >> 6), lane = tid & 63, wr = wid >> 2, wc = wid & 3, fr = lane & 15, fq = lane >> 4;
    const int K = g.K, nt = K / BK;
    unsigned voffA[2], voffB[2];
#pragma unroll
    for (int i = 0; i < 2; ++i) { int R, C; stage_rc(tid * 16 + i * 8192, R, C); const int Rb = Epi::PERM ? ((R & ~31) + perm32(R & 31)) : R;
        voffA[i] = (unsigned)(R * K + C) * 2u; voffB[i] = (unsigned)(Rb * K + C) * 2u; }
    const size_t kstep = (size_t)(BK * 2);
    const size_t hstep = (size_t)HALF * K * 2;
    const size_t tstep = 2 * hstep;
    const unsigned ldsw = (unsigned)wid * 1024u;
    const int aoff = lds_byte(wr * 64 + fr, fq * 8), boff = lds_byte(wc * 32 + fr, fq * 8);
#define PG8_SA(b, h) (((b) * 2 + (h)) * HTB)
#define PG8_SB(b, h) ((4 + (b) * 2 + (h)) * HTB)
#define PG8_STAGE(bufoff, gbase, voff) do { _Pragma("unroll") for (int _i = 0; _i < 2; ++_i) \
        __builtin_amdgcn_global_load_lds((const unsigned*)((const char*)(gbase) + (voff)[_i]), (PG8_LAS unsigned*)(lds + (bufoff) + ldsw + _i * 8192), 16, 0, 0); } while (0)
#define PG8_LDA(dst, b, h) do { _Pragma("unroll") for (int m = 0; m < 4; ++m) _Pragma("unroll") for (int k = 0; k < 2; ++k) dst[m][k] = *(const PG8_LAS bf16x8*)(lds + PG8_SA(b, h) + aoff + m * 2048 + k * 1024); } while (0)
#define PG8_LDB(dst, b, h) do { _Pragma("unroll") for (int n = 0; n < 2; ++n) _Pragma("unroll") for (int k = 0; k < 2; ++k) dst[n][k] = *(const PG8_LAS bf16x8*)(lds + PG8_SB(b, h) + boff + n * 2048 + k * 1024); } while (0)
#define PG8_MMA(ai, bj, At, Bt) do { __builtin_amdgcn_s_setprio(1); _Pragma("unroll") for (int m = 0; m < 4; ++m) _Pragma("unroll") for (int n = 0; n < 2; ++n) _Pragma("unroll") for (int k = 0; k < 2; ++k) \
        acc[ai][bj][m][n] = __builtin_amdgcn_mfma_f32_16x16x32_bf16(Bt[n][k], At[m][k], acc[ai][bj][m][n], 0, 0, 0); __builtin_amdgcn_s_setprio(0); } while (0)
#define PG8_WAIT_V(n) asm volatile("s_waitcnt vmcnt(" #n ")" ::: "memory")
#define PG8_WAIT_L(n) asm volatile("s_waitcnt lgkmcnt(" #n ")" ::: "memory")
#define PG8_BAR __builtin_amdgcn_s_barrier()
#define PG8_SCHED __builtin_amdgcn_sched_barrier(0)
    Unit cur, nxt; int ui = 0;
    if (!S.next(0, cur)) return;
    f32x4 acc[2][2][4][2];
#pragma unroll
    for (int a = 0; a < 2; ++a)
#pragma unroll
        for (int b = 0; b < 2; ++b)
#pragma unroll
            for (int m = 0; m < 4; ++m)
#pragma unroll
                for (int n = 0; n < 2; ++n) acc[a][b][m][n] = (f32x4){0.f, 0.f, 0.f, 0.f};
    bf16x8 At[4][2], B0[2][2], B1[2][2];
    const char* cA = (const char*)g.A + (size_t)cur.pm * tstep; const char* cB = (const char*)g.Bt + (size_t)cur.pn * tstep;
    S.a_ready(cur);
    if constexpr (SP2) {
        PG8_STAGE(PG8_SB(0, 0), cB, voffB); PG8_STAGE(PG8_SB(0, 1), cB + hstep, voffB); PG8_STAGE(PG8_SA(0, 0), cA, voffA); PG8_STAGE(PG8_SA(0, 1), cA + hstep, voffA);
        if (wr == 1) PG8_BAR;
        PG8_WAIT_V(2); PG8_BAR;
        PG8_STAGE(PG8_SB(1, 0), cB + kstep, voffB); PG8_STAGE(PG8_SA(1, 0), cA + kstep, voffA); PG8_STAGE(PG8_SB(1, 1), cB + hstep + kstep, voffB);
        PG8_WAIT_V(6); PG8_BAR;
    } else {
        PG8_STAGE(PG8_SB(0, 0), cB, voffB); PG8_STAGE(PG8_SA(0, 0), cA, voffA); PG8_STAGE(PG8_SB(0, 1), cB + hstep, voffB); PG8_STAGE(PG8_SA(0, 1), cA + hstep, voffA);
        if (wr == 1) PG8_BAR;
        PG8_WAIT_V(4); PG8_BAR;
        PG8_STAGE(PG8_SB(1, 0), cB + kstep, voffB); PG8_STAGE(PG8_SA(1, 0), cA + kstep, voffA); PG8_STAGE(PG8_SB(1, 1), cB + hstep + kstep, voffB);
        PG8_WAIT_V(6); PG8_BAR;
    }
    for (;;) {
        const bool has_next = S.next(ui + 1, nxt);
        const char* nA = has_next ? (const char*)g.A + (size_t)nxt.pm * tstep : cA; const char* nB = has_next ? (const char*)g.Bt + (size_t)nxt.pn * tstep : cB;
        constexpr int NSEG = Epi::MID ? 2 : 1; const int seglen = nt / NSEG;
        for (int seg = 0; seg < NSEG; ++seg) {
        if constexpr (Epi::MID) { if (seg == 1) E.mid(acc, cur, wr, wc, fr, fq); }
        for (int t = seg * seglen; t < (seg + 1) * seglen; t += 2) {
            const bool last = (t == nt - 2);
            const char* a1 = cA + (size_t)(t + 1) * kstep;
            const char* a2 = last ? nA : cA + (size_t)(t + 2) * kstep; const char* b2 = last ? nB : cB + (size_t)(t + 2) * kstep;
            const char* a3 = a2 + kstep; const char* b3 = b2 + kstep;
            if (last && has_next) S.a_ready(nxt);
            if constexpr (SP2) {
            PG8_LDB(B0, 0, 0); PG8_LDB(B1, 0, 1); PG8_SCHED; PG8_LDA(At, 0, 0); PG8_STAGE(PG8_SA(1, 1), a1 + hstep, voffA);
            PG8_WAIT_V(8); PG8_WAIT_L(0); PG8_BAR; PG8_MMA(0, 0, At, B0); PG8_MMA(0, 1, At, B1); PG8_BAR; PG8_SCHED;
            PG8_LDA(At, 0, 1); PG8_STAGE(PG8_SB(0, 0), b2, voffB); PG8_STAGE(PG8_SB(0, 1), b2 + hstep, voffB); PG8_STAGE(PG8_SA(0, 0), a2, voffA);
            PG8_WAIT_V(8); PG8_WAIT_L(0); PG8_BAR; PG8_MMA(1, 0, At, B0); PG8_MMA(1, 1, At, B1); PG8_BAR; PG8_SCHED;
            PG8_LDB(B0, 1, 0); PG8_LDB(B1, 1, 1); PG8_SCHED; PG8_LDA(At, 1, 0); PG8_STAGE(PG8_SA(0, 1), a2 + hstep, voffA);
            PG8_WAIT_V(8); PG8_WAIT_L(0); PG8_BAR; PG8_MMA(0, 0, At, B0); PG8_MMA(0, 1, At, B1); PG8_BAR; PG8_SCHED;
            PG8_LDA(At, 1, 1); PG8_STAGE(PG8_SB(1, 0), b3, voffB); PG8_STAGE(PG8_SB(1, 1), b3 + hstep, voffB); PG8_STAGE(PG8_SA(1, 0), a3, voffA);
            PG8_WAIT_V(8); PG8_WAIT_L(0); PG8_BAR; PG8_MMA(1, 0, At, B0); PG8_MMA(1, 1, At, B1); PG8_BAR; PG8_SCHED;
            } else {
            PG8_LDB(B0, 0, 0); PG8_SCHED; PG8_LDA(At, 0, 0); PG8_STAGE(PG8_SA(1, 1), a1 + hstep, voffA);
            PG8_WAIT_L(8); PG8_BAR; PG8_WAIT_L(0); PG8_MMA(0, 0, At, B0); PG8_BAR; PG8_SCHED;
            PG8_LDB(B1, 0, 1); PG8_STAGE(PG8_SB(0, 0), b2, voffB);
            PG8_BAR; PG8_WAIT_L(0); PG8_MMA(0, 1, At, B1); PG8_BAR;
            PG8_LDA(At, 0, 1); PG8_STAGE(PG8_SA(0, 0), a2, voffA);
            PG8_BAR; PG8_WAIT_L(0); PG8_MMA(1, 0, At, B0); PG8_BAR; PG8_SCHED;
            PG8_STAGE(PG8_SB(0, 1), b2 + hstep, voffB);
            PG8_WAIT_V(6); PG8_BAR; PG8_MMA(1, 1, At, B1); PG8_BAR;
            PG8_LDB(B0, 1, 0); PG8_SCHED; PG8_LDA(At, 1, 0); PG8_STAGE(PG8_SA(0, 1), a2 + hstep, voffA);
            PG8_WAIT_L(8); PG8_BAR; PG8_WAIT_L(0); PG8_MMA(0, 0, At, B0); PG8_BAR; PG8_SCHED;
            PG8_LDB(B1, 1, 1); PG8_STAGE(PG8_SB(1, 0), b3, voffB);
            PG8_BAR; PG8_WAIT_L(0); PG8_MMA(0, 1, At, B1); PG8_BAR;
            PG8_LDA(At, 1, 1); PG8_STAGE(PG8_SA(1, 0), a3, voffA);
            PG8_BAR; PG8_WAIT_L(0); PG8_MMA(1, 0, At, B0); PG8_BAR; PG8_SCHED;
            PG8_STAGE(PG8_SB(1, 1), b3 + hstep, voffB);
            PG8_WAIT_V(6); PG8_BAR; PG8_MMA(1, 1, At, B1); PG8_BAR;
            }
        }
        }
        if constexpr (ALIGN_EPI) { if (wr == 0) PG8_BAR; }
        if constexpr (!Epi::AFTER_DRAIN) { E(acc, cur, wr, wc, fr, fq); S.done(cur); }
        if (!has_next) break;
#pragma unroll
        for (int a = 0; a < 2; ++a)
#pragma unroll
            for (int b = 0; b < 2; ++b)
#pragma unroll
                for (int m = 0; m < 4; ++m)
#pragma unroll
                    for (int n = 0; n < 2; ++n) acc[a][b][m][n] = (f32x4){0.f, 0.f, 0.f, 0.f};
        cur = nxt; cA = nA; cB = nB; ++ui;
        if constexpr (ALIGN_EPI) { if (wr == 1) PG8_BAR; }
    }
    PG8_WAIT_V(0);
    if constexpr (!ALIGN_EPI) { if (wr == 0) PG8_BAR; }
    PG8_BAR;
    if constexpr (Epi::AFTER_DRAIN) { E.fused(acc, cur, wr, wc, fr, fq, lds, wid, lane); S.done(cur); }
#undef PG8_SA
#undef PG8_SB
#undef PG8_STAGE
#undef PG8_LDA
#undef PG8_LDB
#undef PG8_MMA
#undef PG8_WAIT_V
#undef PG8_WAIT_L
#undef PG8_BAR
#undef PG8_SCHED
}
}
#ifndef MK_N_LAUNCHES
#define MK_N_LAUNCHES 1
#endif
constexpr int NWAVES = 8;
constexpr int M_ROWS = 40960, NP_ROWS = 32768, D = 2048, FF = 8192, INW = 8704, QKVW = 4608, GW_ = 4096, HD = 128;
constexpr float EPS = 1e-6f;
constexpr size_t MiB = 1u << 20;
constexpr size_t WS_TAB = 0;
constexpr size_t WS_BAR = 128 * 1024;
constexpr size_t WS_RSTD2 = 1 * MiB;
constexpr size_t WS_SS2 = 2 * MiB;
constexpr size_t WS_SS = 8 * MiB;
constexpr size_t WS_WIN = 32 * MiB;
constexpr size_t WS_WBR = 66 * MiB;
constexpr size_t WS_WOUT = 74 * MiB;
constexpr size_t WS_WUP = 82 * MiB;
constexpr size_t WS_WDN = 114 * MiB;
constexpr size_t WS_BUFA = 146 * MiB;
constexpr size_t WS_QKV = 306 * MiB;
constexpr size_t WS_GATES = 666 * MiB;
constexpr size_t WS_END = 986 * MiB;
constexpr int LDS_BYTES = 147456;

#define LAS __attribute__((address_space(3)))
typedef unsigned short bf16;
typedef unsigned v4u __attribute__((ext_vector_type(4)));
typedef float f32x4 __attribute__((ext_vector_type(4)));
#define LDS_WAIT() asm volatile("s_waitcnt lgkmcnt(0)" ::: "memory")
__device__ __forceinline__ unsigned f2bf(float f) { unsigned u = __builtin_bit_cast(unsigned, f); return (u + 0x7fffu + ((u >> 16) & 1u)) >> 16; }
__device__ __forceinline__ unsigned pk2(float lo, float hi) { return f2bf(lo) | (f2bf(hi) << 16); }
__device__ __forceinline__ float bflo(unsigned w) { return __uint_as_float(w << 16); }
__device__ __forceinline__ float bfhi(unsigned w) { return __uint_as_float(w & 0xffff0000u); }
__device__ __forceinline__ float wave_sum(float v) {
#pragma unroll
    for (int o = 1; o < 64; o <<= 1) v += __shfl_xor(v, o);
    return v;
}
__device__ __forceinline__ float wave_max(float v) {
#pragma unroll
    for (int o = 1; o < 64; o <<= 1) v = fmaxf(v, __shfl_xor(v, o));
    return v;
}
__device__ __forceinline__ void wave_sync() { __builtin_amdgcn_fence(__ATOMIC_RELEASE, "wavefront"); __builtin_amdgcn_wave_barrier(); __builtin_amdgcn_fence(__ATOMIC_ACQUIRE, "wavefront"); }

__device__ __forceinline__ int t5_bucket_dev(int rel) {
    const int n = rel < 0 ? -rel : rel;
    const int b = n < 8 ? n : 8 + (n >= 12) + (n >= 16) + (n >= 23) + (n >= 32) + (n >= 46) + (n >= 64) + (n >= 91);
    return b + (rel > 0 ? 16 : 0);
}

struct Frame {
    unsigned char* lds; int tid, lane, wave, G, bid;
    const float *xp, *xs, *g1, *w_in, *gqa, *gka, *t5, *sink, *gqb, *gkb, *rpb, *wbra, *wbrb, *wout, *g2, *wup, *wdn;
    float* out; unsigned char* ws;
};
__device__ __forceinline__ const float* xrow_ptr(const Frame& F, int m) { return m < NP_ROWS ? F.xp + (size_t)m * D : F.xs + (size_t)(m - NP_ROWS) * D; }

__device__ __forceinline__ void p0_transpose_item(const float* W, int K, int N, bf16* WT, int ldk, int koff, const float* kscale, float* scr, int item, int lane) {
    const int nblk = N / 32, kb = item / nblk, nb = item % nblk, k0 = 64 * kb, n0 = 32 * nb;
    float wv[32];
#pragma unroll
    for (int i = 0; i < 32; ++i) { const int kk = 2 * i + (lane >> 5); wv[i] = W[(size_t)(k0 + kk) * N + n0 + (lane & 31)]; }
#pragma unroll
    for (int i = 0; i < 32; ++i) { const int kk = 2 * i + (lane >> 5); float w = wv[i]; if (kscale) w *= kscale[k0 + kk]; scr[kk * 33 + (lane & 31)] = w; }
    wave_sync();
    const int c = lane & 7;
#pragma unroll
    for (int j = 0; j < 4; ++j) { const int n = (lane >> 3) + 8 * j; const float* s = scr + (8 * c) * 33 + n;
        v4u o; o.x = pk2(s[0 * 33], s[1 * 33]); o.y = pk2(s[2 * 33], s[3 * 33]); o.z = pk2(s[4 * 33], s[5 * 33]); o.w = pk2(s[6 * 33], s[7 * 33]);
        *(v4u*)(WT + (size_t)(n0 + n) * ldk + koff + k0 + 8 * c) = o; }
    wave_sync();
}
__device__ __forceinline__ void p0_prologue(Frame& F) {
    float* scr = (float*)(F.lds + F.wave * 16384);
    const int gw = F.bid * NWAVES + F.wave, NGW = F.G * NWAVES;
    constexpr int I_IN = (D / 64) * (INW / 32), I_BR = (1024 / 64) * (D / 32), I_OUT = (D / 64) * (D / 32), I_UP = (D / 64) * (FF / 32), I_DN = (FF / 64) * (D / 32);
    constexpr int NITEMS = I_IN + 2 * I_BR + I_OUT + I_UP + I_DN;
    for (int it = gw; it < NITEMS; it += NGW) {
        int r = it;
        if (r < I_IN) { p0_transpose_item(F.w_in, D, INW, (bf16*)(F.ws + WS_WIN), D, 0, nullptr, scr, r, F.lane); continue; } r -= I_IN;
        if (r < I_BR) { p0_transpose_item(F.wbra, 1024, D, (bf16*)(F.ws + WS_WBR), D, 0, nullptr, scr, r, F.lane); continue; } r -= I_BR;
        if (r < I_BR) { p0_transpose_item(F.wbrb, 1024, D, (bf16*)(F.ws + WS_WBR), D, 1024, nullptr, scr, r, F.lane); continue; } r -= I_BR;
        if (r < I_OUT) { p0_transpose_item(F.wout, D, D, (bf16*)(F.ws + WS_WOUT), D, 0, nullptr, scr, r, F.lane); continue; } r -= I_OUT;
        if (r < I_UP) { p0_transpose_item(F.wup, D, FF, (bf16*)(F.ws + WS_WUP), D, 0, F.g2, scr, r, F.lane); continue; } r -= I_UP;
        p0_transpose_item(F.wdn, FF, D, (bf16*)(F.ws + WS_WDN), FF, 0, nullptr, scr, r, F.lane);
    }
    bf16* H = (bf16*)(F.ws + WS_BUFA);
    for (int m = gw; m < M_ROWS; m += NGW) {
        const f32x4* xr = (const f32x4*)xrow_ptr(F, m) + F.lane; f32x4 v[8]; float s = 0.f;
#pragma unroll
        for (int j = 0; j < 8; ++j) { v[j] = xr[64 * j]; s += (v[j].x * v[j].x + v[j].y * v[j].y) + (v[j].z * v[j].z + v[j].w * v[j].w); }
        const float rstd = 1.0f / sqrtf(wave_sum(s) * (1.f / D) + EPS);
        unsigned long long* o8 = (unsigned long long*)(H + (size_t)m * D) + F.lane; const f32x4* gp = (const f32x4*)F.g1 + F.lane;
#pragma unroll
        for (int j = 0; j < 8; ++j) { const f32x4 g = gp[64 * j]; o8[64 * j] = (unsigned long long)pk2(v[j].x * rstd * g.x, v[j].y * rstd * g.y) | ((unsigned long long)pk2(v[j].z * rstd * g.z, v[j].w * rstd * g.w) << 32); }
    }
}

__device__ __forceinline__ float rstd_ss(const float* SS, int row, int hs) { const f32x4 p = *(const f32x4*)(SS + ((size_t)row * 36 + hs) * 4); return 1.0f / sqrtf(((p.x + p.y) + (p.z + p.w)) * (1.f / HD) + EPS); }

namespace att {
#define ALAS __attribute__((address_space(3)))
typedef short bf16x8 __attribute__((ext_vector_type(8)));
typedef short v4i16_t __attribute__((ext_vector_type(4)));
constexpr int TAB_OFF = 131072;
constexpr float LOG2E = 1.4426950408889634f;
__device__ __forceinline__ size_t hm(int hs, int row) { return ((size_t)hs * M_ROWS + (size_t)row) * 128; }
__device__ __forceinline__ unsigned img_off(int row, int chunk) { return (unsigned)(row * 256 + (((chunk ^ row) & 15) << 4)); }
__device__ __forceinline__ v4i16_t vtr(const ALAS unsigned char* p) { return __builtin_amdgcn_ds_read_tr16_b64_v4i16((ALAS v4i16_t*)p); }
__device__ __forceinline__ unsigned tr_off(int row, int dt, int i16) { const int ch = 2 * dt + ((i16 & 3) >> 1); return (unsigned)(row * 256 + (((ch ^ row) & 15) << 4) + (i16 & 1) * 8); }
__device__ __forceinline__ void load_q(bf16x8 (&qf)[4], const bf16* QKV, int qrow, int qhs, const float* gq, const float* gk, int g) {
#pragma unroll
    for (int ks = 0; ks < 4; ++ks) { const int d0 = 32 * ks + 8 * g; const v4u w = *(const v4u*)(QKV + hm(qhs, qrow) + d0);
        const f32x4 a0 = *(const f32x4*)(gq + d0), a1 = *(const f32x4*)(gq + d0 + 4), b0 = *(const f32x4*)(gk + d0), b1 = *(const f32x4*)(gk + d0 + 4); const float c = 0.08838834764831845f;
        v4u o; o.x = pk2(bflo(w.x) * a0.x * b0.x * c, bfhi(w.x) * a0.y * b0.y * c); o.y = pk2(bflo(w.y) * a0.z * b0.z * c, bfhi(w.y) * a0.w * b0.w * c);
        o.z = pk2(bflo(w.z) * a1.x * b1.x * c, bfhi(w.z) * a1.y * b1.y * c); o.w = pk2(bflo(w.w) * a1.z * b1.z * c, bfhi(w.w) * a1.w * b1.w * c);
        qf[ks] = __builtin_bit_cast(bf16x8, o); }
}
__device__ __forceinline__ bf16x8 pack_p(const f32x4 a, const f32x4 b) { v4u o; o.x = pk2(a[0], a[1]); o.y = pk2(a[2], a[3]); o.z = pk2(b[0], b[1]); o.w = pk2(b[2], b[3]); return __builtin_bit_cast(bf16x8, o); }

#define ATT_DMA(src, q) __builtin_amdgcn_global_load_lds((const unsigned*)(src), (ALAS unsigned*)(L + (q) * 1024), 16, 0, 0)
#define ATT_VMWAIT() asm volatile("s_waitcnt vmcnt(0)" ::: "memory")
struct UnitA { int base, n, Ls, h; };
__device__ __forceinline__ UnitA decode_a(int u) { UnitA x; x.h = u & 7; const int blk = u >> 3;
    if (blk < 256) { x.base = (blk >> 5) * 4096; x.n = blk & 31; x.Ls = 4096; } else { const int b2 = blk - 256; x.base = NP_ROWS + (b2 >> 4) * 2048; x.n = b2 & 15; x.Ls = 2048; } return x; }
__device__ __forceinline__ void stage_a(ALAS unsigned char* L, const bf16* QKV, const UnitA& x, int off, int w, int lane) {
    const int rl = lane >> 4, p = lane & 15, kpos0 = x.n * 128 - 128;
#pragma unroll
    for (int j = 0; j < 12; ++j) { const int q = w + 8 * j, row = 4 * q + rl; int kp = kpos0 + row; kp = kp < 0 ? 0 : (kp > x.Ls - 1 ? x.Ls - 1 : kp);
        ATT_DMA(QKV + hm(off, x.base + kp) + ((p ^ row) & 15) * 8, q); }
}
__device__ __forceinline__ void attn_a(const Frame& F, ALAS unsigned char* L) {
    ALAS float* rkT = (ALAS float*)(L + TAB_OFF); ALAS float* baT = (ALAS float*)(L + TAB_OFF + 2048);
    const bf16* QKV = (const bf16*)(F.ws + WS_QKV); const float* SS = (const float*)(F.ws + WS_SS); bf16* ATT = (bf16*)(F.ws + WS_BUFA);
    const int tid = F.tid, lane = F.lane, w = F.wave, g = lane >> 4, i16 = lane & 15;
    __syncthreads();
    if (F.bid < 2560) { const UnitA x0 = decode_a(F.bid); stage_a(L, QKV, x0, 8 + (x0.h >> 2), w, lane); }
    for (int u = F.bid; u < 2560; u += F.G) {
        const UnitA x = decode_a(u); const int h = x.h, base = x.base, n = x.n, Ls = x.Ls;
        const int hk = h >> 2, voff = 10 + hk, qoff = h, kpos0 = n * 128 - 128;
        if (tid < 384) { int kp = kpos0 + tid; kp = kp < 0 ? 0 : (kp > Ls - 1 ? Ls - 1 : kp); rkT[tid] = rstd_ss(SS, base + kp, 8 + hk); }
        if (tid < 257) baT[tid] = F.t5[t5_bucket_dev(tid - 128) * 8 + h] * LOG2E;
        const int qrow = base + n * 128 + 16 * w + i16; const float rq = rstd_ss(SS, qrow, h) * LOG2E;
        const float* gq_ = F.gqa; const float* gk_ = F.gka; asm volatile("" : "+s"(gq_), "+s"(gk_));
        bf16x8 qf[4]; load_q(qf, QKV, qrow, qoff, gq_, gk_, g);
        ATT_VMWAIT(); __syncthreads();
        f32x4 s[17];
        unsigned kb[4];
#pragma unroll
        for (int ks = 0; ks < 4; ++ks) kb[ks] = img_off(16 * w + i16, 4 * ks + g);
#pragma unroll
        for (int t = 0; t < 17; ++t) { f32x4 acc = {0.f, 0.f, 0.f, 0.f};
#pragma unroll
            for (int ks = 0; ks < 4; ++ks) { const bf16x8 kf = *(const ALAS bf16x8*)(L + kb[ks] + t * 4096); acc = __builtin_amdgcn_mfma_f32_16x16x32_bf16(kf, qf[ks], acc, 0, 0, 0); }
            s[t] = acc; }
        __syncthreads();
        stage_a(L, QKV, x, voff, w, lane);
        int bb = 4 * g - i16; asm volatile("" : "+v"(bb));
        float m = -1e30f;
#pragma unroll
        for (int t = 0; t < 17; ++t) { const int bi0 = 16 * (w + t) + 4 * g; const f32x4 rk4 = *(const ALAS f32x4*)(rkT + bi0);
#pragma unroll
            for (int r = 0; r < 4; ++r) { const int idx = 16 * t + r + bb, kp = kpos0 + bi0 + r; const bool valid = (unsigned)idx <= 256u && kp >= 0 && kp < Ls;
                const int idc = idx < 0 ? 0 : (idx > 256 ? 256 : idx);
                const float v = valid ? s[t][r] * rq * rk4[r] + baT[idc] : -1e30f; s[t][r] = v; m = fmaxf(m, v); } }
        m = fmaxf(m, __shfl_xor(m, 16)); m = fmaxf(m, __shfl_xor(m, 32));
        const float sk2 = F.sink[h] * LOG2E; m = fmaxf(m, sk2);
        float l = 0.f;
#pragma unroll
        for (int t = 0; t < 17; ++t)
#pragma unroll
            for (int r = 0; r < 4; ++r) { const float p = __builtin_amdgcn_exp2f(s[t][r] - m); s[t][r] = p; l += p; }
        l += __shfl_xor(l, 16); l += __shfl_xor(l, 32); l += __builtin_amdgcn_exp2f(sk2 - m);
        bf16x8 pk[9];
#pragma unroll
        for (int kk = 0; kk < 8; ++kk) pk[kk] = pack_p(s[2 * kk], s[2 * kk + 1]);
        pk[8] = pack_p(s[16], (f32x4){0.f, 0.f, 0.f, 0.f});
        ATT_VMWAIT(); __syncthreads();
        f32x4 o[8];
#pragma unroll
        for (int dt = 0; dt < 8; ++dt) o[dt] = (f32x4){0.f, 0.f, 0.f, 0.f};
        unsigned tb[8];
#pragma unroll
        for (int dt = 0; dt < 8; ++dt) tb[dt] = tr_off(16 * w + 4 * g + (i16 >> 2), dt, i16);
        const unsigned t17off = (unsigned)((w == 7 ? 16 : 17) * 4096);
#pragma unroll
        for (int kk = 0; kk < 9; ++kk) { const unsigned offb = kk < 8 ? (unsigned)((2 * kk + 1) * 4096) : t17off;
#pragma unroll
            for (int dt = 0; dt < 8; ++dt) { const v4i16_t lo = vtr(L + tb[dt] + 2 * kk * 4096), hi = vtr(L + tb[dt] + offb);
                const bf16x8 vf = {lo[0], lo[1], lo[2], lo[3], hi[0], hi[1], hi[2], hi[3]};
                o[dt] = __builtin_amdgcn_mfma_f32_16x16x32_bf16(vf, pk[kk], o[dt], 0, 0, 0); } }
        __syncthreads();
        if (u + F.G < 2560) { const UnitA xn = decode_a(u + F.G); stage_a(L, QKV, xn, 8 + (xn.h >> 2), w, lane); }
        const float inv = 1.0f / l; bf16* op = ATT + (size_t)qrow * D + h * 128 + 4 * g;
#pragma unroll
        for (int dt = 0; dt < 8; ++dt) { const unsigned long long v = (unsigned long long)pk2(o[dt][0] * inv, o[dt][1] * inv) | ((unsigned long long)pk2(o[dt][2] * inv, o[dt][3] * inv) << 32); *(unsigned long long*)(op + 16 * dt) = v; }
    }
    ATT_VMWAIT();
}

struct UnitB { int base, r0, rows, kr0, h, half; };
__device__ __forceinline__ UnitB decode_b(int u) { UnitB x; x.h = u & 7; x.half = (u >> 3) & 1; const int rg = u >> 4;
    if (rg < 128) { x.base = (rg >> 4) * 4096; x.r0 = (rg & 15) * 4; x.rows = 64; } else { const int r2 = rg - 128; x.base = NP_ROWS + (r2 >> 3) * 2048; x.r0 = (r2 & 7) * 4; x.rows = 32; }
    int k = x.r0 - 4; x.kr0 = k < 0 ? 0 : (k > x.rows - 11 ? x.rows - 11 : k); return x; }
__device__ __forceinline__ void stage_b(ALAS unsigned char* L, const bf16* QKV, const UnitB& x, int off, int w, int lane) {
    const int rl = lane >> 4, p = lane & 15, col0 = x.half ? 24 : 0;
#pragma unroll
    for (int j = 0; j < 14; ++j) { const int q = w + 8 * j;
        if (q < 110) { const int row = 4 * q + rl, kr = row / 40, kc = row - kr * 40;
            ATT_DMA(QKV + hm(off, x.base + (x.kr0 + kr) * 64 + col0 + kc) + ((p ^ row) & 15) * 8, q); } }
}
__device__ __forceinline__ void attn_b(const Frame& F, ALAS unsigned char* L) {
    ALAS float* rkT = (ALAS float*)(L + TAB_OFF); ALAS float* bT = (ALAS float*)(L + TAB_OFF + 2048);
    const bf16* QKV = (const bf16*)(F.ws + WS_QKV); const float* SS = (const float*)(F.ws + WS_SS); bf16* ATT = (bf16*)(F.ws + WS_BUFA);
    int tid = F.tid, w = F.wave; asm volatile("" : "+v"(tid), "+s"(w));
    const int lane = tid & 63, g = lane >> 4, i16 = lane & 15;
    __syncthreads();
    if (F.bid < 2560) { const UnitB x0 = decode_b(F.bid); stage_b(L, QKV, x0, 20 + x0.h, w, lane); }
    for (int u = F.bid; u < 2560; u += F.G) {
        const UnitB x = decode_b(u); const int h = x.h, half = x.half, base = x.base, r0 = x.r0, rows = x.rows, kr0 = x.kr0;
        const int col0 = half ? 24 : 0, qoff = 12 + h, voff = 28 + h;
        const int r = r0 + (w >> 1), cb = 2 * half + (w & 1), c = 16 * cb + i16;
        int rs = r - 4; rs = rs < 0 ? 0 : (rs > rows - 8 ? rows - 8 : rs);
        int reg = 16 * cb - 8; reg = reg < 0 ? 0 : (reg > 32 ? 32 : reg); int cs = c - 8; cs = cs < 0 ? 0 : (cs > 48 ? 48 : cs);
        const int q0 = (rs - kr0) * 40 + (reg - col0);
        if (tid < 440) { const int kr = tid / 40, kc = tid - kr * 40; rkT[tid] = rstd_ss(SS, base + (kr0 + kr) * 64 + col0 + kc, 20 + h); }
        bT[tid] = tid < 465 ? F.rpb[h * 465 + tid] * LOG2E : 0.f;
        const int qrow = base + r * 64 + c; const float rq = rstd_ss(SS, qrow, 12 + h) * LOG2E;
        const float* gq_ = F.gqb; const float* gk_ = F.gkb; asm volatile("" : "+s"(gq_), "+s"(gk_));
        bf16x8 qf[4]; load_q(qf, QKV, qrow, qoff, gq_, gk_, g);
        ATT_VMWAIT(); __syncthreads();
        f32x4 s[16];
        unsigned kb[4];
#pragma unroll
        for (int ks = 0; ks < 4; ++ks) kb[ks] = img_off(q0 + i16, 4 * ks + g);
#pragma unroll
        for (int t = 0; t < 16; ++t) { f32x4 acc = {0.f, 0.f, 0.f, 0.f};
#pragma unroll
            for (int ks = 0; ks < 4; ++ks) { const bf16x8 kf = *(const ALAS bf16x8*)(L + (kb[ks] ^ (unsigned)(((t >> 1) & 1) << 7)) + (40 * (t >> 1) + 16 * (t & 1)) * 256); acc = __builtin_amdgcn_mfma_f32_16x16x32_bf16(kf, qf[ks], acc, 0, 0, 0); }
            s[t] = acc; }
        __syncthreads();
        stage_b(L, QKV, x, voff, w, lane);
        float m = -1e30f;
#pragma unroll
        for (int t = 0; t < 16; ++t) { const int i = t >> 1, R0 = q0 + 40 * i + 16 * (t & 1) + 4 * g; const f32x4 rk4 = *(const ALAS f32x4*)(rkT + R0); const int kc0 = reg + 16 * (t & 1) + 4 * g, brow = (rs + i - r + 7) * 31 + 15 - c;
#pragma unroll
            for (int rr = 0; rr < 4; ++rr) { const int kc = kc0 + rr; const bool valid = kc >= cs && kc < cs + 16; int bi = brow + kc; bi = bi < 0 ? 0 : (bi > 464 ? 464 : bi);
                const float v = valid ? s[t][rr] * rq * rk4[rr] + bT[bi] : -1e30f; s[t][rr] = v; m = fmaxf(m, v); } }
        m = fmaxf(m, __shfl_xor(m, 16)); m = fmaxf(m, __shfl_xor(m, 32));
        float l = 0.f;
#pragma unroll
        for (int t = 0; t < 16; ++t)
#pragma unroll
            for (int rr = 0; rr < 4; ++rr) { const float p = __builtin_amdgcn_exp2f(s[t][rr] - m); s[t][rr] = p; l += p; }
        l += __shfl_xor(l, 16); l += __shfl_xor(l, 32);
        bf16x8 pk[8];
#pragma unroll
        for (int kk = 0; kk < 8; ++kk) pk[kk] = pack_p(s[2 * kk], s[2 * kk + 1]);
        ATT_VMWAIT(); __syncthreads();
        f32x4 o[8];
#pragma unroll
        for (int d = 0; d < 8; ++d) o[d] = (f32x4){0.f, 0.f, 0.f, 0.f};
        unsigned tb[8];
#pragma unroll
        for (int d = 0; d < 8; ++d) tb[d] = tr_off(q0 + 4 * g + (i16 >> 2), d, i16);
#pragma unroll
        for (int kk = 0; kk < 8; ++kk) {
#pragma unroll
            for (int d = 0; d < 8; ++d) { const unsigned a = (tb[d] ^ (unsigned)((kk & 1) << 7)) + kk * 40 * 256; const v4i16_t lo = vtr(L + a), hi = vtr(L + a + 4096);
                const bf16x8 vf = {lo[0], lo[1], lo[2], lo[3], hi[0], hi[1], hi[2], hi[3]};
                o[d] = __builtin_amdgcn_mfma_f32_16x16x32_bf16(vf, pk[kk], o[d], 0, 0, 0); } }
        __syncthreads();
        if (u + F.G < 2560) { const UnitB xn = decode_b(u + F.G); stage_b(L, QKV, xn, 20 + xn.h, w, lane); }
        const float inv = 1.0f / l; bf16* op = ATT + (size_t)qrow * D + 1024 + h * 128 + 4 * g;
#pragma unroll
        for (int d = 0; d < 8; ++d) { const unsigned long long v = (unsigned long long)pk2(o[d][0] * inv, o[d][1] * inv) | ((unsigned long long)pk2(o[d][2] * inv, o[d][3] * inv) << 32); *(unsigned long long*)(op + 16 * d) = v; }
    }
    ATT_VMWAIT();
}
}

#define XB_TMO      128
#define XB_XCNT(j)  (256  + 64 * (j))
#define XB_XSUB(j)  (1280 + 64 * (j))
#define XB_XGEN(j)  (2304 + 64 * (j))
#define XB_TOP      3328
#define XB_TOPGEN   3392
#define XCD_BAR_WORDS 3456
#define XB_SPIN_CAP (1u << 18)

__device__ __forceinline__ unsigned xb_ld(unsigned* p)              { return __hip_atomic_load(p, __ATOMIC_RELAXED, __HIP_MEMORY_SCOPE_AGENT); }
__device__ __forceinline__ unsigned xb_add(unsigned* p, unsigned v) { return __hip_atomic_fetch_add(p, v, __ATOMIC_RELAXED, __HIP_MEMORY_SCOPE_AGENT); }
__device__ __forceinline__ unsigned xb_xcc_id() { return (unsigned)__builtin_amdgcn_s_getreg((3 << 11) | 20) & 0xFu; }
#define XB_SPIN(cond, bar) do { unsigned _sp = 0; while (cond) { __builtin_amdgcn_s_sleep(1); \
    if ((++_sp & 255u) == 0u) { if (xb_ld(&(bar)[XB_TMO])) break; if (_sp > XB_SPIN_CAP) { atomicAdd(&(bar)[XB_TMO], 1u); break; } } } } while (0)

struct XcdBarrier {
    unsigned* bar; unsigned x;
    volatile LAS unsigned* st;
};

__device__ __forceinline__ XcdBarrier xcd_barrier_post(unsigned* bar, volatile LAS unsigned* st) {
    XcdBarrier b; b.bar = bar; b.x = xb_xcc_id(); b.st = st;
    if (threadIdx.x == 0) (void)xb_add(&bar[XB_XCNT(b.x)], 1u);
    return b;
}
__device__ __forceinline__ void xcd_barrier_complete(unsigned* bar, unsigned x, unsigned& nloc, unsigned& nx) {
    const unsigned G = gridDim.x * gridDim.y * gridDim.z;
    unsigned sum, cnt, mine, sp = 0u;
    for (;;) {
        sum = 0u; cnt = 0u; mine = 0u;
#pragma unroll
        for (unsigned j = 0; j < 16; ++j) { const unsigned c = xb_ld(&bar[XB_XCNT(j)]); sum += c; cnt += (c > 0u) ? 1u : 0u; mine = (j == x) ? c : mine; }
        if (sum == G) break;
        __builtin_amdgcn_s_sleep(1);
        if ((++sp & 255u) == 0u) { if (xb_ld(&bar[XB_TMO])) break; if (sp > XB_SPIN_CAP) { atomicAdd(&bar[XB_TMO], 1u); break; } }
    }
    nloc = mine > 0u ? mine : 1u; nx = cnt > 0u ? cnt : 1u;
}

__device__ __forceinline__ void xcd_barrier(const XcdBarrier& b) {
    asm volatile("s_waitcnt vmcnt(0)" ::: "memory");
    __syncthreads();
    if (threadIdx.x == 0) {
        unsigned* bar = b.bar;
        __builtin_amdgcn_s_waitcnt(0);
        unsigned nloc = b.st[0], nx = b.st[1];
        if (nloc == 0u) { xcd_barrier_complete(bar, b.x, nloc, nx); b.st[0] = nloc; b.st[1] = nx; }
        const unsigned old = xb_add(&bar[XB_XSUB(b.x)], 1u);
        const unsigned gen = old / nloc;
        if (old + 1u == (gen + 1u) * nloc) {
            __builtin_amdgcn_fence(__ATOMIC_RELEASE, "agent");
            asm volatile("s_waitcnt vmcnt(0)" ::: "memory");
            const unsigned og = xb_add(&bar[XB_TOP], 1u);
            const unsigned tg = og / nx;
            if (og + 1u == (tg + 1u) * nx) xb_add(&bar[XB_TOPGEN], 1u);
            else XB_SPIN(xb_ld(&bar[XB_TOPGEN]) == tg, bar);
            __builtin_amdgcn_fence(__ATOMIC_ACQUIRE, "agent");
            xb_add(&bar[XB_XGEN(b.x)], 1u);
            asm volatile("s_waitcnt vmcnt(0)" ::: "memory");
        } else {
            XB_SPIN(xb_ld(&bar[XB_XGEN(b.x)]) == gen, bar);
            __builtin_amdgcn_fence(__ATOMIC_ACQUIRE, "agent");
            asm volatile("s_waitcnt vmcnt(0)" ::: "memory");
        }
    }
    __syncthreads();
}

struct Args { const float* in[17]; float* out; unsigned char* ws; int ph_lo, ph_hi; };
constexpr int N_PHASES = 8;
__global__ void __launch_bounds__(NWAVES * 64, 2) fwd_megakernel(Args args) {
    extern __shared__ __attribute__((aligned(16))) unsigned char lds[];
    cg::grid_group grid = cg::this_grid();
    Frame F;
    F.lds = lds; F.tid = threadIdx.x; F.lane = F.tid & 63; F.wave = __builtin_amdgcn_readfirstlane(F.tid >> 6); F.G = gridDim.x; F.bid = blockIdx.x;
    F.xp = args.in[0]; F.xs = args.in[1]; F.g1 = args.in[2]; F.w_in = args.in[3]; F.gqa = args.in[4]; F.gka = args.in[5]; F.t5 = args.in[6]; F.sink = args.in[7];
    F.gqb = args.in[8]; F.gkb = args.in[9]; F.rpb = args.in[10]; F.wbra = args.in[11]; F.wbrb = args.in[12]; F.wout = args.in[13]; F.g2 = args.in[14]; F.wup = args.in[15]; F.wdn = args.in[16];
    F.out = args.out; F.ws = args.ws;
    unsigned char* ws = args.ws;
    PG8_LAS unsigned char* ldsl = (PG8_LAS unsigned char*)lds;
    const int lo = args.ph_lo, hi = args.ph_hi;
#ifndef PHASE_MASK
#define PHASE_MASK 0xff
#endif
#define IN(k) (((PHASE_MASK >> (k)) & 1) && lo <= (k) && (k) < hi)
#define STAMP() do {} while (0)
#define SEAM(k) do { if (IN(k) && IN((k) + 1)) { if ((k) == 0) grid.sync(); else xcd_barrier(xbar); } STAMP(); } while (0)
    bf16* BUFA = (bf16*)(ws + WS_BUFA); bf16* QKV = (bf16*)(ws + WS_QKV); bf16* GATES = (bf16*)(ws + WS_GATES);
    float* SS = (float*)(ws + WS_SS); float* SS2 = (float*)(ws + WS_SS2); float* RSTD2 = (float*)(ws + WS_RSTD2);

    STAMP();
    { volatile LAS unsigned* st_ = (volatile LAS unsigned*)((LAS unsigned char*)lds + 139264 + 256); if (F.tid < 2) st_[F.tid] = 0u; __syncthreads(); }
    XcdBarrier xbar; xbar.bar = (unsigned*)(ws + WS_BAR); xbar.x = 0u; xbar.st = (volatile LAS unsigned*)((LAS unsigned char*)lds + 139264 + 256);
    if (IN(0)) { if (F.bid == 0) for (int i = F.tid; i < XCD_BAR_WORDS; i += NWAVES * 64) ((unsigned*)(ws + WS_BAR))[i] = 0u;
        p0_prologue(F); __syncthreads(); }
    SEAM(0);
    xbar = xcd_barrier_post((unsigned*)(ws + WS_BAR), (volatile LAS unsigned*)((LAS unsigned char*)lds + 139264 + 256));
    if (IN(1)) {
        pg8::Gemm g{BUFA, (const bf16*)(ws + WS_WIN), M_ROWS, INW, D}; pg8::StaticOrder S; S.init(M_ROWS, INW, F.G, F.bid);
        pg8::EpiProj E{QKV, GATES, SS};
        pg8::gemm_phase<pg8::EpiProj, pg8::StaticOrder, true, true>(ldsl, g, S, E);
    }
    SEAM(1);
    if (IN(2)) { att::attn_a(F, (ALAS unsigned char*)lds); att::attn_b(F, (ALAS unsigned char*)lds); __syncthreads(); }
    SEAM(2);
    if (IN(3)) {
        pg8::Gemm g{BUFA, (const bf16*)(ws + WS_WBR), M_ROWS, D, D}; pg8::StaticOrder S; S.init(M_ROWS, D, F.G, F.bid);
        pg8::EpiMerge E{GATES, QKV};
        pg8::gemm_phase<pg8::EpiMerge, pg8::StaticOrder, true, true>(ldsl, g, S, E);
    }
    SEAM(3);
    if (IN(4)) {
        pg8::Gemm g{QKV, (const bf16*)(ws + WS_WOUT), M_ROWS, D, D}; pg8::StaticOrder S; S.init(M_ROWS, D, F.G, F.bid);
        pg8::EpiOut1 E{F.xp, F.xs, F.out, BUFA, SS2};
        pg8::gemm_phase<pg8::EpiOut1, pg8::StaticOrder, true, true>(ldsl, g, S, E);
    }
    SEAM(4);
    if (IN(5)) {
        for (int m = F.bid * 512 + F.tid; m < M_ROWS; m += F.G * 512) { const f32x4* p = (const f32x4*)(SS2 + (size_t)m * 32); float s = 0.f;
#pragma unroll
            for (int j = 0; j < 8; ++j) { const f32x4 v = p[j]; s += (v.x + v.y) + (v.z + v.w); }
            RSTD2[m] = 1.0f / sqrtf(s * (1.f / D) + EPS); }
    }
    SEAM(5);
    if (IN(6)) {
        pg8::Gemm g{BUFA, (const bf16*)(ws + WS_WUP), M_ROWS, FF, D}; pg8::StaticOrder S; S.init(M_ROWS, FF, F.G, F.bid);
        pg8::EpiUp E{RSTD2, QKV};
        pg8::gemm_phase<pg8::EpiUp, pg8::StaticOrder, true, true>(ldsl, g, S, E);
    }
    SEAM(6);
    if (IN(7)) {
        pg8::Gemm g{QKV, (const bf16*)(ws + WS_WDN), M_ROWS, D, FF}; pg8::StaticOrder S; S.init(M_ROWS, D, F.G, F.bid);
        pg8::EpiDown E{F.out, BUFA};
        pg8::gemm_phase<pg8::EpiDown, pg8::StaticOrder, true, true>(ldsl, g, S, E);
    }
#undef IN
#undef SEAM
}


extern "C" void kernel_launch(void* const* d_in, const int* in_sizes, int n_in, void* d_out, int out_size, void* d_ws, size_t ws_size, hipStream_t stream) {
    static int grid = 0;
    if (grid == 0) {
        if (n_in != 17 || in_sizes[0] != NP_ROWS * D || in_sizes[1] != (M_ROWS - NP_ROWS) * D || out_size != M_ROWS * D || ws_size < WS_END) {
            fprintf(stderr, "kernel_launch: shape/workspace mismatch (n_in %d, in0 %d, out %d, ws %zu < %zu); nothing launched\n", n_in, n_in > 0 ? in_sizes[0] : -1, out_size, ws_size, (size_t)WS_END); grid = -1; return; }
        int dev = 0, cus = 0, per_cu = 0;
        if (hipGetDevice(&dev) != hipSuccess || hipDeviceGetAttribute(&cus, hipDeviceAttributeMultiprocessorCount, dev) != hipSuccess) { fprintf(stderr, "kernel_launch: device query failed\n"); grid = -1; return; }
        if (hipFuncSetAttribute((const void*)fwd_megakernel, hipFuncAttributeMaxDynamicSharedMemorySize, LDS_BYTES) != hipSuccess) { fprintf(stderr, "kernel_launch: hipFuncSetAttribute failed\n"); grid = -1; return; }
        if (hipOccupancyMaxActiveBlocksPerMultiprocessor(&per_cu, (const void*)fwd_megakernel, NWAVES * 64, LDS_BYTES) != hipSuccess || per_cu < 1) { fprintf(stderr, "kernel_launch: occupancy query says %d blocks per CU\n", per_cu); per_cu = 1; }
        (void)hipGetLastError();
        grid = cus * 1;
    }
    if (grid < 0) return;
    Args a{};
    for (int i = 0; i < 17; ++i) a.in[i] = (const float*)d_in[i];
    a.out = (float*)d_out; a.ws = (unsigned char*)d_ws;
#if MK_N_LAUNCHES == 1
    a.ph_lo = 0; a.ph_hi = N_PHASES;
    void* kargs[] = {&a};
    hipError_t e = hipLaunchCooperativeKernel((const void*)fwd_megakernel, dim3(grid), dim3(NWAVES * 64), kargs, LDS_BYTES, stream);
    if (e != hipSuccess) fprintf(stderr, "kernel_launch: cooperative launch failed: %s (grid %d)\n", hipGetErrorString(e), grid);
#else
    for (int ph = 0; ph < N_PHASES; ++ph) {
        a.ph_lo = ph; a.ph_hi = ph + 1;
        hipLaunchKernelGGL(fwd_megakernel, dim3(grid), dim3(NWAVES * 64), LDS_BYTES, stream, a);
        const hipError_t le = hipPeekAtLastError();
        if (le != hipSuccess) { fprintf(stderr, "kernel_launch: launch %d failed: %s\n", ph, hipGetErrorName(le)); break; }
    }
#endif
}
```

```cpp
#include <hip/hip_runtime.h>
#include <hip/hip_cooperative_groups.h>
#include <cstdio>
#include <cstdint>
namespace cg = cooperative_groups;
#define MK_N_LAUNCHES 1
namespace pg8 {
#define PG8_LAS __attribute__((address_space(3)))
typedef unsigned short bf16_t;
typedef short bf16x8 __attribute__((ext_vector_type(8)));
typedef float f32x4 __attribute__((ext_vector_type(4)));
typedef unsigned u32x4 __attribute__((ext_vector_type(4)));
constexpr int BM = 256, BK = 64, HALF = 128, HTB = HALF * BK * 2  , STAGE_BYTES = 8 * HTB, NXCD = 8, WGM = 8;

__host__ __device__ __forceinline__ int lds_byte(int r, int c) { const int st = (r >> 4) * 2 + (c >> 5), rr = r & 15, cc = c & 31, ob = rr * 64 + cc * 2; return st * 1024 + (ob ^ (((ob >> 9) & 1) << 5)); }
__host__ __device__ __forceinline__ void stage_rc(int b, int& R, int& C) { const int st = b / 1024, sb = b % 1024, swz = sb ^ (((sb >> 9) & 1) << 5); R = (st >> 1) * 16 + swz / 64; C = (st & 1) * 32 + (swz % 64) / 2; }
__host__ __device__ __forceinline__ int perm32(int rho) { const int n = rho >> 4, i = rho & 15; return 8 * (i >> 2) + 4 * n + (i & 3); }

struct Unit { int pm, pn; };
struct Gemm { const bf16_t* A; const bf16_t* Bt; int M, N, K; };

struct StaticOrder {
    int nM, nN, nwg, G, c;
    __host__ __device__ void init(int M, int N, int G_, int c_) { nM = M / BM; nN = N / BM; nwg = nM * nN; G = G_; c = c_; }
    __host__ __device__ bool next(int i, Unit& u) const {
        const long L = (long)i * G + c; if (L >= nwg) return false;
        int wgid = (int)L; { const int q = nwg / NXCD, r = nwg % NXCD, xcd = wgid % NXCD, off = wgid / NXCD; wgid = (xcd < r ? xcd * (q + 1) : r * (q + 1) + (xcd - r) * q) + off; }
        const int nig = WGM * nN, gid = wgid / nig, fm = gid * WGM, gsz = (nM - fm) < WGM ? (nM - fm) : WGM;
        u.pm = fm + ((wgid % nig) % gsz); u.pn = (wgid % nig) / gsz; return true;
    }
    __device__ __forceinline__ void a_ready(const Unit&) const {}
    __device__ __forceinline__ void done(const Unit&) const {}
};

__device__ __forceinline__ unsigned cvt_pk_bf16(float lo, float hi) { unsigned r; asm volatile("s_nop 0\n\tv_cvt_pk_bf16_f32 %0, %1, %2" : "=v"(r) : "v"(lo), "v"(hi)); return r; }
typedef float f32x2 __attribute__((ext_vector_type(2)));
typedef unsigned u32x2 __attribute__((ext_vector_type(2)));
__device__ __forceinline__ float bf_lo(unsigned w) { return __uint_as_float(w << 16); }
__device__ __forceinline__ float bf_hi(unsigned w) { return __uint_as_float(w & 0xffff0000u); }
__device__ __forceinline__ u32x4 pack8(const f32x4 v0, const f32x4 v1) { u32x4 w; w.x = cvt_pk_bf16(v0[0], v0[1]); w.y = cvt_pk_bf16(v0[2], v0[3]); w.z = cvt_pk_bf16(v1[0], v1[1]); w.w = cvt_pk_bf16(v1[2], v1[3]); return w; }
__device__ __forceinline__ float sigmoidf_(float x) { return __builtin_amdgcn_rcpf(1.0f + __builtin_amdgcn_exp2f(-1.44269504089f * x)); }
constexpr int QKV_LD = 4608, GATE_LD = 4096, DM = 2048, FFD = 8192, NHS = 36, NPROMPT_ROWS = 32768;

struct EpiProj {
    static constexpr bool PERM = true, AFTER_DRAIN = false, MID = false;
    bf16_t* QKV; bf16_t* GATES; float* SS;
    __device__ __forceinline__ void operator()(const f32x4 (&acc)[2][2][4][2], const Unit& u, int wr, int wc, int fr, int fq) const {
        const int row0 = u.pm * BM + wr * 64 + fr;
        asm volatile("s_nop 15\n\ts_nop 15" ::: "memory");
        if (u.pn < 18) {
            const int col0 = u.pn * BM + wc * 32 + 8 * fq;
#pragma unroll
            for (int ai = 0; ai < 2; ++ai)
#pragma unroll
                for (int m = 0; m < 4; ++m) { const int row = row0 + ai * HALF + m * 16; bf16_t* rowp = QKV + ((size_t)(u.pn * 2) * 40960 + (size_t)row) * 128 + wc * 32 + 8 * fq;
#pragma unroll
                    for (int bj = 0; bj < 2; ++bj) { const f32x4 v0 = acc[ai][bj][m][0], v1 = acc[ai][bj][m][1];
                        float s = (v0[0] * v0[0] + v0[1] * v0[1]) + (v0[2] * v0[2] + v0[3] * v0[3]) + (v1[0] * v1[0] + v1[1] * v1[1]) + (v1[2] * v1[2] + v1[3] * v1[3]);
                        s += __shfl_xor(s, 16); s += __shfl_xor(s, 32);
                        if (fq == 0) SS[((size_t)row * NHS + u.pn * 2 + bj) * 4 + wc] = s;
                        *(u32x4*)(rowp + (size_t)bj * 40960 * 128) = pack8(v0, v1); } }
        } else {
            const int col0 = (u.pn - 18) * BM + wc * 32 + 8 * fq;
#pragma unroll
            for (int ai = 0; ai < 2; ++ai)
#pragma unroll
                for (int m = 0; m < 4; ++m) { const int row = row0 + ai * HALF + m * 16; bf16_t* rowp = GATES + (size_t)row * GATE_LD + col0;
#pragma unroll
                    for (int bj = 0; bj < 2; ++bj) { f32x4 v0 = acc[ai][bj][m][0], v1 = acc[ai][bj][m][1];
#pragma unroll
                        for (int j = 0; j < 4; ++j) { v0[j] = sigmoidf_(v0[j]); v1[j] = sigmoidf_(v1[j]); }
                        *(u32x4*)(rowp + bj * HALF) = pack8(v0, v1); } }
        }
    }
};

struct EpiMerge {
    static constexpr bool PERM = true, AFTER_DRAIN = false, MID = true;
    const bf16_t* GATES; bf16_t* OUT;
    __device__ __forceinline__ void mid(f32x4 (&acc)[2][2][4][2], const Unit& u, int wr, int wc, int fr, int fq) const {
        const int row0 = u.pm * BM + wr * 64 + fr, col0 = u.pn * BM + wc * 32 + 8 * fq;
        const bf16_t* gp0 = GATES + (size_t)row0 * GATE_LD + col0;
        asm volatile("" : "+v"(gp0));
#pragma unroll
        for (int ai = 0; ai < 2; ++ai) { u32x4 ga[4][2], gb[4][2];
#pragma unroll
            for (int m = 0; m < 4; ++m)
#pragma unroll
                for (int bj = 0; bj < 2; ++bj) { const bf16_t* gp = gp0 + (size_t)(ai * HALF + m * 16) * GATE_LD + bj * HALF; ga[m][bj] = *(const u32x4*)gp; gb[m][bj] = *(const u32x4*)(gp + DM); }
#pragma unroll
            for (int m = 0; m < 4; ++m)
#pragma unroll
                for (int bj = 0; bj < 2; ++bj) { const u32x4 a = ga[m][bj], b = gb[m][bj]; f32x4& c0 = acc[ai][bj][m][0]; f32x4& c1 = acc[ai][bj][m][1];
                    c0[0] *= bf_lo(a.x) * __builtin_amdgcn_rcpf(bf_lo(b.x)); c0[1] *= bf_hi(a.x) * __builtin_amdgcn_rcpf(bf_hi(b.x));
                    c0[2] *= bf_lo(a.y) * __builtin_amdgcn_rcpf(bf_lo(b.y)); c0[3] *= bf_hi(a.y) * __builtin_amdgcn_rcpf(bf_hi(b.y));
                    c1[0] *= bf_lo(a.z) * __builtin_amdgcn_rcpf(bf_lo(b.z)); c1[1] *= bf_hi(a.z) * __builtin_amdgcn_rcpf(bf_hi(b.z));
                    c1[2] *= bf_lo(a.w) * __builtin_amdgcn_rcpf(bf_lo(b.w)); c1[3] *= bf_hi(a.w) * __builtin_amdgcn_rcpf(bf_hi(b.w)); }
            asm volatile("" ::: "memory"); }
    }
    __device__ __forceinline__ void operator()(const f32x4 (&acc)[2][2][4][2], const Unit& u, int wr, int wc, int fr, int fq) const {
        const int row0 = u.pm * BM + wr * 64 + fr, col0 = u.pn * BM + wc * 32 + 8 * fq;
        u32x4 gb[2][4][2];
#pragma unroll
        for (int ai = 0; ai < 2; ++ai)
#pragma unroll
            for (int m = 0; m < 4; ++m)
#pragma unroll
                for (int bj = 0; bj < 2; ++bj) gb[ai][m][bj] = *(const u32x4*)(GATES + (size_t)(row0 + ai * HALF + m * 16) * GATE_LD + DM + col0 + bj * HALF);
#pragma unroll
        for (int ai = 0; ai < 2; ++ai)
#pragma unroll
            for (int m = 0; m < 4; ++m) { bf16_t* op = OUT + (size_t)(row0 + ai * HALF + m * 16) * DM + col0;
#pragma unroll
                for (int bj = 0; bj < 2; ++bj) { const u32x4 b = gb[ai][m][bj];
                    f32x4 v0 = acc[ai][bj][m][0], v1 = acc[ai][bj][m][1];
                    v0[0] *= bf_lo(b.x); v0[1] *= bf_hi(b.x); v0[2] *= bf_lo(b.y); v0[3] *= bf_hi(b.y);
                    v1[0] *= bf_lo(b.z); v1[1] *= bf_hi(b.z); v1[2] *= bf_lo(b.w); v1[3] *= bf_hi(b.w);
                    *(u32x4*)(op + bj * HALF) = pack8(v0, v1); } }
    }
};

struct EpiOut1 {
    static constexpr bool PERM = true, AFTER_DRAIN = false, MID = false;
    const float* xp; const float* xs; float* OUT; bf16_t* X1B; float* SS2;
    __device__ __forceinline__ void operator()(const f32x4 (&acc)[2][2][4][2], const Unit& u, int wr, int wc, int fr, int fq) const {
        const int row0 = u.pm * BM + wr * 64 + fr, col0 = u.pn * BM + wc * 32 + 8 * fq;
        const float* xb = (u.pm * BM < NPROMPT_ROWS) ? xp : xs - (size_t)NPROMPT_ROWS * DM;
#pragma unroll
        for (int ai = 0; ai < 2; ++ai) { f32x4 xv[4][2][2];
#pragma unroll
            for (int m = 0; m < 4; ++m)
#pragma unroll
                for (int bj = 0; bj < 2; ++bj) { const float* xr = xb + (size_t)(row0 + ai * HALF + m * 16) * DM + col0 + bj * HALF; xv[m][bj][0] = *(const f32x4*)xr; xv[m][bj][1] = *(const f32x4*)(xr + 4); }
#pragma unroll
            for (int m = 0; m < 4; ++m) { const size_t row = (size_t)(row0 + ai * HALF + m * 16); bf16_t* bp = X1B + row * DM + col0;
                float s = 0.f;
#pragma unroll
                for (int bj = 0; bj < 2; ++bj) { const f32x4 v0 = acc[ai][bj][m][0] + xv[m][bj][0], v1 = acc[ai][bj][m][1] + xv[m][bj][1];
                    s += (v0[0] * v0[0] + v0[1] * v0[1]) + (v0[2] * v0[2] + v0[3] * v0[3]) + (v1[0] * v1[0] + v1[1] * v1[1]) + (v1[2] * v1[2] + v1[3] * v1[3]);
                    *(u32x4*)(bp + bj * HALF) = pack8(v0, v1); }
                s += __shfl_xor(s, 16); s += __shfl_xor(s, 32);
                if (fq == 0) SS2[row * 32 + u.pn * 4 + wc] = s; }
            asm volatile("" ::: "memory"); }
    }
};

struct EpiUp {
    static constexpr bool PERM = true, AFTER_DRAIN = false, MID = false;
    const float* RSTD2; bf16_t* U;
    __device__ __forceinline__ void operator()(const f32x4 (&acc)[2][2][4][2], const Unit& u, int wr, int wc, int fr, int fq) const {
        const int row0 = u.pm * BM + wr * 64 + fr, col0 = u.pn * BM + wc * 32 + 8 * fq;
#pragma unroll
        for (int ai = 0; ai < 2; ++ai)
#pragma unroll
            for (int m = 0; m < 4; ++m) { const size_t row = (size_t)(row0 + ai * HALF + m * 16); const float rs = RSTD2[row]; bf16_t* op = U + row * FFD + col0;
#pragma unroll
                for (int bj = 0; bj < 2; ++bj) { f32x4 v0 = acc[ai][bj][m][0] * rs, v1 = acc[ai][bj][m][1] * rs;
#pragma unroll
                    for (int j = 0; j < 4; ++j) { const float a = fmaxf(v0[j], 0.f), b = fmaxf(v1[j], 0.f); v0[j] = a * a; v1[j] = b * b; }
                    *(u32x4*)(op + bj * HALF) = pack8(v0, v1); } }
    }
};

struct EpiDown {
    static constexpr bool PERM = true, AFTER_DRAIN = false, MID = false;
    float* OUT; const bf16_t* X1B;
    __device__ __forceinline__ void operator()(const f32x4 (&acc)[2][2][4][2], const Unit& u, int wr, int wc, int fr, int fq) const {
        const int row0 = u.pm * BM + wr * 64 + fr, col0 = u.pn * BM + wc * 32 + 8 * fq;
        u32x4 xw[2][4][2];
#pragma unroll
        for (int ai = 0; ai < 2; ++ai)
#pragma unroll
            for (int m = 0; m < 4; ++m)
#pragma unroll
                for (int bj = 0; bj < 2; ++bj) xw[ai][m][bj] = *(const u32x4*)(X1B + (size_t)(row0 + ai * HALF + m * 16) * DM + col0 + bj * HALF);
#pragma unroll
        for (int ai = 0; ai < 2; ++ai)
#pragma unroll
            for (int m = 0; m < 4; ++m) { float* op = OUT + (size_t)(row0 + ai * HALF + m * 16) * DM + col0;
#pragma unroll
                for (int bj = 0; bj < 2; ++bj) { const u32x4 x = xw[ai][m][bj]; f32x4 v0 = acc[ai][bj][m][0], v1 = acc[ai][bj][m][1];
                    v0[0] += bf_lo(x.x); v0[1] += bf_hi(x.x); v0[2] += bf_lo(x.y); v0[3] += bf_hi(x.y); v1[0] += bf_lo(x.z); v1[1] += bf_hi(x.z); v1[2] += bf_lo(x.w); v1[3] += bf_hi(x.w);
                    *(f32x4*)(op + bj * HALF) = v0; *(f32x4*)(op + bj * HALF + 4) = v1; } }
    }
};

template <class Epi, class Sched, bool ALIGN_EPI = false, bool SP2 = false>
__device__ __forceinline__ void gemm_phase(PG8_LAS unsigned char* lds, const Gemm g, const Sched& S, const Epi& E) {
    const int tid = threadIdx.x, wid = __builtin_amdgcn_readfirstlane(tid >> 6), lane = tid & 63, wr = wid >> 2, wc = wid & 3, fr = lane & 15, fq = lane >> 4;
    const int K = g.K, nt = K / BK;
    unsigned voffA[2], voffB[2];
#pragma unroll
    for (int i = 0; i < 2; ++i) { int R, C; stage_rc(tid * 16 + i * 8192, R, C); const int Rb = Epi::PERM ? ((R & ~31) + perm32(R & 31)) : R;
        voffA[i] = (unsigned)(R * K + C) * 2u; voffB[i] = (unsigned)(Rb * K + C) * 2u; }
    const size_t kstep = (size_t)(BK * 2);
    const size_t hstep = (size_t)HALF * K * 2;
    const size_t tstep = 2 * hstep;
    const unsigned ldsw = (unsigned)wid * 1024u;
    const int aoff = lds_byte(wr * 64 + fr, fq * 8), boff = lds_byte(wc * 32 + fr, fq * 8);
#define PG8_SA(b, h) (((b) * 2 + (h)) * HTB)
#define PG8_SB(b, h) ((4 + (b) * 2 + (h)) * HTB)
#define PG8_STAGE(bufoff, gbase, voff) do { _Pragma("unroll") for (int _i = 0; _i < 2; ++_i) \
        __builtin_amdgcn_global_load_lds((const unsigned*)((const char*)(gbase) + (voff)[_i]), (PG8_LAS unsigned*)(lds + (bufoff) + ldsw + _i * 8192), 16, 0, 0); } while (0)
#define PG8_LDA(dst, b, h) do { _Pragma("unroll") for (int m = 0; m < 4; ++m) _Pragma("unroll") for (int k = 0; k < 2; ++k) dst[m][k] = *(const PG8_LAS bf16x8*)(lds + PG8_SA(b, h) + aoff + m * 2048 + k * 1024); } while (0)
#define PG8_LDB(dst, b, h) do { _Pragma("unroll") for (int n = 0; n < 2; ++n) _Pragma("unroll") for (int k = 0; k < 2; ++k) dst[n][k] = *(const PG8_LAS bf16x8*)(lds + PG8_SB(b, h) + boff + n * 2048 + k * 1024); } while (0)
#define PG8_MMA(ai, bj, At, Bt) do { __builtin_amdgcn_s_setprio(1); _Pragma("unroll") for (int m = 0; m < 4; ++m) _Pragma("unroll") for (int n = 0; n < 2; ++n) _Pragma("unroll") for (int k = 0; k < 2; ++k) \
        acc[ai][bj][m][n] = __builtin_amdgcn_mfma_f32_16x16x32_bf16(Bt[n][k], At[m][k], acc[ai][bj][m][n], 0, 0, 0); __builtin_amdgcn_s_setprio(0); } while (0)
#define PG8_WAIT_V(n) asm volatile("s_waitcnt vmcnt(" #n ")" ::: "memory")
#define PG8_WAIT_L(n) asm volatile("s_waitcnt lgkmcnt(" #n ")" ::: "memory")
#define PG8_BAR __builtin_amdgcn_s_barrier()
#define PG8_SCHED __builtin_amdgcn_sched_barrier(0)
    Unit cur, nxt; int ui = 0;
    if (!S.next(0, cur)) return;
    f32x4 acc[2][2][4][2];
#pragma unroll
    for (int a = 0; a < 2; ++a)
#pragma unroll
        for (int b = 0; b < 2; ++b)
#pragma unroll
            for (int m = 0; m < 4; ++m)
#pragma unroll
                for (int n = 0; n < 2; ++n) acc[a][b][m][n] = (f32x4){0.f, 0.f, 0.f, 0.f};
    bf16x8 At[4][2], B0[2][2], B1[2][2];
    const char* cA = (const char*)g.A + (size_t)cur.pm * tstep; const char* cB = (const char*)g.Bt + (size_t)cur.pn * tstep;
    S.a_ready(cur);
    if constexpr (SP2) {
        PG8_STAGE(PG8_SB(0, 0), cB, voffB); PG8_STAGE(PG8_SB(0, 1), cB + hstep, voffB); PG8_STAGE(PG8_SA(0, 0), cA, voffA); PG8_STAGE(PG8_SA(0, 1), cA + hstep, voffA);
        if (wr == 1) PG8_BAR;
        PG8_WAIT_V(2); PG8_BAR;
        PG8_STAGE(PG8_SB(1, 0), cB + kstep, voffB); PG8_STAGE(PG8_SA(1, 0), cA + kstep, voffA); PG8_STAGE(PG8_SB(1, 1), cB + hstep + kstep, voffB);
        PG8_WAIT_V(6); PG8_BAR;
    } else {
        PG8_STAGE(PG8_SB(0, 0), cB, voffB); PG8_STAGE(PG8_SA(0, 0), cA, voffA); PG8_STAGE(PG8_SB(0, 1), cB + hstep, voffB); PG8_STAGE(PG8_SA(0, 1), cA + hstep, voffA);
        if (wr == 1) PG8_BAR;
        PG8_WAIT_V(4); PG8_BAR;
        PG8_STAGE(PG8_SB(1, 0), cB + kstep, voffB); PG8_STAGE(PG8_SA(1, 0), cA + kstep, voffA); PG8_STAGE(PG8_SB(1, 1), cB + hstep + kstep, voffB);
        PG8_WAIT_V(6); PG8_BAR;
    }
    for (;;) {
        const bool has_next = S.next(ui + 1, nxt);
        const char* nA = has_next ? (const char*)g.A + (size_t)nxt.pm * tstep : cA; const char* nB = has_next ? (const char*)g.Bt + (size_t)nxt.pn * tstep : cB;
        constexpr int NSEG = Epi::MID ? 2 : 1; const int seglen = nt / NSEG;
        for (int seg = 0; seg < NSEG; ++seg) {
        if constexpr (Epi::MID) { if (seg == 1) E.mid(acc, cur, wr, wc, fr, fq); }
        for (int t = seg * seglen; t < (seg + 1) * seglen; t += 2) {
            const bool last = (t == nt - 2);
            const char* a1 = cA + (size_t)(t + 1) * kstep;
            const char* a2 = last ? nA : cA + (size_t)(t + 2) * kstep; const char* b2 = last ? nB : cB + (size_t)(t + 2) * kstep;
            const char* a3 = a2 + kstep; const char* b3 = b2 + kstep;
            if (last && has_next) S.a_ready(nxt);
            if constexpr (SP2) {
            PG8_LDB(B0, 0, 0); PG8_LDB(B1, 0, 1); PG8_SCHED; PG8_LDA(At, 0, 0); PG8_STAGE(PG8_SA(1, 1), a1 + hstep, voffA);
            PG8_WAIT_V(8); PG8_WAIT_L(0); PG8_BAR; PG8_MMA(0, 0, At, B0); PG8_MMA(0, 1, At, B1); PG8_BAR; PG8_SCHED;
            PG8_LDA(At, 0, 1); PG8_STAGE(PG8_SB(0, 0), b2, voffB); PG8_STAGE(PG8_SB(0, 1), b2 + hstep, voffB); PG8_STAGE(PG8_SA(0, 0), a2, voffA);
            PG8_WAIT_V(8); PG8_WAIT_L(0); PG8_BAR; PG8_MMA(1, 0, At, B0); PG8_MMA(1, 1, At, B1); PG8_BAR; PG8_SCHED;
            PG8_LDB(B0, 1, 0); PG8_LDB(B1, 1, 1); PG8_SCHED; PG8_LDA(At, 1, 0); PG8_STAGE(PG8_SA(0, 1), a2 + hstep, voffA);
            PG8_WAIT_V(8); PG8_WAIT_L(0); PG8_BAR; PG8_MMA(0, 0, At, B0); PG8_MMA(0, 1, At, B1); PG8_BAR; PG8_SCHED;
            PG8_LDA(At, 1, 1); PG8_STAGE(PG8_SB(1, 0), b3, voffB); PG8_STAGE(PG8_SB(1, 1), b3 + hstep, voffB); PG8_STAGE(PG8_SA(1, 0), a3, voffA);
            PG8_WAIT_V(8); PG8_WAIT_L(0); PG8_BAR; PG8_MMA(1, 0, At, B0); PG8_MMA(1, 1, At, B1); PG8_BAR; PG8_SCHED;
            } else {
            PG8_LDB(B0, 0, 0); PG8_SCHED; PG8_LDA(At, 0, 0); PG8_STAGE(PG8_SA(1, 1), a1 + hstep, voffA);
            PG8_WAIT_L(8); PG8_BAR; PG8_WAIT_L(0); PG8_MMA(0, 0, At, B0); PG8_BAR; PG8_SCHED;
            PG8_LDB(B1, 0, 1); PG8_STAGE(PG8_SB(0, 0), b2, voffB);
            PG8_BAR; PG8_WAIT_L(0); PG8_MMA(0, 1, At, B1); PG8_BAR;
            PG8_LDA(At, 0, 1); PG8_STAGE(PG8_SA(0, 0), a2, voffA);
            PG8_BAR; PG8_WAIT_L(0); PG8_MMA(1, 0, At, B0); PG8_BAR; PG8_SCHED;
            PG8_STAGE(PG8_SB(0, 1), b2 + hstep, voffB);
            PG8_WAIT_V(6); PG8_BAR; PG8_MMA(1, 1, At, B1); PG8_BAR;
            PG8_LDB(B0, 1, 0); PG8_SCHED; PG8_LDA(At, 1, 0); PG8_STAGE(PG8_SA(0, 1), a2 + hstep, voffA);
            PG8_WAIT_L(8); PG8_BAR; PG8_WAIT_L(0); PG8_MMA(0, 0, At, B0); PG8_BAR; PG8_SCHED;
            PG8_LDB(B1, 1, 1); PG8_STAGE(PG8_SB(1, 0), b3, voffB);
            PG8_BAR; PG8_WAIT_L(0); PG8_MMA(0, 1, At, B1); PG8_BAR;
            PG8_LDA(At, 1, 1); PG8_STAGE(PG8_SA(1, 0), a3, voffA);
            PG8_BAR; PG8_WAIT_L(0); PG8_MMA(1, 0, At, B0); PG8_BAR; PG8_SCHED;
            PG8_STAGE(PG8_SB(1, 1), b3 + hstep, voffB);
            PG8_WAIT_V(6); PG8_BAR; PG8_MMA(1, 1, At, B1); PG8_BAR;
            }
        }
        }
        if constexpr (ALIGN_EPI) { if (wr == 0) PG8_BAR; }
        if constexpr (!Epi::AFTER_DRAIN) { E(acc, cur, wr, wc, fr, fq); S.done(cur); }
        if (!has_next) break;
#pragma unroll
        for (int a = 0; a < 2; ++a)
#pragma unroll
            for (int b = 0; b < 2; ++b)
#pragma unroll
                for (int m = 0; m < 4; ++m)
#pragma unroll
                    for (int n = 0; n < 2; ++n) acc[a][b][m][n] = (f32x4){0.f, 0.f, 0.f, 0.f};
        cur = nxt; cA = nA; cB = nB; ++ui;
        if constexpr (ALIGN_EPI) { if (wr == 1) PG8_BAR; }
    }
    PG8_WAIT_V(0);
    if constexpr (!ALIGN_EPI) { if (wr == 0) PG8_BAR; }
    PG8_BAR;
    if constexpr (Epi::AFTER_DRAIN) { E.fused(acc, cur, wr, wc, fr, fq, lds, wid, lane); S.done(cur); }
#undef PG8_SA
#undef PG8_SB
#undef PG8_STAGE
#undef PG8_LDA
#undef PG8_LDB
#undef PG8_MMA
#undef PG8_WAIT_V
#undef PG8_WAIT_L
#undef PG8_BAR
#undef PG8_SCHED
}
}
#ifndef MK_N_LAUNCHES
#define MK_N_LAUNCHES 1
#endif
constexpr int NWAVES = 8;
constexpr int M_ROWS = 40960, NP_ROWS = 32768, D = 2048, FF = 8192, INW = 8704, QKVW = 4608, GW_ = 4096, HD = 128;
constexpr float EPS = 1e-6f;
constexpr size_t MiB = 1u << 20;
constexpr size_t WS_TAB = 0;
constexpr size_t WS_BAR = 128 * 1024;
constexpr size_t WS_RSTD2 = 1 * MiB;
constexpr size_t WS_SS2 = 2 * MiB;
constexpr size_t WS_SS = 8 * MiB;
constexpr size_t WS_WIN = 32 * MiB;
constexpr size_t WS_WBR = 66 * MiB;
constexpr size_t WS_WOUT = 74 * MiB;
constexpr size_t WS_WUP = 82 * MiB;
constexpr size_t WS_WDN = 114 * MiB;
constexpr size_t WS_BUFA = 146 * MiB;
constexpr size_t WS_QKV = 306 * MiB;
constexpr size_t WS_GATES = 666 * MiB;
constexpr size_t WS_END = 986 * MiB;
constexpr int LDS_BYTES = 147456;

#define LAS __attribute__((address_space(3)))
typedef unsigned short bf16;
typedef unsigned v4u __attribute__((ext_vector_type(4)));
typedef float f32x4 __attribute__((ext_vector_type(4)));
#define LDS_WAIT() asm volatile("s_waitcnt lgkmcnt(0)" ::: "memory")
__device__ __forceinline__ unsigned f2bf(float f) { unsigned u = __builtin_bit_cast(unsigned, f); return (u + 0x7fffu + ((u >> 16) & 1u)) >> 16; }
__device__ __forceinline__ unsigned pk2(float lo, float hi) { return f2bf(lo) | (f2bf(hi) << 16); }
__device__ __forceinline__ float bflo(unsigned w) { return __uint_as_float(w << 16); }
__device__ __forceinline__ float bfhi(unsigned w) { return __uint_as_float(w & 0xffff0000u); }
__device__ __forceinline__ float wave_sum(float v) {
#pragma unroll
    for (int o = 1; o < 64; o <<= 1) v += __shfl_xor(v, o);
    return v;
}
__device__ __forceinline__ float wave_max(float v) {
#pragma unroll
    for (int o = 1; o < 64; o <<= 1) v = fmaxf(v, __shfl_xor(v, o));
    return v;
}
__device__ __forceinline__ void wave_sync() { __builtin_amdgcn_fence(__ATOMIC_RELEASE, "wavefront"); __builtin_amdgcn_wave_barrier(); __builtin_amdgcn_fence(__ATOMIC_ACQUIRE, "wavefront"); }

__device__ __forceinline__ int t5_bucket_dev(int rel) {
    const int n = rel < 0 ? -rel : rel;
    const int b = n < 8 ? n : 8 + (n >= 12) + (n >= 16) + (n >= 23) + (n >= 32) + (n >= 46) + (n >= 64) + (n >= 91);
    return b + (rel > 0 ? 16 : 0);
}

struct Frame {
    unsigned char* lds; int tid, lane, wave, G, bid;
    const float *xp, *xs, *g1, *w_in, *gqa, *gka, *t5, *sink, *gqb, *gkb, *rpb, *wbra, *wbrb, *wout, *g2, *wup, *wdn;
    float* out; unsigned char* ws;
};
__device__ __forceinline__ const float* xrow_ptr(const Frame& F, int m) { return m < NP_ROWS ? F.xp + (size_t)m * D : F.xs + (size_t)(m - NP_ROWS) * D; }

__device__ __forceinline__ void p0_transpose_item(const float* W, int K, int N, bf16* WT, int ldk, int koff, const float* kscale, float* scr, int item, int lane) {
    const int nblk = N / 32, kb = item / nblk, nb = item % nblk, k0 = 64 * kb, n0 = 32 * nb;
    float wv[32];
#pragma unroll
    for (int i = 0; i < 32; ++i) { const int kk = 2 * i + (lane >> 5); wv[i] = W[(size_t)(k0 + kk) * N + n0 + (lane & 31)]; }
#pragma unroll
    for (int i = 0; i < 32; ++i) { const int kk = 2 * i + (lane >> 5); float w = wv[i]; if (kscale) w *= kscale[k0 + kk]; scr[kk * 33 + (lane & 31)] = w; }
    wave_sync();
    const int c = lane & 7;
#pragma unroll
    for (int j = 0; j < 4; ++j) { const int n = (lane >> 3) + 8 * j; const float* s = scr + (8 * c) * 33 + n;
        v4u o; o.x = pk2(s[0 * 33], s[1 * 33]); o.y = pk2(s[2 * 33], s[3 * 33]); o.z = pk2(s[4 * 33], s[5 * 33]); o.w = pk2(s[6 * 33], s[7 * 33]);
        *(v4u*)(WT + (size_t)(n0 + n) * ldk + koff + k0 + 8 * c) = o; }
    wave_sync();
}
__device__ __forceinline__ void p0_prologue(Frame& F) {
    float* scr = (float*)(F.lds + F.wave * 16384);
    const int gw = F.bid * NWAVES + F.wave, NGW = F.G * NWAVES;
    constexpr int I_IN = (D / 64) * (INW / 32), I_BR = (1024 / 64) * (D / 32), I_OUT = (D / 64) * (D / 32), I_UP = (D / 64) * (FF / 32), I_DN = (FF / 64) * (D / 32);
    constexpr int NITEMS = I_IN + 2 * I_BR + I_OUT + I_UP + I_DN;
    for (int it = gw; it < NITEMS; it += NGW) {
        int r = it;
        if (r < I_IN) { p0_transpose_item(F.w_in, D, INW, (bf16*)(F.ws + WS_WIN), D, 0, nullptr, scr, r, F.lane); continue; } r -= I_IN;
        if (r < I_BR) { p0_transpose_item(F.wbra, 1024, D, (bf16*)(F.ws + WS_WBR), D, 0, nullptr, scr, r, F.lane); continue; } r -= I_BR;
        if (r < I_BR) { p0_transpose_item(F.wbrb, 1024, D, (bf16*)(F.ws + WS_WBR), D, 1024, nullptr, scr, r, F.lane); continue; } r -= I_BR;
        if (r < I_OUT) { p0_transpose_item(F.wout, D, D, (bf16*)(F.ws + WS_WOUT), D, 0, nullptr, scr, r, F.lane); continue; } r -= I_OUT;
        if (r < I_UP) { p0_transpose_item(F.wup, D, FF, (bf16*)(F.ws + WS_WUP), D, 0, F.g2, scr, r, F.lane); continue; } r -= I_UP;
        p0_transpose_item(F.wdn, FF, D, (bf16*)(F.ws + WS_WDN), FF, 0, nullptr, scr, r, F.lane);
    }
    bf16* H = (bf16*)(F.ws + WS_BUFA);
    for (int m = gw; m < M_ROWS; m += NGW) {
        const f32x4* xr = (const f32x4*)xrow_ptr(F, m) + F.lane; f32x4 v[8]; float s = 0.f;
#pragma unroll
        for (int j = 0; j < 8; ++j) { v[j] = xr[64 * j]; s += (v[j].x * v[j].x + v[j].y * v[j].y) + (v[j].z * v[j].z + v[j].w * v[j].w); }
        const float rstd = 1.0f / sqrtf(wave_sum(s) * (1.f / D) + EPS);
        unsigned long long* o8 = (unsigned long long*)(H + (size_t)m * D) + F.lane; const f32x4* gp = (const f32x4*)F.g1 + F.lane;
#pragma unroll
        for (int j = 0; j < 8; ++j) { const f32x4 g = gp[64 * j]; o8[64 * j] = (unsigned long long)pk2(v[j].x * rstd * g.x, v[j].y * rstd * g.y) | ((unsigned long long)pk2(v[j].z * rstd * g.z, v[j].w * rstd * g.w) << 32); }
    }
}

__device__ __forceinline__ float rstd_ss(const float* SS, int row, int hs) { const f32x4 p = *(const f32x4*)(SS + ((size_t)row * 36 + hs) * 4); return 1.0f / sqrtf(((p.x + p.y) + (p.z + p.w)) * (1.f / HD) + EPS); }

namespace att {
#define ALAS __attribute__((address_space(3)))
typedef short bf16x8 __attribute__((ext_vector_type(8)));
typedef short v4i16_t __attribute__((ext_vector_type(4)));
constexpr int TAB_OFF = 131072;
constexpr float LOG2E = 1.4426950408889634f;
__device__ __forceinline__ size_t hm(int hs, int row) { return ((size_t)hs * M_ROWS + (size_t)row) * 128; }
__device__ __forceinline__ unsigned img_off(int row, int chunk) { return (unsigned)(row * 256 + (((chunk ^ row) & 15) << 4)); }
__device__ __forceinline__ v4i16_t vtr(const ALAS unsigned char* p) { return __builtin_amdgcn_ds_read_tr16_b64_v4i16((ALAS v4i16_t*)p); }
__device__ __forceinline__ unsigned tr_off(int row, int dt, int i16) { const int ch = 2 * dt + ((i16 & 3) >> 1); return (unsigned)(row * 256 + (((ch ^ row) & 15) << 4) + (i16 & 1) * 8); }
__device__ __forceinline__ void load_q(bf16x8 (&qf)[4], const bf16* QKV, int qrow, int qhs, const float* gq, const float* gk, int g) {
#pragma unroll
    for (int ks = 0; ks < 4; ++ks) { const int d0 = 32 * ks + 8 * g; const v4u w = *(const v4u*)(QKV + hm(qhs, qrow) + d0);
        const f32x4 a0 = *(const f32x4*)(gq + d0), a1 = *(const f32x4*)(gq + d0 + 4), b0 = *(const f32x4*)(gk + d0), b1 = *(const f32x4*)(gk + d0 + 4); const float c = 0.08838834764831845f;
        v4u o; o.x = pk2(bflo(w.x) * a0.x * b0.x * c, bfhi(w.x) * a0.y * b0.y * c); o.y = pk2(bflo(w.y) * a0.z * b0.z * c, bfhi(w.y) * a0.w * b0.w * c);
        o.z = pk2(bflo(w.z) * a1.x * b1.x * c, bfhi(w.z) * a1.y * b1.y * c); o.w = pk2(bflo(w.w) * a1.z * b1.z * c, bfhi(w.w) * a1.w * b1.w * c);
        qf[ks] = __builtin_bit_cast(bf16x8, o); }
}
__device__ __forceinline__ unsigned cvt2(float lo, float hi) { return pg8::cvt_pk_bf16(lo, hi); }
__device__ __forceinline__ bf16x8 pack_p(const f32x4 a, const f32x4 b) { v4u o; o.x = cvt2(a[0], a[1]); o.y = cvt2(a[2], a[3]); o.z = cvt2(b[0], b[1]); o.w = cvt2(b[2], b[3]); return __builtin_bit_cast(bf16x8, o); }

#define ATT_DMA(src, q) __builtin_amdgcn_global_load_lds((const unsigned*)(src), (ALAS unsigned*)(L + (q) * 1024), 16, 0, 0)
#define ATT_VMWAIT() asm volatile("s_waitcnt vmcnt(0)" ::: "memory")
struct UnitA { int base, n, Ls, h; };
__device__ __forceinline__ UnitA decode_a(int u, bool xmap) { UnitA x;
    if (xmap) { const int bid = u & 255, k = (u >> 8) * 8 + (bid & 7), j = bid >> 3;
        if (k < 64) { x.base = (k >> 3) * 4096; x.n = ((k >> 1) & 3) * 8 + (j >> 2); x.h = (k & 1) * 4 + (j & 3); x.Ls = 4096; }
        else { const int k2 = k - 64; x.base = NP_ROWS + (k2 >> 2) * 2048; x.n = ((k2 >> 1) & 1) * 8 + (j >> 2); x.h = (k2 & 1) * 4 + (j & 3); x.Ls = 2048; }
        return x; }
    x.h = u & 7; const int blk = u >> 3;
    if (blk < 256) { x.base = (blk >> 5) * 4096; x.n = blk & 31; x.Ls = 4096; } else { const int b2 = blk - 256; x.base = NP_ROWS + (b2 >> 4) * 2048; x.n = b2 & 15; x.Ls = 2048; } return x; }
__device__ __forceinline__ void stage_a(ALAS unsigned char* L, const bf16* QKV, const UnitA& x, int off, int w, int lane) {
    const int rl = lane >> 4, p = lane & 15, kpos0 = x.n * 128 - 128;
#pragma unroll
    for (int j = 0; j < 12; ++j) { const int q = w + 8 * j, row = 4 * q + rl; int kp = kpos0 + row; kp = kp < 0 ? 0 : (kp > x.Ls - 1 ? x.Ls - 1 : kp);
        ATT_DMA(QKV + hm(off, x.base + kp) + ((p ^ row) & 15) * 8, q); }
}
__device__ __forceinline__ void attn_a(const Frame& F, ALAS unsigned char* L) {
    ALAS float* rkT = (ALAS float*)(L + TAB_OFF); ALAS float* baT = (ALAS float*)(L + TAB_OFF + 2048);
    const bf16* QKV = (const bf16*)(F.ws + WS_QKV); const float* SS = (const float*)(F.ws + WS_SS); bf16* ATT = (bf16*)(F.ws + WS_BUFA);
    const int tid = F.tid, lane = F.lane, w = F.wave, g = lane >> 4, i16 = lane & 15;
    __syncthreads();
    const bool xmap = (F.G == 256);
    if (F.bid < 2560) { const UnitA x0 = decode_a(F.bid, xmap); stage_a(L, QKV, x0, 8 + (x0.h >> 2), w, lane); }
    for (int u = F.bid; u < 2560; u += F.G) {
        const UnitA x = decode_a(u, xmap); const int h = x.h, base = x.base, n = x.n, Ls = x.Ls;
        const int hk = h >> 2, voff = 10 + hk, qoff = h, kpos0 = n * 128 - 128;
        if (tid < 384) { int kp = kpos0 + tid; kp = kp < 0 ? 0 : (kp > Ls - 1 ? Ls - 1 : kp); rkT[tid] = rstd_ss(SS, base + kp, 8 + hk); }
        if (tid < 288) { const int rel = tid - 16 - 128; baT[tid] = (rel >= -128 && rel <= 128) ? F.t5[t5_bucket_dev(rel) * 8 + h] * LOG2E : 0.f; }
        const int qrow = base + n * 128 + 16 * w + i16; const float rq = rstd_ss(SS, qrow, h) * LOG2E;
        const float* gq_ = F.gqa; const float* gk_ = F.gka; asm volatile("" : "+s"(gq_), "+s"(gk_));
        bf16x8 qf[4]; load_q(qf, QKV, qrow, qoff, gq_, gk_, g);
        ATT_VMWAIT(); __syncthreads();
        f32x4 s[17];
        unsigned kb[4];
#pragma unroll
        for (int ks = 0; ks < 4; ++ks) kb[ks] = img_off(16 * w + i16, 4 * ks + g);
#pragma unroll
        for (int t = 0; t < 17; ++t) { f32x4 acc = {0.f, 0.f, 0.f, 0.f};
#pragma unroll
            for (int ks = 0; ks < 4; ++ks) { const bf16x8 kf = *(const ALAS bf16x8*)(L + kb[ks] + t * 4096); acc = __builtin_amdgcn_mfma_f32_16x16x32_bf16(kf, qf[ks], acc, 0, 0, 0); }
            s[t] = acc; }
        __syncthreads();
        stage_a(L, QKV, x, voff, w, lane);
        int bb = 4 * g - i16 + 16; asm volatile("" : "+v"(bb));
        const int nbk = Ls >> 7; float l = 0.f;
#pragma unroll
        for (int t = 0; t < 17; ++t) { const int blk3 = (w + t) >> 3; const bool tile_ok = blk3 == 0 ? (n > 0) : (blk3 == 2 ? (n < nbk - 1) : true);
            if (!tile_ok) { s[t] = (f32x4){0.f, 0.f, 0.f, 0.f}; }
            else { const f32x4 rk4 = *(const ALAS f32x4*)(rkT + 16 * (w + t) + 4 * g) * rq;
#pragma unroll
                for (int r = 0; r < 4; ++r) { const int idx = 16 * t + r + bb; float p = __builtin_amdgcn_exp2f(s[t][r] * rk4[r] + baT[idx]);
                    if (t == 0 || t == 16) p = (unsigned)(idx - 16) <= 256u ? p : 0.f;
                    s[t][r] = p; l += p; } } }
        l += __shfl_xor(l, 16); l += __shfl_xor(l, 32); l += __builtin_amdgcn_exp2f(F.sink[h] * LOG2E);
        bf16x8 pk[9];
#pragma unroll
        for (int kk = 0; kk < 8; ++kk) pk[kk] = pack_p(s[2 * kk], s[2 * kk + 1]);
        pk[8] = pack_p(s[16], (f32x4){0.f, 0.f, 0.f, 0.f});
        ATT_VMWAIT(); __syncthreads();
        f32x4 o[8];
#pragma unroll
        for (int dt = 0; dt < 8; ++dt) o[dt] = (f32x4){0.f, 0.f, 0.f, 0.f};
        unsigned tb[8];
#pragma unroll
        for (int dt = 0; dt < 8; ++dt) tb[dt] = tr_off(16 * w + 4 * g + (i16 >> 2), dt, i16);
        const unsigned t17off = (unsigned)((w == 7 ? 16 : 17) * 4096);
#pragma unroll
        for (int kk = 0; kk < 9; ++kk) { const unsigned offb = kk < 8 ? (unsigned)((2 * kk + 1) * 4096) : t17off;
#pragma unroll
            for (int dt = 0; dt < 8; ++dt) { const v4i16_t lo = vtr(L + tb[dt] + 2 * kk * 4096), hi = vtr(L + tb[dt] + offb);
                const bf16x8 vf = {lo[0], lo[1], lo[2], lo[3], hi[0], hi[1], hi[2], hi[3]};
                o[dt] = __builtin_amdgcn_mfma_f32_16x16x32_bf16(vf, pk[kk], o[dt], 0, 0, 0); } }
        __syncthreads();
        if (u + F.G < 2560) { const UnitA xn = decode_a(u + F.G, xmap); stage_a(L, QKV, xn, 8 + (xn.h >> 2), w, lane); }
        const float inv = 1.0f / l; bf16* op = ATT + (size_t)qrow * D + h * 128 + 4 * g;
#pragma unroll
        for (int dt = 0; dt < 8; ++dt) { const unsigned long long v = (unsigned long long)cvt2(o[dt][0] * inv, o[dt][1] * inv) | ((unsigned long long)cvt2(o[dt][2] * inv, o[dt][3] * inv) << 32); *(unsigned long long*)(op + 16 * dt) = v; }
    }
    ATT_VMWAIT();
}

struct UnitB { int base, r0, rows, kr0, h, half; };
__device__ __forceinline__ UnitB decode_b(int u, bool xmap) { UnitB x;
    if (xmap) { const int bid = u & 255, k = (u >> 8) * 8 + (bid & 7), j = bid >> 3;
        if (k < 64) { x.base = (k >> 3) * 4096; x.h = k & 7; x.half = j & 1; x.r0 = (j >> 1) * 4; x.rows = 64; }
        else { const int p = 2 * (k - 64) + (j >> 4), jj = j & 15; x.base = NP_ROWS + (p >> 3) * 2048; x.h = p & 7; x.half = jj & 1; x.r0 = (jj >> 1) * 4; x.rows = 32; } }
    else { x.h = u & 7; x.half = (u >> 3) & 1; const int rg = u >> 4;
    if (rg < 128) { x.base = (rg >> 4) * 4096; x.r0 = (rg & 15) * 4; x.rows = 64; } else { const int r2 = rg - 128; x.base = NP_ROWS + (r2 >> 3) * 2048; x.r0 = (r2 & 7) * 4; x.rows = 32; } }
    int k = x.r0 - 4; x.kr0 = k < 0 ? 0 : (k > x.rows - 11 ? x.rows - 11 : k); return x; }
__device__ __forceinline__ void stage_b(ALAS unsigned char* L, const bf16* QKV, const UnitB& x, int off, int w, int lane) {
    const int rl = lane >> 4, p = lane & 15, col0 = x.half ? 24 : 0;
#pragma unroll
    for (int j = 0; j < 14; ++j) { const int q = w + 8 * j;
        if (q < 110) { const int row = 4 * q + rl, kr = row / 40, kc = row - kr * 40;
            ATT_DMA(QKV + hm(off, x.base + (x.kr0 + kr) * 64 + col0 + kc) + ((p ^ row) & 15) * 8, q); } }
}
__device__ __forceinline__ void attn_b(const Frame& F, ALAS unsigned char* L) {
    ALAS float* rkT = (ALAS float*)(L + TAB_OFF); ALAS float* bT = (ALAS float*)(L + TAB_OFF + 2048);
    const bf16* QKV = (const bf16*)(F.ws + WS_QKV); const float* SS = (const float*)(F.ws + WS_SS); bf16* ATT = (bf16*)(F.ws + WS_BUFA);
    int tid = F.tid, w = F.wave; asm volatile("" : "+v"(tid), "+s"(w));
    const int lane = tid & 63, g = lane >> 4, i16 = lane & 15;
    __syncthreads();
    const bool xmap = (F.G == 256);
    if (F.bid < 2560) { const UnitB x0 = decode_b(F.bid, xmap); stage_b(L, QKV, x0, 20 + x0.h, w, lane); }
    for (int u = F.bid; u < 2560; u += F.G) {
        const UnitB x = decode_b(u, xmap); const int h = x.h, half = x.half, base = x.base, r0 = x.r0, rows = x.rows, kr0 = x.kr0;
        const int col0 = half ? 24 : 0, qoff = 12 + h, voff = 28 + h;
        const int r = r0 + (w >> 1), cb = 2 * half + (w & 1), c = 16 * cb + i16;
        int rs = r - 4; rs = rs < 0 ? 0 : (rs > rows - 8 ? rows - 8 : rs);
        int reg = 16 * cb - 8; reg = reg < 0 ? 0 : (reg > 32 ? 32 : reg); int cs = c - 8; cs = cs < 0 ? 0 : (cs > 48 ? 48 : cs);
        const int q0 = (rs - kr0) * 40 + (reg - col0);
        if (tid < 440) { const int kr = tid / 40, kc = tid - kr * 40; rkT[tid] = rstd_ss(SS, base + (kr0 + kr) * 64 + col0 + kc, 20 + h); }
        for (int i = tid; i < 640; i += 512) bT[i] = (i >= 64 && i < 64 + 465) ? F.rpb[h * 465 + i - 64] * LOG2E : 0.f;
        const int qrow = base + r * 64 + c; const float rq = rstd_ss(SS, qrow, 12 + h) * LOG2E;
        const float* gq_ = F.gqb; const float* gk_ = F.gkb; asm volatile("" : "+s"(gq_), "+s"(gk_));
        bf16x8 qf[4]; load_q(qf, QKV, qrow, qoff, gq_, gk_, g);
        ATT_VMWAIT(); __syncthreads();
        f32x4 s[16];
        unsigned kb[4];
#pragma unroll
        for (int ks = 0; ks < 4; ++ks) kb[ks] = img_off(q0 + i16, 4 * ks + g);
#pragma unroll
        for (int t = 0; t < 16; ++t) { f32x4 acc = {0.f, 0.f, 0.f, 0.f};
#pragma unroll
            for (int ks = 0; ks < 4; ++ks) { const bf16x8 kf = *(const ALAS bf16x8*)(L + (kb[ks] ^ (unsigned)(((t >> 1) & 1) << 7)) + (40 * (t >> 1) + 16 * (t & 1)) * 256); acc = __builtin_amdgcn_mfma_f32_16x16x32_bf16(kf, qf[ks], acc, 0, 0, 0); }
            s[t] = acc; }
        __syncthreads();
        stage_b(L, QKV, x, voff, w, lane);
        float l = 0.f;
#pragma unroll
        for (int t = 0; t < 16; ++t) { const int i = t >> 1, R0 = q0 + 40 * i + 16 * (t & 1) + 4 * g; const f32x4 rk4 = *(const ALAS f32x4*)(rkT + R0) * rq; const int kc0 = reg + 16 * (t & 1) + 4 * g, brow = (rs + i - r + 7) * 31 + 15 - c + 64;
#pragma unroll
            for (int rr = 0; rr < 4; ++rr) { const int kc = kc0 + rr; float p = __builtin_amdgcn_exp2f(s[t][rr] * rk4[rr] + bT[brow + kc]);
                p = (kc >= cs && kc < cs + 16) ? p : 0.f; s[t][rr] = p; l += p; } }
        l += __shfl_xor(l, 16); l += __shfl_xor(l, 32);
        bf16x8 pk[8];
#pragma unroll
        for (int kk = 0; kk < 8; ++kk) pk[kk] = pack_p(s[2 * kk], s[2 * kk + 1]);
        ATT_VMWAIT(); __syncthreads();
        f32x4 o[8];
#pragma unroll
        for (int d = 0; d < 8; ++d) o[d] = (f32x4){0.f, 0.f, 0.f, 0.f};
        unsigned tb[8];
#pragma unroll
        for (int d = 0; d < 8; ++d) tb[d] = tr_off(q0 + 4 * g + (i16 >> 2), d, i16);
#pragma unroll
        for (int kk = 0; kk < 8; ++kk) {
#pragma unroll
            for (int d = 0; d < 8; ++d) { const unsigned a = (tb[d] ^ (unsigned)((kk & 1) << 7)) + kk * 40 * 256; const v4i16_t lo = vtr(L + a), hi = vtr(L + a + 4096);
                const bf16x8 vf = {lo[0], lo[1], lo[2], lo[3], hi[0], hi[1], hi[2], hi[3]};
                o[d] = __builtin_amdgcn_mfma_f32_16x16x32_bf16(vf, pk[kk], o[d], 0, 0, 0); } }
        __syncthreads();
        if (u + F.G < 2560) { const UnitB xn = decode_b(u + F.G, xmap); stage_b(L, QKV, xn, 20 + xn.h, w, lane); }
        const float inv = 1.0f / l; bf16* op = ATT + (size_t)qrow * D + 1024 + h * 128 + 4 * g;
#pragma unroll
        for (int d = 0; d < 8; ++d) { const unsigned long long v = (unsigned long long)cvt2(o[d][0] * inv, o[d][1] * inv) | ((unsigned long long)cvt2(o[d][2] * inv, o[d][3] * inv) << 32); *(unsigned long long*)(op + 16 * d) = v; }
    }
    ATT_VMWAIT();
}
}

#define XB_TMO      128
#define XB_XCNT(j)  (256  + 64 * (j))
#define XB_XSUB(j)  (1280 + 64 * (j))
#define XB_XGEN(j)  (2304 + 64 * (j))
#define XB_TOP      3328
#define XB_TOPGEN   3392
#define XCD_BAR_WORDS 3456
#define XB_SPIN_CAP (1u << 18)

__device__ __forceinline__ unsigned xb_ld(unsigned* p)              { return __hip_atomic_load(p, __ATOMIC_RELAXED, __HIP_MEMORY_SCOPE_AGENT); }
__device__ __forceinline__ unsigned xb_add(unsigned* p, unsigned v) { return __hip_atomic_fetch_add(p, v, __ATOMIC_RELAXED, __HIP_MEMORY_SCOPE_AGENT); }
__device__ __forceinline__ unsigned xb_xcc_id() { return (unsigned)__builtin_amdgcn_s_getreg((3 << 11) | 20) & 0xFu; }
#define XB_SPIN(cond, bar) do { unsigned _sp = 0; while (cond) { __builtin_amdgcn_s_sleep(1); \
    if ((++_sp & 255u) == 0u) { if (xb_ld(&(bar)[XB_TMO])) break; if (_sp > XB_SPIN_CAP) { atomicAdd(&(bar)[XB_TMO], 1u); break; } } } } while (0)

struct XcdBarrier {
    unsigned* bar; unsigned x;
    volatile LAS unsigned* st;
};

__device__ __forceinline__ XcdBarrier xcd_barrier_post(unsigned* bar, volatile LAS unsigned* st) {
    XcdBarrier b; b.bar = bar; b.x = xb_xcc_id(); b.st = st;
    if (threadIdx.x == 0) (void)xb_add(&bar[XB_XCNT(b.x)], 1u);
    return b;
}
__device__ __forceinline__ void xcd_barrier_complete(unsigned* bar, unsigned x, unsigned& nloc, unsigned& nx) {
    const unsigned G = gridDim.x * gridDim.y * gridDim.z;
    unsigned sum, cnt, mine, sp = 0u;
    for (;;) {
        sum = 0u; cnt = 0u; mine = 0u;
#pragma unroll
        for (unsigned j = 0; j < 16; ++j) { const unsigned c = xb_ld(&bar[XB_XCNT(j)]); sum += c; cnt += (c > 0u) ? 1u : 0u; mine = (j == x) ? c : mine; }
        if (sum == G) break;
        __builtin_amdgcn_s_sleep(1);
        if ((++sp & 255u) == 0u) { if (xb_ld(&bar[XB_TMO])) break; if (sp > XB_SPIN_CAP) { atomicAdd(&bar[XB_TMO], 1u); break; } }
    }
    nloc = mine > 0u ? mine : 1u; nx = cnt > 0u ? cnt : 1u;
}

__device__ __forceinline__ void xcd_barrier(const XcdBarrier& b) {
    asm volatile("s_waitcnt vmcnt(0)" ::: "memory");
    __syncthreads();
    if (threadIdx.x == 0) {
        unsigned* bar = b.bar;
        __builtin_amdgcn_s_waitcnt(0);
        unsigned nloc = b.st[0], nx = b.st[1];
        if (nloc == 0u) { xcd_barrier_complete(bar, b.x, nloc, nx); b.st[0] = nloc; b.st[1] = nx; }
        const unsigned old = xb_add(&bar[XB_XSUB(b.x)], 1u);
        const unsigned gen = old / nloc;
        if (old + 1u == (gen + 1u) * nloc) {
            __builtin_amdgcn_fence(__ATOMIC_RELEASE, "agent");
            asm volatile("s_waitcnt vmcnt(0)" ::: "memory");
            const unsigned og = xb_add(&bar[XB_TOP], 1u);
            const unsigned tg = og / nx;
            if (og + 1u == (tg + 1u) * nx) xb_add(&bar[XB_TOPGEN], 1u);
            else XB_SPIN(xb_ld(&bar[XB_TOPGEN]) == tg, bar);
            __builtin_amdgcn_fence(__ATOMIC_ACQUIRE, "agent");
            xb_add(&bar[XB_XGEN(b.x)], 1u);
            asm volatile("s_waitcnt vmcnt(0)" ::: "memory");
        } else {
            XB_SPIN(xb_ld(&bar[XB_XGEN(b.x)]) == gen, bar);
            __builtin_amdgcn_fence(__ATOMIC_ACQUIRE, "agent");
            asm volatile("s_waitcnt vmcnt(0)" ::: "memory");
        }
    }
    __syncthreads();
}

struct Args { const float* in[17]; float* out; unsigned char* ws; int ph_lo, ph_hi; };
constexpr int N_PHASES = 8;
__global__ void __launch_bounds__(NWAVES * 64, 2) fwd_megakernel(Args args) {
    extern __shared__ __attribute__((aligned(16))) unsigned char lds[];
    cg::grid_group grid = cg::this_grid();
    Frame F;
    F.lds = lds; F.tid = threadIdx.x; F.lane = F.tid & 63; F.wave = __builtin_amdgcn_readfirstlane(F.tid >> 6); F.G = gridDim.x; F.bid = blockIdx.x;
    F.xp = args.in[0]; F.xs = args.in[1]; F.g1 = args.in[2]; F.w_in = args.in[3]; F.gqa = args.in[4]; F.gka = args.in[5]; F.t5 = args.in[6]; F.sink = args.in[7];
    F.gqb = args.in[8]; F.gkb = args.in[9]; F.rpb = args.in[10]; F.wbra = args.in[11]; F.wbrb = args.in[12]; F.wout = args.in[13]; F.g2 = args.in[14]; F.wup = args.in[15]; F.wdn = args.in[16];
    F.out = args.out; F.ws = args.ws;
    unsigned char* ws = args.ws;
    PG8_LAS unsigned char* ldsl = (PG8_LAS unsigned char*)lds;
    const int lo = args.ph_lo, hi = args.ph_hi;
#ifndef PHASE_MASK
#define PHASE_MASK 0xff
#endif
#define IN(k) (((PHASE_MASK >> (k)) & 1) && lo <= (k) && (k) < hi)
#define STAMP() do {} while (0)
#define SEAM(k) do { if (IN(k) && IN((k) + 1)) { if ((k) == 0) grid.sync(); else xcd_barrier(xbar); } STAMP(); } while (0)
    bf16* BUFA = (bf16*)(ws + WS_BUFA); bf16* QKV = (bf16*)(ws + WS_QKV); bf16* GATES = (bf16*)(ws + WS_GATES);
    float* SS = (float*)(ws + WS_SS); float* SS2 = (float*)(ws + WS_SS2); float* RSTD2 = (float*)(ws + WS_RSTD2);

    STAMP();
    { volatile LAS unsigned* st_ = (volatile LAS unsigned*)((LAS unsigned char*)lds + 139264 + 256); if (F.tid < 2) st_[F.tid] = 0u; __syncthreads(); }
    XcdBarrier xbar; xbar.bar = (unsigned*)(ws + WS_BAR); xbar.x = 0u; xbar.st = (volatile LAS unsigned*)((LAS unsigned char*)lds + 139264 + 256);
    if (IN(0)) { if (F.bid == 0) for (int i = F.tid; i < XCD_BAR_WORDS; i += NWAVES * 64) ((unsigned*)(ws + WS_BAR))[i] = 0u;
        p0_prologue(F); __syncthreads(); }
    SEAM(0);
    xbar = xcd_barrier_post((unsigned*)(ws + WS_BAR), (volatile LAS unsigned*)((LAS unsigned char*)lds + 139264 + 256));
    if (IN(1)) {
        pg8::Gemm g{BUFA, (const bf16*)(ws + WS_WIN), M_ROWS, INW, D}; pg8::StaticOrder S; S.init(M_ROWS, INW, F.G, F.bid);
        pg8::EpiProj E{QKV, GATES, SS};
        pg8::gemm_phase<pg8::EpiProj, pg8::StaticOrder, true, true>(ldsl, g, S, E);
    }
    SEAM(1);
    if (IN(2)) { att::attn_a(F, (ALAS unsigned char*)lds); att::attn_b(F, (ALAS unsigned char*)lds); __syncthreads(); }
    SEAM(2);
    if (IN(3)) {
        pg8::Gemm g{BUFA, (const bf16*)(ws + WS_WBR), M_ROWS, D, D}; pg8::StaticOrder S; S.init(M_ROWS, D, F.G, F.bid);
        pg8::EpiMerge E{GATES, QKV};
        pg8::gemm_phase<pg8::EpiMerge, pg8::StaticOrder, true, true>(ldsl, g, S, E);
    }
    SEAM(3);
    if (IN(4)) {
        pg8::Gemm g{QKV, (const bf16*)(ws + WS_WOUT), M_ROWS, D, D}; pg8::StaticOrder S; S.init(M_ROWS, D, F.G, F.bid);
        pg8::EpiOut1 E{F.xp, F.xs, F.out, BUFA, SS2};
        pg8::gemm_phase<pg8::EpiOut1, pg8::StaticOrder, true, true>(ldsl, g, S, E);
    }
    SEAM(4);
    if (IN(5)) {
        for (int m = F.bid * 512 + F.tid; m < M_ROWS; m += F.G * 512) { const f32x4* p = (const f32x4*)(SS2 + (size_t)m * 32); float s = 0.f;
#pragma unroll
            for (int j = 0; j < 8; ++j) { const f32x4 v = p[j]; s += (v.x + v.y) + (v.z + v.w); }
            RSTD2[m] = 1.0f / sqrtf(s * (1.f / D) + EPS); }
    }
    SEAM(5);
    if (IN(6)) {
        pg8::Gemm g{BUFA, (const bf16*)(ws + WS_WUP), M_ROWS, FF, D}; pg8::StaticOrder S; S.init(M_ROWS, FF, F.G, F.bid);
        pg8::EpiUp E{RSTD2, QKV};
        pg8::gemm_phase<pg8::EpiUp, pg8::StaticOrder, true, true>(ldsl, g, S, E);
    }
    SEAM(6);
    if (IN(7)) {
        pg8::Gemm g{QKV, (const bf16*)(ws + WS_WDN), M_ROWS, D, FF}; pg8::StaticOrder S; S.init(M_ROWS, D, F.G, F.bid);
        pg8::EpiDown E{F.out, BUFA};
        pg8::gemm_phase<pg8::EpiDown, pg8::StaticOrder, true, true>(ldsl, g, S, E);
    }
#undef IN
#undef SEAM
}


extern "C" void kernel_launch(void* const* d_in, const int* in_sizes, int n_in, void* d_out, int out_size, void* d_ws, size_t ws_size, hipStream_t stream) {
    static int grid = 0;
    if (grid == 0) {
        if (n_in != 17 || in_sizes[0] != NP_ROWS * D || in_sizes[1] != (M_ROWS - NP_ROWS) * D || out_size != M_ROWS * D || ws_size < WS_END) {
            fprintf(stderr, "kernel_launch: shape/workspace mismatch (n_in %d, in0 %d, out %d, ws %zu < %zu); nothing launched\n", n_in, n_in > 0 ? in_sizes[0] : -1, out_size, ws_size, (size_t)WS_END); grid = -1; return; }
        int dev = 0, cus = 0, per_cu = 0;
        if (hipGetDevice(&dev) != hipSuccess || hipDeviceGetAttribute(&cus, hipDeviceAttributeMultiprocessorCount, dev) != hipSuccess) { fprintf(stderr, "kernel_launch: device query failed\n"); grid = -1; return; }
        if (hipFuncSetAttribute((const void*)fwd_megakernel, hipFuncAttributeMaxDynamicSharedMemorySize, LDS_BYTES) != hipSuccess) { fprintf(stderr, "kernel_launch: hipFuncSetAttribute failed\n"); grid = -1; return; }
        if (hipOccupancyMaxActiveBlocksPerMultiprocessor(&per_cu, (const void*)fwd_megakernel, NWAVES * 64, LDS_BYTES) != hipSuccess || per_cu < 1) { fprintf(stderr, "kernel_launch: occupancy query says %d blocks per CU\n", per_cu); per_cu = 1; }
        (void)hipGetLastError();
        grid = cus * 1;
    }
    if (grid < 0) return;
    Args a{};
    for (int i = 0; i < 17; ++i) a.in[i] = (const float*)d_in[i];
    a.out = (float*)d_out; a.ws = (unsigned char*)d_ws;
#if MK_N_LAUNCHES == 1
    a.ph_lo = 0; a.ph_hi = N_PHASES;
    void* kargs[] = {&a};
    hipError_t e = hipLaunchCooperativeKernel((const void*)fwd_megakernel, dim3(grid), dim3(NWAVES * 64), kargs, LDS_BYTES, stream);
    if (e != hipSuccess) fprintf(stderr, "kernel_launch: cooperative launch failed: %s (grid %d)\n", hipGetErrorString(e), grid);
#else
    for (int ph = 0; ph < N_PHASES; ++ph) {
        a.ph_lo = ph; a.ph_hi = ph + 1;
        hipLaunchKernelGGL(fwd_megakernel, dim3(grid), dim3(NWAVES * 64), LDS_BYTES, stream, a);
        const hipError_t le = hipPeekAtLastError();
        if (le != hipSuccess) { fprintf(stderr, "kernel_launch: launch %d failed: %s\n", ph, hipGetErrorName(le)); break; }
    }
#endif
}
```

```cpp
#include <hip/hip_runtime.h>
#include <hip/hip_cooperative_groups.h>
#include <cstdio>
#include <cstdint>
namespace cg = cooperative_groups;
#define MK_N_LAUNCHES 1
namespace pg8 {
#define PG8_LAS __attribute__((address_space(3)))
typedef unsigned short bf16_t;
typedef short bf16x8 __attribute__((ext_vector_type(8)));
typedef float f32x4 __attribute__((ext_vector_type(4)));
typedef unsigned u32x4 __attribute__((ext_vector_type(4)));
constexpr int BM = 256, BK = 64, HALF = 128, HTB = HALF * BK * 2  , STAGE_BYTES = 8 * HTB, NXCD = 8, WGM = 8;

__host__ __device__ __forceinline__ int lds_byte(int r, int c) { const int st = (r >> 4) * 2 + (c >> 5), rr = r & 15, cc = c & 31, ob = rr * 64 + cc * 2; return st * 1024 + (ob ^ (((ob >> 9) & 1) << 5)); }
__host__ __device__ __forceinline__ void stage_rc(int b, int& R, int& C) { const int st = b / 1024, sb = b % 1024, swz = sb ^ (((sb >> 9) & 1) << 5); R = (st >> 1) * 16 + swz / 64; C = (st & 1) * 32 + (swz % 64) / 2; }
__host__ __device__ __forceinline__ int perm32(int rho) { const int n = rho >> 4, i = rho & 15; return 8 * (i >> 2) + 4 * n + (i & 3); }

struct Unit { int pm, pn; };
struct Gemm { const bf16_t* A; const bf16_t* Bt; int M, N, K; };

struct StaticOrder {
    int nM, nN, nwg, G, c;
    __host__ __device__ void init(int M, int N, int G_, int c_) { nM = M / BM; nN = N / BM; nwg = nM * nN; G = G_; c = c_; }
    __host__ __device__ bool next(int i, Unit& u) const {
        const long L = (long)i * G + c; if (L >= nwg) return false;
        int wgid = (int)L; { const int q = nwg / NXCD, r = nwg % NXCD, xcd = wgid % NXCD, off = wgid / NXCD; wgid = (xcd < r ? xcd * (q + 1) : r * (q + 1) + (xcd - r) * q) + off; }
        const int nig = WGM * nN, gid = wgid / nig, fm = gid * WGM, gsz = (nM - fm) < WGM ? (nM - fm) : WGM;
        u.pm = fm + ((wgid % nig) % gsz); u.pn = (wgid % nig) / gsz; return true;
    }
    __device__ __forceinline__ void a_ready(const Unit&) const {}
    __device__ __forceinline__ void done(const Unit&) const {}
};

__device__ __forceinline__ unsigned cvt_pk_bf16(float lo, float hi) { unsigned r; asm volatile("s_nop 0\n\tv_cvt_pk_bf16_f32 %0, %1, %2" : "=v"(r) : "v"(lo), "v"(hi)); return r; }
typedef float f32x2 __attribute__((ext_vector_type(2)));
typedef unsigned u32x2 __attribute__((ext_vector_type(2)));
__device__ __forceinline__ float bf_lo(unsigned w) { return __uint_as_float(w << 16); }
__device__ __forceinline__ float bf_hi(unsigned w) { return __uint_as_float(w & 0xffff0000u); }
__device__ __forceinline__ u32x4 pack8(const f32x4 v0, const f32x4 v1) { u32x4 w; w.x = cvt_pk_bf16(v0[0], v0[1]); w.y = cvt_pk_bf16(v0[2], v0[3]); w.z = cvt_pk_bf16(v1[0], v1[1]); w.w = cvt_pk_bf16(v1[2], v1[3]); return w; }
__device__ __forceinline__ float sigmoidf_(float x) { return __builtin_amdgcn_rcpf(1.0f + __builtin_amdgcn_exp2f(-1.44269504089f * x)); }
constexpr int QKV_LD = 4608, GATE_LD = 4096, DM = 2048, FFD = 8192, NHS = 36, NPROMPT_ROWS = 32768;

struct EpiProj {
    static constexpr bool PERM = true, AFTER_DRAIN = false, MID = false;
    bf16_t* QKV; bf16_t* GATES; float* SS;
    __device__ __forceinline__ void operator()(const f32x4 (&acc)[2][2][4][2], const Unit& u, int wr, int wc, int fr, int fq) const {
        const int row0 = u.pm * BM + wr * 64 + fr;
        asm volatile("s_nop 15\n\ts_nop 15" ::: "memory");
        if (u.pn < 18) {
            const int col0 = u.pn * BM + wc * 32 + 8 * fq;
#pragma unroll
            for (int ai = 0; ai < 2; ++ai)
#pragma unroll
                for (int m = 0; m < 4; ++m) { const int row = row0 + ai * HALF + m * 16; bf16_t* rowp = QKV + ((size_t)(u.pn * 2) * 40960 + (size_t)row) * 128 + wc * 32 + 8 * fq;
#pragma unroll
                    for (int bj = 0; bj < 2; ++bj) { const f32x4 v0 = acc[ai][bj][m][0], v1 = acc[ai][bj][m][1];
                        float s = (v0[0] * v0[0] + v0[1] * v0[1]) + (v0[2] * v0[2] + v0[3] * v0[3]) + (v1[0] * v1[0] + v1[1] * v1[1]) + (v1[2] * v1[2] + v1[3] * v1[3]);
                        s += __shfl_xor(s, 16); s += __shfl_xor(s, 32);
                        if (fq == 0) SS[((size_t)row * NHS + u.pn * 2 + bj) * 4 + wc] = s;
                        *(u32x4*)(rowp + (size_t)bj * 40960 * 128) = pack8(v0, v1); } }
        } else {
            const int col0 = (u.pn - 18) * BM + wc * 32 + 8 * fq;
#pragma unroll
            for (int ai = 0; ai < 2; ++ai)
#pragma unroll
                for (int m = 0; m < 4; ++m) { const int row = row0 + ai * HALF + m * 16; bf16_t* rowp = GATES + (size_t)row * GATE_LD + col0;
#pragma unroll
                    for (int bj = 0; bj < 2; ++bj) { f32x4 v0 = acc[ai][bj][m][0], v1 = acc[ai][bj][m][1];
#pragma unroll
                        for (int j = 0; j < 4; ++j) { v0[j] = sigmoidf_(v0[j]); v1[j] = sigmoidf_(v1[j]); }
                        *(u32x4*)(rowp + bj * HALF) = pack8(v0, v1); } }
        }
    }
};

struct EpiMerge {
    static constexpr bool PERM = true, AFTER_DRAIN = false, MID = true;
    const bf16_t* GATES; bf16_t* OUT;
    __device__ __forceinline__ void mid(f32x4 (&acc)[2][2][4][2], const Unit& u, int wr, int wc, int fr, int fq) const {
        const int row0 = u.pm * BM + wr * 64 + fr, col0 = u.pn * BM + wc * 32 + 8 * fq;
        const bf16_t* gp0 = GATES + (size_t)row0 * GATE_LD + col0;
        asm volatile("" : "+v"(gp0));
#pragma unroll
        for (int ai = 0; ai < 2; ++ai) { u32x4 ga[4][2], gb[4][2];
#pragma unroll
            for (int m = 0; m < 4; ++m)
#pragma unroll
                for (int bj = 0; bj < 2; ++bj) { const bf16_t* gp = gp0 + (size_t)(ai * HALF + m * 16) * GATE_LD + bj * HALF; ga[m][bj] = *(const u32x4*)gp; gb[m][bj] = *(const u32x4*)(gp + DM); }
#pragma unroll
            for (int m = 0; m < 4; ++m)
#pragma unroll
                for (int bj = 0; bj < 2; ++bj) { const u32x4 a = ga[m][bj], b = gb[m][bj]; f32x4& c0 = acc[ai][bj][m][0]; f32x4& c1 = acc[ai][bj][m][1];
                    c0[0] *= bf_lo(a.x) * __builtin_amdgcn_rcpf(bf_lo(b.x)); c0[1] *= bf_hi(a.x) * __builtin_amdgcn_rcpf(bf_hi(b.x));
                    c0[2] *= bf_lo(a.y) * __builtin_amdgcn_rcpf(bf_lo(b.y)); c0[3] *= bf_hi(a.y) * __builtin_amdgcn_rcpf(bf_hi(b.y));
                    c1[0] *= bf_lo(a.z) * __builtin_amdgcn_rcpf(bf_lo(b.z)); c1[1] *= bf_hi(a.z) * __builtin_amdgcn_rcpf(bf_hi(b.z));
                    c1[2] *= bf_lo(a.w) * __builtin_amdgcn_rcpf(bf_lo(b.w)); c1[3] *= bf_hi(a.w) * __builtin_amdgcn_rcpf(bf_hi(b.w)); }
            asm volatile("" ::: "memory"); }
    }
    __device__ __forceinline__ void operator()(const f32x4 (&acc)[2][2][4][2], const Unit& u, int wr, int wc, int fr, int fq) const {
        const int row0 = u.pm * BM + wr * 64 + fr, col0 = u.pn * BM + wc * 32 + 8 * fq;
        u32x4 gb[2][4][2];
#pragma unroll
        for (int ai = 0; ai < 2; ++ai)
#pragma unroll
            for (int m = 0; m < 4; ++m)
#pragma unroll
                for (int bj = 0; bj < 2; ++bj) gb[ai][m][bj] = *(const u32x4*)(GATES + (size_t)(row0 + ai * HALF + m * 16) * GATE_LD + DM + col0 + bj * HALF);
#pragma unroll
        for (int ai = 0; ai < 2; ++ai)
#pragma unroll
            for (int m = 0; m < 4; ++m) { bf16_t* op = OUT + (size_t)(row0 + ai * HALF + m * 16) * DM + col0;
#pragma unroll
                for (int bj = 0; bj < 2; ++bj) { const u32x4 b = gb[ai][m][bj];
                    f32x4 v0 = acc[ai][bj][m][0], v1 = acc[ai][bj][m][1];
                    v0[0] *= bf_lo(b.x); v0[1] *= bf_hi(b.x); v0[2] *= bf_lo(b.y); v0[3] *= bf_hi(b.y);
                    v1[0] *= bf_lo(b.z); v1[1] *= bf_hi(b.z); v1[2] *= bf_lo(b.w); v1[3] *= bf_hi(b.w);
                    *(u32x4*)(op + bj * HALF) = pack8(v0, v1); } }
    }
};

struct EpiOut1 {
    static constexpr bool PERM = true, AFTER_DRAIN = false, MID = false;
    const float* xp; const float* xs; float* OUT; bf16_t* X1B; float* SS2;
    __device__ __forceinline__ void operator()(const f32x4 (&acc)[2][2][4][2], const Unit& u, int wr, int wc, int fr, int fq) const {
        const int row0 = u.pm * BM + wr * 64 + fr, col0 = u.pn * BM + wc * 32 + 8 * fq;
        const float* xb = (u.pm * BM < NPROMPT_ROWS) ? xp : xs - (size_t)NPROMPT_ROWS * DM;
#pragma unroll
        for (int ai = 0; ai < 2; ++ai) { f32x4 xv[4][2][2];
#pragma unroll
            for (int m = 0; m < 4; ++m)
#pragma unroll
                for (int bj = 0; bj < 2; ++bj) { const float* xr = xb + (size_t)(row0 + ai * HALF + m * 16) * DM + col0 + bj * HALF; xv[m][bj][0] = *(const f32x4*)xr; xv[m][bj][1] = *(const f32x4*)(xr + 4); }
#pragma unroll
            for (int m = 0; m < 4; ++m) { const size_t row = (size_t)(row0 + ai * HALF + m * 16); bf16_t* bp = X1B + row * DM + col0;
                float s = 0.f;
#pragma unroll
                for (int bj = 0; bj < 2; ++bj) { const f32x4 v0 = acc[ai][bj][m][0] + xv[m][bj][0], v1 = acc[ai][bj][m][1] + xv[m][bj][1];
                    s += (v0[0] * v0[0] + v0[1] * v0[1]) + (v0[2] * v0[2] + v0[3] * v0[3]) + (v1[0] * v1[0] + v1[1] * v1[1]) + (v1[2] * v1[2] + v1[3] * v1[3]);
                    *(u32x4*)(bp + bj * HALF) = pack8(v0, v1); }
                s += __shfl_xor(s, 16); s += __shfl_xor(s, 32);
                if (fq == 0) SS2[row * 32 + u.pn * 4 + wc] = s; }
            asm volatile("" ::: "memory"); }
    }
};

struct EpiUp {
    static constexpr bool PERM = true, AFTER_DRAIN = false, MID = false;
    const PG8_LAS float* rsT; const PG8_LAS int* pmT; bf16_t* U;
    __device__ __forceinline__ void operator()(const f32x4 (&acc)[2][2][4][2], const Unit& u, int wr, int wc, int fr, int fq) const {
        const int row0 = u.pm * BM + wr * 64 + fr, col0 = u.pn * BM + wc * 32 + 8 * fq;
        int slot = 0;
#pragma unroll
        for (int k = 1; k < 8; ++k) slot = (pmT[k] == u.pm) ? k : slot;
        const PG8_LAS float* rsp = rsT + slot * BM + wr * 64 + fr;
#pragma unroll
        for (int ai = 0; ai < 2; ++ai)
#pragma unroll
            for (int m = 0; m < 4; ++m) { const size_t row = (size_t)(row0 + ai * HALF + m * 16); const float rs = rsp[ai * HALF + m * 16]; bf16_t* op = U + row * FFD + col0;
#pragma unroll
                for (int bj = 0; bj < 2; ++bj) { f32x4 v0 = acc[ai][bj][m][0] * rs, v1 = acc[ai][bj][m][1] * rs;
#pragma unroll
                    for (int j = 0; j < 4; ++j) { const float a = fmaxf(v0[j], 0.f), b = fmaxf(v1[j], 0.f); v0[j] = a * a; v1[j] = b * b; }
                    *(u32x4*)(op + bj * HALF) = pack8(v0, v1); } }
    }
};

struct EpiDown {
    static constexpr bool PERM = true, AFTER_DRAIN = false, MID = false;
    float* OUT; const bf16_t* X1B;
    __device__ __forceinline__ void operator()(const f32x4 (&acc)[2][2][4][2], const Unit& u, int wr, int wc, int fr, int fq) const {
        const int row0 = u.pm * BM + wr * 64 + fr, col0 = u.pn * BM + wc * 32 + 8 * fq;
        u32x4 xw[2][4][2];
#pragma unroll
        for (int ai = 0; ai < 2; ++ai)
#pragma unroll
            for (int m = 0; m < 4; ++m)
#pragma unroll
                for (int bj = 0; bj < 2; ++bj) xw[ai][m][bj] = *(const u32x4*)(X1B + (size_t)(row0 + ai * HALF + m * 16) * DM + col0 + bj * HALF);
#pragma unroll
        for (int ai = 0; ai < 2; ++ai)
#pragma unroll
            for (int m = 0; m < 4; ++m) { float* op = OUT + (size_t)(row0 + ai * HALF + m * 16) * DM + col0;
#pragma unroll
                for (int bj = 0; bj < 2; ++bj) { const u32x4 x = xw[ai][m][bj]; f32x4 v0 = acc[ai][bj][m][0], v1 = acc[ai][bj][m][1];
                    v0[0] += bf_lo(x.x); v0[1] += bf_hi(x.x); v0[2] += bf_lo(x.y); v0[3] += bf_hi(x.y); v1[0] += bf_lo(x.z); v1[1] += bf_hi(x.z); v1[2] += bf_lo(x.w); v1[3] += bf_hi(x.w);
                    *(f32x4*)(op + bj * HALF) = v0; *(f32x4*)(op + bj * HALF + 4) = v1; } }
    }
};

template <class Epi, class Sched, bool ALIGN_EPI = false, bool SP2 = false>
__device__ __forceinline__ void gemm_phase(PG8_LAS unsigned char* lds, const Gemm g, const Sched& S, const Epi& E) {
    const int tid = threadIdx.x, wid = __builtin_amdgcn_readfirstlane(tid >> 6), lane = tid & 63, wr = wid >> 2, wc = wid & 3, fr = lane & 15, fq = lane >> 4;
    const int K = g.K, nt = K / BK;
    unsigned voffA[2], voffB[2];
#pragma unroll
    for (int i = 0; i < 2; ++i) { int R, C; stage_rc(tid * 16 + i * 8192, R, C); const int Rb = Epi::PERM ? ((R & ~31) + perm32(R & 31)) : R;
        voffA[i] = (unsigned)(R * K + C) * 2u; voffB[i] = (unsigned)(Rb * K + C) * 2u; }
    const size_t kstep = (size_t)(BK * 2);
    const size_t hstep = (size_t)HALF * K * 2;
    const size_t tstep = 2 * hstep;
    const unsigned ldsw = (unsigned)wid * 1024u;
    const int aoff = lds_byte(wr * 64 + fr, fq * 8), boff = lds_byte(wc * 32 + fr, fq * 8);
#define PG8_SA(b, h) (((b) * 2 + (h)) * HTB)
#define PG8_SB(b, h) ((4 + (b) * 2 + (h)) * HTB)
#define PG8_STAGE(bufoff, gbase, voff) do { _Pragma("unroll") for (int _i = 0; _i < 2; ++_i) \
        __builtin_amdgcn_global_load_lds((const unsigned*)((const char*)(gbase) + (voff)[_i]), (PG8_LAS unsigned*)(lds + (bufoff) + ldsw + _i * 8192), 16, 0, 0); } while (0)
#define PG8_LDA(dst, b, h) do { _Pragma("unroll") for (int m = 0; m < 4; ++m) _Pragma("unroll") for (int k = 0; k < 2; ++k) dst[m][k] = *(const PG8_LAS bf16x8*)(lds + PG8_SA(b, h) + aoff + m * 2048 + k * 1024); } while (0)
#define PG8_LDB(dst, b, h) do { _Pragma("unroll") for (int n = 0; n < 2; ++n) _Pragma("unroll") for (int k = 0; k < 2; ++k) dst[n][k] = *(const PG8_LAS bf16x8*)(lds + PG8_SB(b, h) + boff + n * 2048 + k * 1024); } while (0)
#define PG8_MMA(ai, bj, At, Bt) do { __builtin_amdgcn_s_setprio(1); _Pragma("unroll") for (int m = 0; m < 4; ++m) _Pragma("unroll") for (int n = 0; n < 2; ++n) _Pragma("unroll") for (int k = 0; k < 2; ++k) \
        acc[ai][bj][m][n] = __builtin_amdgcn_mfma_f32_16x16x32_bf16(Bt[n][k], At[m][k], acc[ai][bj][m][n], 0, 0, 0); __builtin_amdgcn_s_setprio(0); } while (0)
#define PG8_WAIT_V(n) asm volatile("s_waitcnt vmcnt(" #n ")" ::: "memory")
#define PG8_WAIT_L(n) asm volatile("s_waitcnt lgkmcnt(" #n ")" ::: "memory")
#define PG8_BAR __builtin_amdgcn_s_barrier()
#define PG8_SCHED __builtin_amdgcn_sched_barrier(0)
    Unit cur, nxt; int ui = 0;
    if (!S.next(0, cur)) return;
    f32x4 acc[2][2][4][2];
#pragma unroll
    for (int a = 0; a < 2; ++a)
#pragma unroll
        for (int b = 0; b < 2; ++b)
#pragma unroll
            for (int m = 0; m < 4; ++m)
#pragma unroll
                for (int n = 0; n < 2; ++n) acc[a][b][m][n] = (f32x4){0.f, 0.f, 0.f, 0.f};
    bf16x8 At[4][2], B0[2][2], B1[2][2];
    const char* cA = (const char*)g.A + (size_t)cur.pm * tstep; const char* cB = (const char*)g.Bt + (size_t)cur.pn * tstep;
    S.a_ready(cur);
    if constexpr (SP2) {
        PG8_STAGE(PG8_SB(0, 0), cB, voffB); PG8_STAGE(PG8_SB(0, 1), cB + hstep, voffB); PG8_STAGE(PG8_SA(0, 0), cA, voffA); PG8_STAGE(PG8_SA(0, 1), cA + hstep, voffA);
        if (wr == 1) PG8_BAR;
        PG8_WAIT_V(2); PG8_BAR;
        PG8_STAGE(PG8_SB(1, 0), cB + kstep, voffB); PG8_STAGE(PG8_SA(1, 0), cA + kstep, voffA); PG8_STAGE(PG8_SB(1, 1), cB + hstep + kstep, voffB);
        PG8_WAIT_V(6); PG8_BAR;
    } else {
        PG8_STAGE(PG8_SB(0, 0), cB, voffB); PG8_STAGE(PG8_SA(0, 0), cA, voffA); PG8_STAGE(PG8_SB(0, 1), cB + hstep, voffB); PG8_STAGE(PG8_SA(0, 1), cA + hstep, voffA);
        if (wr == 1) PG8_BAR;
        PG8_WAIT_V(4); PG8_BAR;
        PG8_STAGE(PG8_SB(1, 0), cB + kstep, voffB); PG8_STAGE(PG8_SA(1, 0), cA + kstep, voffA); PG8_STAGE(PG8_SB(1, 1), cB + hstep + kstep, voffB);
        PG8_WAIT_V(6); PG8_BAR;
    }
    for (;;) {
        const bool has_next = S.next(ui + 1, nxt);
        const char* nA = has_next ? (const char*)g.A + (size_t)nxt.pm * tstep : cA; const char* nB = has_next ? (const char*)g.Bt + (size_t)nxt.pn * tstep : cB;
        constexpr int NSEG = Epi::MID ? 2 : 1; const int seglen = nt / NSEG;
        for (int seg = 0; seg < NSEG; ++seg) {
        if constexpr (Epi::MID) { if (seg == 1) E.mid(acc, cur, wr, wc, fr, fq); }
        for (int t = seg * seglen; t < (seg + 1) * seglen; t += 2) {
            const bool last = (t == nt - 2);
            const char* a1 = cA + (size_t)(t + 1) * kstep;
            const char* a2 = last ? nA : cA + (size_t)(t + 2) * kstep; const char* b2 = last ? nB : cB + (size_t)(t + 2) * kstep;
            const char* a3 = a2 + kstep; const char* b3 = b2 + kstep;
            if (last && has_next) S.a_ready(nxt);
            if constexpr (SP2) {
            PG8_LDB(B0, 0, 0); PG8_LDB(B1, 0, 1); PG8_SCHED; PG8_LDA(At, 0, 0); PG8_STAGE(PG8_SA(1, 1), a1 + hstep, voffA);
            PG8_WAIT_V(8); PG8_WAIT_L(0); PG8_BAR; PG8_MMA(0, 0, At, B0); PG8_MMA(0, 1, At, B1); PG8_BAR; PG8_SCHED;
            PG8_LDA(At, 0, 1); PG8_STAGE(PG8_SB(0, 0), b2, voffB); PG8_STAGE(PG8_SB(0, 1), b2 + hstep, voffB); PG8_STAGE(PG8_SA(0, 0), a2, voffA);
            PG8_WAIT_V(8); PG8_WAIT_L(0); PG8_BAR; PG8_MMA(1, 0, At, B0); PG8_MMA(1, 1, At, B1); PG8_BAR; PG8_SCHED;
            PG8_LDB(B0, 1, 0); PG8_LDB(B1, 1, 1); PG8_SCHED; PG8_LDA(At, 1, 0); PG8_STAGE(PG8_SA(0, 1), a2 + hstep, voffA);
            PG8_WAIT_V(8); PG8_WAIT_L(0); PG8_BAR; PG8_MMA(0, 0, At, B0); PG8_MMA(0, 1, At, B1); PG8_BAR; PG8_SCHED;
            PG8_LDA(At, 1, 1); PG8_STAGE(PG8_SB(1, 0), b3, voffB); PG8_STAGE(PG8_SB(1, 1), b3 + hstep, voffB); PG8_STAGE(PG8_SA(1, 0), a3, voffA);
            PG8_WAIT_V(8); PG8_WAIT_L(0); PG8_BAR; PG8_MMA(1, 0, At, B0); PG8_MMA(1, 1, At, B1); PG8_BAR; PG8_SCHED;
            } else {
            PG8_LDB(B0, 0, 0); PG8_SCHED; PG8_LDA(At, 0, 0); PG8_STAGE(PG8_SA(1, 1), a1 + hstep, voffA);
            PG8_WAIT_L(8); PG8_BAR; PG8_WAIT_L(0); PG8_MMA(0, 0, At, B0); PG8_BAR; PG8_SCHED;
            PG8_LDB(B1, 0, 1); PG8_STAGE(PG8_SB(0, 0), b2, voffB);
            PG8_BAR; PG8_WAIT_L(0); PG8_MMA(0, 1, At, B1); PG8_BAR;
            PG8_LDA(At, 0, 1); PG8_STAGE(PG8_SA(0, 0), a2, voffA);
            PG8_BAR; PG8_WAIT_L(0); PG8_MMA(1, 0, At, B0); PG8_BAR; PG8_SCHED;
            PG8_STAGE(PG8_SB(0, 1), b2 + hstep, voffB);
            PG8_WAIT_V(6); PG8_BAR; PG8_MMA(1, 1, At, B1); PG8_BAR;
            PG8_LDB(B0, 1, 0); PG8_SCHED; PG8_LDA(At, 1, 0); PG8_STAGE(PG8_SA(0, 1), a2 + hstep, voffA);
            PG8_WAIT_L(8); PG8_BAR; PG8_WAIT_L(0); PG8_MMA(0, 0, At, B0); PG8_BAR; PG8_SCHED;
            PG8_LDB(B1, 1, 1); PG8_STAGE(PG8_SB(1, 0), b3, voffB);
            PG8_BAR; PG8_WAIT_L(0); PG8_MMA(0, 1, At, B1); PG8_BAR;
            PG8_LDA(At, 1, 1); PG8_STAGE(PG8_SA(1, 0), a3, voffA);
            PG8_BAR; PG8_WAIT_L(0); PG8_MMA(1, 0, At, B0); PG8_BAR; PG8_SCHED;
            PG8_STAGE(PG8_SB(1, 1), b3 + hstep, voffB);
            PG8_WAIT_V(6); PG8_BAR; PG8_MMA(1, 1, At, B1); PG8_BAR;
            }
        }
        }
        if constexpr (ALIGN_EPI) { if (wr == 0) PG8_BAR; }
        if constexpr (!Epi::AFTER_DRAIN) { E(acc, cur, wr, wc, fr, fq); S.done(cur); }
        if (!has_next) break;
#pragma unroll
        for (int a = 0; a < 2; ++a)
#pragma unroll
            for (int b = 0; b < 2; ++b)
#pragma unroll
                for (int m = 0; m < 4; ++m)
#pragma unroll
                    for (int n = 0; n < 2; ++n) acc[a][b][m][n] = (f32x4){0.f, 0.f, 0.f, 0.f};
        cur = nxt; cA = nA; cB = nB; ++ui;
        if constexpr (ALIGN_EPI) { if (wr == 1) PG8_BAR; }
    }
    PG8_WAIT_V(0);
    if constexpr (!ALIGN_EPI) { if (wr == 0) PG8_BAR; }
    PG8_BAR;
    if constexpr (Epi::AFTER_DRAIN) { E.fused(acc, cur, wr, wc, fr, fq, lds, wid, lane); S.done(cur); }
#undef PG8_SA
#undef PG8_SB
#undef PG8_STAGE
#undef PG8_LDA
#undef PG8_LDB
#undef PG8_MMA
#undef PG8_WAIT_V
#undef PG8_WAIT_L
#undef PG8_BAR
#undef PG8_SCHED
}
}
#ifndef MK_N_LAUNCHES
#define MK_N_LAUNCHES 1
#endif
constexpr int NWAVES = 8;
constexpr int M_ROWS = 40960, NP_ROWS = 32768, D = 2048, FF = 8192, INW = 8704, QKVW = 4608, GW_ = 4096, HD = 128;
constexpr float EPS = 1e-6f;
constexpr size_t MiB = 1u << 20;
constexpr size_t WS_TAB = 0;
constexpr size_t WS_BAR = 128 * 1024;
constexpr size_t WS_RSTD2 = 1 * MiB;
constexpr size_t WS_SS2 = 2 * MiB;
constexpr size_t WS_SS = 8 * MiB;
constexpr size_t WS_WIN = 32 * MiB;
constexpr size_t WS_WBR = 66 * MiB;
constexpr size_t WS_WOUT = 74 * MiB;
constexpr size_t WS_WUP = 82 * MiB;
constexpr size_t WS_WDN = 114 * MiB;
constexpr size_t WS_BUFA = 146 * MiB;
constexpr size_t WS_QKV = 306 * MiB;
constexpr size_t WS_GATES = 666 * MiB;
constexpr size_t WS_END = 986 * MiB;
constexpr int LDS_BYTES = 147456;

#define LAS __attribute__((address_space(3)))
typedef unsigned short bf16;
typedef unsigned v4u __attribute__((ext_vector_type(4)));
typedef float f32x4 __attribute__((ext_vector_type(4)));
#define LDS_WAIT() asm volatile("s_waitcnt lgkmcnt(0)" ::: "memory")
__device__ __forceinline__ unsigned f2bf(float f) { unsigned u = __builtin_bit_cast(unsigned, f); return (u + 0x7fffu + ((u >> 16) & 1u)) >> 16; }
__device__ __forceinline__ unsigned pk2(float lo, float hi) { return f2bf(lo) | (f2bf(hi) << 16); }
__device__ __forceinline__ float bflo(unsigned w) { return __uint_as_float(w << 16); }
__device__ __forceinline__ float bfhi(unsigned w) { return __uint_as_float(w & 0xffff0000u); }
__device__ __forceinline__ float wave_sum(float v) {
#pragma unroll
    for (int o = 1; o < 64; o <<= 1) v += __shfl_xor(v, o);
    return v;
}
__device__ __forceinline__ float wave_max(float v) {
#pragma unroll
    for (int o = 1; o < 64; o <<= 1) v = fmaxf(v, __shfl_xor(v, o));
    return v;
}
__device__ __forceinline__ void wave_sync() { __builtin_amdgcn_fence(__ATOMIC_RELEASE, "wavefront"); __builtin_amdgcn_wave_barrier(); __builtin_amdgcn_fence(__ATOMIC_ACQUIRE, "wavefront"); }

__device__ __forceinline__ int t5_bucket_dev(int rel) {
    const int n = rel < 0 ? -rel : rel;
    const int b = n < 8 ? n : 8 + (n >= 12) + (n >= 16) + (n >= 23) + (n >= 32) + (n >= 46) + (n >= 64) + (n >= 91);
    return b + (rel > 0 ? 16 : 0);
}

struct Frame {
    unsigned char* lds; int tid, lane, wave, G, bid;
    const float *xp, *xs, *g1, *w_in, *gqa, *gka, *t5, *sink, *gqb, *gkb, *rpb, *wbra, *wbrb, *wout, *g2, *wup, *wdn;
    float* out; unsigned char* ws;
};
__device__ __forceinline__ const float* xrow_ptr(const Frame& F, int m) { return m < NP_ROWS ? F.xp + (size_t)m * D : F.xs + (size_t)(m - NP_ROWS) * D; }

__device__ __forceinline__ void p0_transpose_item(const float* W, int K, int N, bf16* WT, int ldk, int koff, const float* kscale, float* scr, int item, int lane) {
    const int nblk = N / 32, kb = item / nblk, nb = item % nblk, k0 = 64 * kb, n0 = 32 * nb;
    float wv[32];
#pragma unroll
    for (int i = 0; i < 32; ++i) { const int kk = 2 * i + (lane >> 5); wv[i] = W[(size_t)(k0 + kk) * N + n0 + (lane & 31)]; }
#pragma unroll
    for (int i = 0; i < 32; ++i) { const int kk = 2 * i + (lane >> 5); float w = wv[i]; if (kscale) w *= kscale[k0 + kk]; scr[kk * 33 + (lane & 31)] = w; }
    wave_sync();
    const int c = lane & 7;
#pragma unroll
    for (int j = 0; j < 4; ++j) { const int n = (lane >> 3) + 8 * j; const float* s = scr + (8 * c) * 33 + n;
        v4u o; o.x = pk2(s[0 * 33], s[1 * 33]); o.y = pk2(s[2 * 33], s[3 * 33]); o.z = pk2(s[4 * 33], s[5 * 33]); o.w = pk2(s[6 * 33], s[7 * 33]);
        *(v4u*)(WT + (size_t)(n0 + n) * ldk + koff + k0 + 8 * c) = o; }
    wave_sync();
}
__device__ __forceinline__ void p0_prologue(Frame& F) {
    float* scr = (float*)(F.lds + F.wave * 16384);
    const int gw = F.bid * NWAVES + F.wave, NGW = F.G * NWAVES;
    constexpr int I_IN = (D / 64) * (INW / 32), I_BR = (1024 / 64) * (D / 32), I_OUT = (D / 64) * (D / 32), I_UP = (D / 64) * (FF / 32), I_DN = (FF / 64) * (D / 32);
    constexpr int NITEMS = I_IN + 2 * I_BR + I_OUT + I_UP + I_DN;
    for (int it = gw; it < NITEMS; it += NGW) {
        int r = it;
        if (r < I_IN) { p0_transpose_item(F.w_in, D, INW, (bf16*)(F.ws + WS_WIN), D, 0, nullptr, scr, r, F.lane); continue; } r -= I_IN;
        if (r < I_BR) { p0_transpose_item(F.wbra, 1024, D, (bf16*)(F.ws + WS_WBR), D, 0, nullptr, scr, r, F.lane); continue; } r -= I_BR;
        if (r < I_BR) { p0_transpose_item(F.wbrb, 1024, D, (bf16*)(F.ws + WS_WBR), D, 1024, nullptr, scr, r, F.lane); continue; } r -= I_BR;
        if (r < I_OUT) { p0_transpose_item(F.wout, D, D, (bf16*)(F.ws + WS_WOUT), D, 0, nullptr, scr, r, F.lane); continue; } r -= I_OUT;
        if (r < I_UP) { p0_transpose_item(F.wup, D, FF, (bf16*)(F.ws + WS_WUP), D, 0, F.g2, scr, r, F.lane); continue; } r -= I_UP;
        p0_transpose_item(F.wdn, FF, D, (bf16*)(F.ws + WS_WDN), FF, 0, nullptr, scr, r, F.lane);
    }
    bf16* H = (bf16*)(F.ws + WS_BUFA);
    for (int m = gw; m < M_ROWS; m += NGW) {
        const f32x4* xr = (const f32x4*)xrow_ptr(F, m) + F.lane; f32x4 v[8]; float s = 0.f;
#pragma unroll
        for (int j = 0; j < 8; ++j) { v[j] = xr[64 * j]; s += (v[j].x * v[j].x + v[j].y * v[j].y) + (v[j].z * v[j].z + v[j].w * v[j].w); }
        const float rstd = 1.0f / sqrtf(wave_sum(s) * (1.f / D) + EPS);
        unsigned long long* o8 = (unsigned long long*)(H + (size_t)m * D) + F.lane; const f32x4* gp = (const f32x4*)F.g1 + F.lane;
#pragma unroll
        for (int j = 0; j < 8; ++j) { const f32x4 g = gp[64 * j]; o8[64 * j] = (unsigned long long)pk2(v[j].x * rstd * g.x, v[j].y * rstd * g.y) | ((unsigned long long)pk2(v[j].z * rstd * g.z, v[j].w * rstd * g.w) << 32); }
    }
}

__device__ __forceinline__ float rstd_ss(const float* SS, int row, int hs) { const f32x4 p = *(const f32x4*)(SS + ((size_t)row * 36 + hs) * 4); return 1.0f / sqrtf(((p.x + p.y) + (p.z + p.w)) * (1.f / HD) + EPS); }

namespace att {
#define ALAS __attribute__((address_space(3)))
typedef short bf16x8 __attribute__((ext_vector_type(8)));
typedef short v4i16_t __attribute__((ext_vector_type(4)));
constexpr int TAB_OFF = 131072;
constexpr float LOG2E = 1.4426950408889634f;
__device__ __forceinline__ size_t hm(int hs, int row) { return ((size_t)hs * M_ROWS + (size_t)row) * 128; }
__device__ __forceinline__ unsigned img_off(int row, int chunk) { return (unsigned)(row * 256 + (((chunk ^ row) & 15) << 4)); }
__device__ __forceinline__ v4i16_t vtr(const ALAS unsigned char* p) { return __builtin_amdgcn_ds_read_tr16_b64_v4i16((ALAS v4i16_t*)p); }
__device__ __forceinline__ unsigned tr_off(int row, int dt, int i16) { const int ch = 2 * dt + ((i16 & 3) >> 1); return (unsigned)(row * 256 + (((ch ^ row) & 15) << 4) + (i16 & 1) * 8); }
__device__ __forceinline__ void load_q(bf16x8 (&qf)[4], const bf16* QKV, int qrow, int qhs, const float* gq, const float* gk, int g) {
#pragma unroll
    for (int ks = 0; ks < 4; ++ks) { const int d0 = 32 * ks + 8 * g; const v4u w = *(const v4u*)(QKV + hm(qhs, qrow) + d0);
        const f32x4 a0 = *(const f32x4*)(gq + d0), a1 = *(const f32x4*)(gq + d0 + 4), b0 = *(const f32x4*)(gk + d0), b1 = *(const f32x4*)(gk + d0 + 4); const float c = 0.08838834764831845f;
        v4u o; o.x = pk2(bflo(w.x) * a0.x * b0.x * c, bfhi(w.x) * a0.y * b0.y * c); o.y = pk2(bflo(w.y) * a0.z * b0.z * c, bfhi(w.y) * a0.w * b0.w * c);
        o.z = pk2(bflo(w.z) * a1.x * b1.x * c, bfhi(w.z) * a1.y * b1.y * c); o.w = pk2(bflo(w.w) * a1.z * b1.z * c, bfhi(w.w) * a1.w * b1.w * c);
        qf[ks] = __builtin_bit_cast(bf16x8, o); }
}
__device__ __forceinline__ unsigned cvt2(float lo, float hi) { return pg8::cvt_pk_bf16(lo, hi); }
__device__ __forceinline__ bf16x8 pack_p(const f32x4 a, const f32x4 b) { v4u o; o.x = cvt2(a[0], a[1]); o.y = cvt2(a[2], a[3]); o.z = cvt2(b[0], b[1]); o.w = cvt2(b[2], b[3]); return __builtin_bit_cast(bf16x8, o); }

#define ATT_DMA(src, q) __builtin_amdgcn_global_load_lds((const unsigned*)(src), (ALAS unsigned*)(L + (q) * 1024), 16, 0, 0)
#define ATT_VMWAIT() asm volatile("s_waitcnt vmcnt(0)" ::: "memory")
struct UnitA { int base, n, Ls, h; };
__device__ __forceinline__ UnitA decode_a(int u, bool xmap) { UnitA x;
    if (xmap) { const int bid = u & 255, k = (u >> 8) * 8 + (bid & 7), j = bid >> 3;
        if (k < 64) { x.base = (k >> 3) * 4096; x.n = ((k >> 1) & 3) * 8 + (j >> 2); x.h = (k & 1) * 4 + (j & 3); x.Ls = 4096; }
        else { const int k2 = k - 64; x.base = NP_ROWS + (k2 >> 2) * 2048; x.n = ((k2 >> 1) & 1) * 8 + (j >> 2); x.h = (k2 & 1) * 4 + (j & 3); x.Ls = 2048; }
        return x; }
    x.h = u & 7; const int blk = u >> 3;
    if (blk < 256) { x.base = (blk >> 5) * 4096; x.n = blk & 31; x.Ls = 4096; } else { const int b2 = blk - 256; x.base = NP_ROWS + (b2 >> 4) * 2048; x.n = b2 & 15; x.Ls = 2048; } return x; }
__device__ __forceinline__ void stage_a(ALAS unsigned char* L, const bf16* QKV, const UnitA& x, int off, int w, int lane) {
    const int rl = lane >> 4, p = lane & 15, kpos0 = x.n * 128 - 128;
#pragma unroll
    for (int j = 0; j < 12; ++j) { const int q = w + 8 * j, row = 4 * q + rl; int kp = kpos0 + row; kp = kp < 0 ? 0 : (kp > x.Ls - 1 ? x.Ls - 1 : kp);
        ATT_DMA(QKV + hm(off, x.base + kp) + ((p ^ row) & 15) * 8, q); }
}
__device__ __forceinline__ void attn_a(const Frame& F, ALAS unsigned char* L) {
    ALAS float* rkT = (ALAS float*)(L + TAB_OFF); ALAS float* baT = (ALAS float*)(L + TAB_OFF + 2048);
    const bf16* QKV = (const bf16*)(F.ws + WS_QKV); const float* SS = (const float*)(F.ws + WS_SS); bf16* ATT = (bf16*)(F.ws + WS_BUFA);
    const int tid = F.tid, lane = F.lane, w = F.wave, g = lane >> 4, i16 = lane & 15;
    __syncthreads();
    const bool xmap = (F.G == 256);
    if (F.bid < 2560) { const UnitA x0 = decode_a(F.bid, xmap); stage_a(L, QKV, x0, 8 + (x0.h >> 2), w, lane); }
    for (int u = F.bid; u < 2560; u += F.G) {
        const UnitA x = decode_a(u, xmap); const int h = x.h, base = x.base, n = x.n, Ls = x.Ls;
        const int hk = h >> 2, voff = 10 + hk, qoff = h, kpos0 = n * 128 - 128;
        if (tid < 384) { int kp = kpos0 + tid; kp = kp < 0 ? 0 : (kp > Ls - 1 ? Ls - 1 : kp); rkT[tid] = rstd_ss(SS, base + kp, 8 + hk); }
        if (tid < 288) { const int rel = tid - 16 - 128; baT[tid] = (rel >= -128 && rel <= 128) ? F.t5[t5_bucket_dev(rel) * 8 + h] * LOG2E : 0.f; }
        const int qrow = base + n * 128 + 16 * w + i16; const float rq = rstd_ss(SS, qrow, h) * LOG2E;
        const float* gq_ = F.gqa; const float* gk_ = F.gka; asm volatile("" : "+s"(gq_), "+s"(gk_));
        bf16x8 qf[4]; load_q(qf, QKV, qrow, qoff, gq_, gk_, g);
        ATT_VMWAIT(); __syncthreads();
        f32x4 s[17];
        unsigned kb[4];
#pragma unroll
        for (int ks = 0; ks < 4; ++ks) kb[ks] = img_off(16 * w + i16, 4 * ks + g);
#pragma unroll
        for (int t = 0; t < 17; ++t) { f32x4 acc = {0.f, 0.f, 0.f, 0.f};
#pragma unroll
            for (int ks = 0; ks < 4; ++ks) { const bf16x8 kf = *(const ALAS bf16x8*)(L + kb[ks] + t * 4096); acc = __builtin_amdgcn_mfma_f32_16x16x32_bf16(kf, qf[ks], acc, 0, 0, 0); }
            s[t] = acc; }
        __syncthreads();
        stage_a(L, QKV, x, voff, w, lane);
        int bb = 4 * g - i16 + 16; asm volatile("" : "+v"(bb));
        const int nbk = Ls >> 7; float l = 0.f;
#pragma unroll
        for (int t = 0; t < 17; ++t) { const int blk3 = (w + t) >> 3; const bool tile_ok = blk3 == 0 ? (n > 0) : (blk3 == 2 ? (n < nbk - 1) : true);
            if (!tile_ok) { s[t] = (f32x4){0.f, 0.f, 0.f, 0.f}; }
            else { const f32x4 rk4 = *(const ALAS f32x4*)(rkT + 16 * (w + t) + 4 * g) * rq;
#pragma unroll
                for (int r = 0; r < 4; ++r) { const int idx = 16 * t + r + bb; float p = __builtin_amdgcn_exp2f(s[t][r] * rk4[r] + baT[idx]);
                    if (t == 0 || t == 16) p = (unsigned)(idx - 16) <= 256u ? p : 0.f;
                    s[t][r] = p; l += p; } } }
        l += __shfl_xor(l, 16); l += __shfl_xor(l, 32); l += __builtin_amdgcn_exp2f(F.sink[h] * LOG2E);
        bf16x8 pk[9];
#pragma unroll
        for (int kk = 0; kk < 8; ++kk) pk[kk] = pack_p(s[2 * kk], s[2 * kk + 1]);
        pk[8] = pack_p(s[16], (f32x4){0.f, 0.f, 0.f, 0.f});
        ATT_VMWAIT(); __syncthreads();
        f32x4 o[8];
#pragma unroll
        for (int dt = 0; dt < 8; ++dt) o[dt] = (f32x4){0.f, 0.f, 0.f, 0.f};
        unsigned tb[8];
#pragma unroll
        for (int dt = 0; dt < 8; ++dt) tb[dt] = tr_off(16 * w + 4 * g + (i16 >> 2), dt, i16);
        const unsigned t17off = (unsigned)((w == 7 ? 16 : 17) * 4096);
#pragma unroll
        for (int kk = 0; kk < 9; ++kk) { const unsigned offb = kk < 8 ? (unsigned)((2 * kk + 1) * 4096) : t17off;
#pragma unroll
            for (int dt = 0; dt < 8; ++dt) { const v4i16_t lo = vtr(L + tb[dt] + 2 * kk * 4096), hi = vtr(L + tb[dt] + offb);
                const bf16x8 vf = {lo[0], lo[1], lo[2], lo[3], hi[0], hi[1], hi[2], hi[3]};
                o[dt] = __builtin_amdgcn_mfma_f32_16x16x32_bf16(vf, pk[kk], o[dt], 0, 0, 0); } }
        __syncthreads();
        if (u + F.G < 2560) { const UnitA xn = decode_a(u + F.G, xmap); stage_a(L, QKV, xn, 8 + (xn.h >> 2), w, lane); }
        const float inv = 1.0f / l; bf16* op = ATT + (size_t)qrow * D + h * 128 + 4 * g;
#pragma unroll
        for (int dt = 0; dt < 8; ++dt) { const unsigned long long v = (unsigned long long)cvt2(o[dt][0] * inv, o[dt][1] * inv) | ((unsigned long long)cvt2(o[dt][2] * inv, o[dt][3] * inv) << 32); *(unsigned long long*)(op + 16 * dt) = v; }
    }
    ATT_VMWAIT();
}

struct UnitB { int base, r0, rows, kr0, h, half; };
__device__ __forceinline__ UnitB decode_b(int u, bool xmap) { UnitB x;
    if (xmap) { const int bid = u & 255, k = (u >> 8) * 8 + (bid & 7), j = bid >> 3;
        if (k < 64) { x.base = (k >> 3) * 4096; x.h = k & 7; x.half = j & 1; x.r0 = (j >> 1) * 4; x.rows = 64; }
        else { const int p = 2 * (k - 64) + (j >> 4), jj = j & 15; x.base = NP_ROWS + (p >> 3) * 2048; x.h = p & 7; x.half = jj & 1; x.r0 = (jj >> 1) * 4; x.rows = 32; } }
    else { x.h = u & 7; x.half = (u >> 3) & 1; const int rg = u >> 4;
    if (rg < 128) { x.base = (rg >> 4) * 4096; x.r0 = (rg & 15) * 4; x.rows = 64; } else { const int r2 = rg - 128; x.base = NP_ROWS + (r2 >> 3) * 2048; x.r0 = (r2 & 7) * 4; x.rows = 32; } }
    int k = x.r0 - 4; x.kr0 = k < 0 ? 0 : (k > x.rows - 11 ? x.rows - 11 : k); return x; }
__device__ __forceinline__ void stage_b(ALAS unsigned char* L, const bf16* QKV, const UnitB& x, int off, int w, int lane) {
    const int rl = lane >> 4, p = lane & 15, col0 = x.half ? 24 : 0;
#pragma unroll
    for (int j = 0; j < 14; ++j) { const int q = w + 8 * j;
        if (q < 110) { const int row = 4 * q + rl, kr = row / 40, kc = row - kr * 40;
            ATT_DMA(QKV + hm(off, x.base + (x.kr0 + kr) * 64 + col0 + kc) + ((p ^ row) & 15) * 8, q); } }
}
__device__ __forceinline__ void attn_b(const Frame& F, ALAS unsigned char* L) {
    ALAS float* rkT = (ALAS float*)(L + TAB_OFF); ALAS float* bT = (ALAS float*)(L + TAB_OFF + 2048);
    const bf16* QKV = (const bf16*)(F.ws + WS_QKV); const float* SS = (const float*)(F.ws + WS_SS); bf16* ATT = (bf16*)(F.ws + WS_BUFA);
    int tid = F.tid, w = F.wave; asm volatile("" : "+v"(tid), "+s"(w));
    const int lane = tid & 63, g = lane >> 4, i16 = lane & 15;
    __syncthreads();
    const bool xmap = (F.G == 256);
    if (F.bid < 2560) { const UnitB x0 = decode_b(F.bid, xmap); stage_b(L, QKV, x0, 20 + x0.h, w, lane); }
    for (int u = F.bid; u < 2560; u += F.G) {
        const UnitB x = decode_b(u, xmap); const int h = x.h, half = x.half, base = x.base, r0 = x.r0, rows = x.rows, kr0 = x.kr0;
        const int col0 = half ? 24 : 0, qoff = 12 + h, voff = 28 + h;
        const int r = r0 + (w >> 1), cb = 2 * half + (w & 1), c = 16 * cb + i16;
        int rs = r - 4; rs = rs < 0 ? 0 : (rs > rows - 8 ? rows - 8 : rs);
        int reg = 16 * cb - 8; reg = reg < 0 ? 0 : (reg > 32 ? 32 : reg); int cs = c - 8; cs = cs < 0 ? 0 : (cs > 48 ? 48 : cs);
        const int q0 = (rs - kr0) * 40 + (reg - col0);
        if (tid < 440) { const int kr = tid / 40, kc = tid - kr * 40; rkT[tid] = rstd_ss(SS, base + (kr0 + kr) * 64 + col0 + kc, 20 + h); }
        for (int i = tid; i < 640; i += 512) bT[i] = (i >= 64 && i < 64 + 465) ? F.rpb[h * 465 + i - 64] * LOG2E : 0.f;
        const int qrow = base + r * 64 + c; const float rq = rstd_ss(SS, qrow, 12 + h) * LOG2E;
        const float* gq_ = F.gqb; const float* gk_ = F.gkb; asm volatile("" : "+s"(gq_), "+s"(gk_));
        bf16x8 qf[4]; load_q(qf, QKV, qrow, qoff, gq_, gk_, g);
        ATT_VMWAIT(); __syncthreads();
        f32x4 s[16];
        unsigned kb[4];
#pragma unroll
        for (int ks = 0; ks < 4; ++ks) kb[ks] = img_off(q0 + i16, 4 * ks + g);
#pragma unroll
        for (int t = 0; t < 16; ++t) { f32x4 acc = {0.f, 0.f, 0.f, 0.f};
#pragma unroll
            for (int ks = 0; ks < 4; ++ks) { const bf16x8 kf = *(const ALAS bf16x8*)(L + (kb[ks] ^ (unsigned)(((t >> 1) & 1) << 7)) + (40 * (t >> 1) + 16 * (t & 1)) * 256); acc = __builtin_amdgcn_mfma_f32_16x16x32_bf16(kf, qf[ks], acc, 0, 0, 0); }
            s[t] = acc; }
        __syncthreads();
        stage_b(L, QKV, x, voff, w, lane);
        float l = 0.f;
#pragma unroll
        for (int t = 0; t < 16; ++t) { const int i = t >> 1, R0 = q0 + 40 * i + 16 * (t & 1) + 4 * g; const f32x4 rk4 = *(const ALAS f32x4*)(rkT + R0) * rq; const int kc0 = reg + 16 * (t & 1) + 4 * g, brow = (rs + i - r + 7) * 31 + 15 - c + 64;
#pragma unroll
            for (int rr = 0; rr < 4; ++rr) { const int kc = kc0 + rr; float p = __builtin_amdgcn_exp2f(s[t][rr] * rk4[rr] + bT[brow + kc]);
                p = (kc >= cs && kc < cs + 16) ? p : 0.f; s[t][rr] = p; l += p; } }
        l += __shfl_xor(l, 16); l += __shfl_xor(l, 32);
        bf16x8 pk[8];
#pragma unroll
        for (int kk = 0; kk < 8; ++kk) pk[kk] = pack_p(s[2 * kk], s[2 * kk + 1]);
        ATT_VMWAIT(); __syncthreads();
        f32x4 o[8];
#pragma unroll
        for (int d = 0; d < 8; ++d) o[d] = (f32x4){0.f, 0.f, 0.f, 0.f};
        unsigned tb[8];
#pragma unroll
        for (int d = 0; d < 8; ++d) tb[d] = tr_off(q0 + 4 * g + (i16 >> 2), d, i16);
#pragma unroll
        for (int kk = 0; kk < 8; ++kk) {
#pragma unroll
            for (int d = 0; d < 8; ++d) { const unsigned a = (tb[d] ^ (unsigned)((kk & 1) << 7)) + kk * 40 * 256; const v4i16_t lo = vtr(L + a), hi = vtr(L + a + 4096);
                const bf16x8 vf = {lo[0], lo[1], lo[2], lo[3], hi[0], hi[1], hi[2], hi[3]};
                o[d] = __builtin_amdgcn_mfma_f32_16x16x32_bf16(vf, pk[kk], o[d], 0, 0, 0); } }
        __syncthreads();
        if (u + F.G < 2560) { const UnitB xn = decode_b(u + F.G, xmap); stage_b(L, QKV, xn, 20 + xn.h, w, lane); }
        const float inv = 1.0f / l; bf16* op = ATT + (size_t)qrow * D + 1024 + h * 128 + 4 * g;
#pragma unroll
        for (int d = 0; d < 8; ++d) { const unsigned long long v = (unsigned long long)cvt2(o[d][0] * inv, o[d][1] * inv) | ((unsigned long long)cvt2(o[d][2] * inv, o[d][3] * inv) << 32); *(unsigned long long*)(op + 16 * d) = v; }
    }
    ATT_VMWAIT();
}
}

#define XB_TMO      128
#define XB_XCNT(j)  (256  + 64 * (j))
#define XB_XSUB(j)  (1280 + 64 * (j))
#define XB_XGEN(j)  (2304 + 64 * (j))
#define XB_TOP      3328
#define XB_TOPGEN   3392
#define XCD_BAR_WORDS 3456
#define XB_SPIN_CAP (1u << 18)

__device__ __forceinline__ unsigned xb_ld(unsigned* p)              { return __hip_atomic_load(p, __ATOMIC_RELAXED, __HIP_MEMORY_SCOPE_AGENT); }
__device__ __forceinline__ unsigned xb_add(unsigned* p, unsigned v) { return __hip_atomic_fetch_add(p, v, __ATOMIC_RELAXED, __HIP_MEMORY_SCOPE_AGENT); }
__device__ __forceinline__ unsigned xb_xcc_id() { return (unsigned)__builtin_amdgcn_s_getreg((3 << 11) | 20) & 0xFu; }
#define XB_SPIN(cond, bar) do { unsigned _sp = 0; while (cond) { __builtin_amdgcn_s_sleep(1); \
    if ((++_sp & 255u) == 0u) { if (xb_ld(&(bar)[XB_TMO])) break; if (_sp > XB_SPIN_CAP) { atomicAdd(&(bar)[XB_TMO], 1u); break; } } } } while (0)

struct XcdBarrier {
    unsigned* bar; unsigned x;
    volatile LAS unsigned* st;
};

__device__ __forceinline__ XcdBarrier xcd_barrier_post(unsigned* bar, volatile LAS unsigned* st) {
    XcdBarrier b; b.bar = bar; b.x = xb_xcc_id(); b.st = st;
    if (threadIdx.x == 0) (void)xb_add(&bar[XB_XCNT(b.x)], 1u);
    return b;
}
__device__ __forceinline__ void xcd_barrier_complete(unsigned* bar, unsigned x, unsigned& nloc, unsigned& nx) {
    const unsigned G = gridDim.x * gridDim.y * gridDim.z;
    unsigned sum, cnt, mine, sp = 0u;
    for (;;) {
        sum = 0u; cnt = 0u; mine = 0u;
#pragma unroll
        for (unsigned j = 0; j < 16; ++j) { const unsigned c = xb_ld(&bar[XB_XCNT(j)]); sum += c; cnt += (c > 0u) ? 1u : 0u; mine = (j == x) ? c : mine; }
        if (sum == G) break;
        __builtin_amdgcn_s_sleep(1);
        if ((++sp & 255u) == 0u) { if (xb_ld(&bar[XB_TMO])) break; if (sp > XB_SPIN_CAP) { atomicAdd(&bar[XB_TMO], 1u); break; } }
    }
    nloc = mine > 0u ? mine : 1u; nx = cnt > 0u ? cnt : 1u;
}

__device__ __forceinline__ void xcd_barrier(const XcdBarrier& b) {
    asm volatile("s_waitcnt vmcnt(0)" ::: "memory");
    __syncthreads();
    if (threadIdx.x == 0) {
        unsigned* bar = b.bar;
        __builtin_amdgcn_s_waitcnt(0);
        unsigned nloc = b.st[0], nx = b.st[1];
        if (nloc == 0u) { xcd_barrier_complete(bar, b.x, nloc, nx); b.st[0] = nloc; b.st[1] = nx; }
        const unsigned old = xb_add(&bar[XB_XSUB(b.x)], 1u);
        const unsigned gen = old / nloc;
        if (old + 1u == (gen + 1u) * nloc) {
            __builtin_amdgcn_fence(__ATOMIC_RELEASE, "agent");
            asm volatile("s_waitcnt vmcnt(0)" ::: "memory");
            const unsigned og = xb_add(&bar[XB_TOP], 1u);
            const unsigned tg = og / nx;
            if (og + 1u == (tg + 1u) * nx) xb_add(&bar[XB_TOPGEN], 1u);
            else XB_SPIN(xb_ld(&bar[XB_TOPGEN]) == tg, bar);
            __builtin_amdgcn_fence(__ATOMIC_ACQUIRE, "agent");
            xb_add(&bar[XB_XGEN(b.x)], 1u);
            asm volatile("s_waitcnt vmcnt(0)" ::: "memory");
        } else {
            XB_SPIN(xb_ld(&bar[XB_XGEN(b.x)]) == gen, bar);
            __builtin_amdgcn_fence(__ATOMIC_ACQUIRE, "agent");
            asm volatile("s_waitcnt vmcnt(0)" ::: "memory");
        }
    }
    __syncthreads();
}

struct Args { const float* in[17]; float* out; unsigned char* ws; int ph_lo, ph_hi; };
constexpr int N_PHASES = 8;
__global__ void __launch_bounds__(NWAVES * 64, 2) fwd_megakernel(Args args) {
    extern __shared__ __attribute__((aligned(16))) unsigned char lds[];
    cg::grid_group grid = cg::this_grid();
    Frame F;
    F.lds = lds; F.tid = threadIdx.x; F.lane = F.tid & 63; F.wave = __builtin_amdgcn_readfirstlane(F.tid >> 6); F.G = gridDim.x; F.bid = blockIdx.x;
    F.xp = args.in[0]; F.xs = args.in[1]; F.g1 = args.in[2]; F.w_in = args.in[3]; F.gqa = args.in[4]; F.gka = args.in[5]; F.t5 = args.in[6]; F.sink = args.in[7];
    F.gqb = args.in[8]; F.gkb = args.in[9]; F.rpb = args.in[10]; F.wbra = args.in[11]; F.wbrb = args.in[12]; F.wout = args.in[13]; F.g2 = args.in[14]; F.wup = args.in[15]; F.wdn = args.in[16];
    F.out = args.out; F.ws = args.ws;
    unsigned char* ws = args.ws;
    PG8_LAS unsigned char* ldsl = (PG8_LAS unsigned char*)lds;
    const int lo = args.ph_lo, hi = args.ph_hi;
#ifndef PHASE_MASK
#define PHASE_MASK 0xff
#endif
#define IN(k) (((PHASE_MASK >> (k)) & 1) && lo <= (k) && (k) < hi)
#define STAMP() do {} while (0)
#define SEAM(k) do { if (IN(k) && IN((k) + 1)) { if ((k) == 0) grid.sync(); else xcd_barrier(xbar); } STAMP(); } while (0)
    bf16* BUFA = (bf16*)(ws + WS_BUFA); bf16* QKV = (bf16*)(ws + WS_QKV); bf16* GATES = (bf16*)(ws + WS_GATES);
    float* SS = (float*)(ws + WS_SS); float* SS2 = (float*)(ws + WS_SS2); float* RSTD2 = (float*)(ws + WS_RSTD2);

    STAMP();
    { volatile LAS unsigned* st_ = (volatile LAS unsigned*)((LAS unsigned char*)lds + 139264 + 256); if (F.tid < 2) st_[F.tid] = 0u; __syncthreads(); }
    XcdBarrier xbar; xbar.bar = (unsigned*)(ws + WS_BAR); xbar.x = 0u; xbar.st = (volatile LAS unsigned*)((LAS unsigned char*)lds + 139264 + 256);
    if (IN(0)) { if (F.bid == 0) for (int i = F.tid; i < XCD_BAR_WORDS; i += NWAVES * 64) ((unsigned*)(ws + WS_BAR))[i] = 0u;
        p0_prologue(F); __syncthreads(); }
    SEAM(0);
    xbar = xcd_barrier_post((unsigned*)(ws + WS_BAR), (volatile LAS unsigned*)((LAS unsigned char*)lds + 139264 + 256));
    if (IN(1)) {
        pg8::Gemm g{BUFA, (const bf16*)(ws + WS_WIN), M_ROWS, INW, D}; pg8::StaticOrder S; S.init(M_ROWS, INW, F.G, F.bid);
        pg8::EpiProj E{QKV, GATES, SS};
        pg8::gemm_phase<pg8::EpiProj, pg8::StaticOrder, true, true>(ldsl, g, S, E);
    }
    SEAM(1);
    if (IN(2)) { att::attn_a(F, (ALAS unsigned char*)lds); att::attn_b(F, (ALAS unsigned char*)lds); __syncthreads(); }
    SEAM(2);
    if (IN(3)) {
        pg8::Gemm g{BUFA, (const bf16*)(ws + WS_WBR), M_ROWS, D, D}; pg8::StaticOrder S; S.init(M_ROWS, D, F.G, F.bid);
        pg8::EpiMerge E{GATES, QKV};
        pg8::gemm_phase<pg8::EpiMerge, pg8::StaticOrder, true, true>(ldsl, g, S, E);
    }
    SEAM(3);
    if (IN(4)) {
        pg8::Gemm g{QKV, (const bf16*)(ws + WS_WOUT), M_ROWS, D, D}; pg8::StaticOrder S; S.init(M_ROWS, D, F.G, F.bid);
        pg8::EpiOut1 E{F.xp, F.xs, F.out, BUFA, SS2};
        pg8::gemm_phase<pg8::EpiOut1, pg8::StaticOrder, true, true>(ldsl, g, S, E);
    }
    SEAM(4);
    if (IN(6)) {
        pg8::Gemm g{BUFA, (const bf16*)(ws + WS_WUP), M_ROWS, FF, D}; pg8::StaticOrder S; S.init(M_ROWS, FF, F.G, F.bid);
        PG8_LAS float* rsT = (PG8_LAS float*)(ldsl + 131072); PG8_LAS int* pmT = (PG8_LAS int*)(ldsl + 131072 + 8 * 256 * 4);
        { if (F.tid < 8) pmT[F.tid] = -1;
          __syncthreads();
          int nslot = 0, last = -1; pg8::Unit uu;
          for (int i = 0; S.next(i, uu); ++i) if (uu.pm != last) { last = uu.pm;
              if (nslot < 8) { if (F.tid < 256) { const f32x4* p = (const f32x4*)(SS2 + (size_t)(uu.pm * 256 + F.tid) * 32); float sq = 0.f;
#pragma unroll
                      for (int j = 0; j < 8; ++j) { const f32x4 v = p[j]; sq += (v.x + v.y) + (v.z + v.w); }
                      rsT[nslot * 256 + F.tid] = 1.0f / sqrtf(sq * (1.f / D) + EPS); }
                  if (F.tid == 0) pmT[nslot] = uu.pm; }
              ++nslot; }
          __syncthreads(); }
        pg8::EpiUp E{rsT, pmT, QKV};
        pg8::gemm_phase<pg8::EpiUp, pg8::StaticOrder, true, true>(ldsl, g, S, E);
    }
    SEAM(6);
    if (IN(7)) {
        pg8::Gemm g{QKV, (const bf16*)(ws + WS_WDN), M_ROWS, D, FF}; pg8::StaticOrder S; S.init(M_ROWS, D, F.G, F.bid);
        pg8::EpiDown E{F.out, BUFA};
        pg8::gemm_phase<pg8::EpiDown, pg8::StaticOrder, true, true>(ldsl, g, S, E);
    }
#undef IN
#undef SEAM
}


extern "C" void kernel_launch(void* const* d_in, const int* in_sizes, int n_in, void* d_out, int out_size, void* d_ws, size_t ws_size, hipStream_t stream) {
    static int grid = 0;
    if (grid == 0) {
        if (n_in != 17 || in_sizes[0] != NP_ROWS * D || in_sizes[1] != (M_ROWS - NP_ROWS) * D || out_size != M_ROWS * D || ws_size < WS_END) {
            fprintf(stderr, "kernel_launch: shape/workspace mismatch (n_in %d, in0 %d, out %d, ws %zu < %zu); nothing launched\n", n_in, n_in > 0 ? in_sizes[0] : -1, out_size, ws_size, (size_t)WS_END); grid = -1; return; }
        int dev = 0, cus = 0, per_cu = 0;
        if (hipGetDevice(&dev) != hipSuccess || hipDeviceGetAttribute(&cus, hipDeviceAttributeMultiprocessorCount, dev) != hipSuccess) { fprintf(stderr, "kernel_launch: device query failed\n"); grid = -1; return; }
        if (hipFuncSetAttribute((const void*)fwd_megakernel, hipFuncAttributeMaxDynamicSharedMemorySize, LDS_BYTES) != hipSuccess) { fprintf(stderr, "kernel_launch: hipFuncSetAttribute failed\n"); grid = -1; return; }
        if (hipOccupancyMaxActiveBlocksPerMultiprocessor(&per_cu, (const void*)fwd_megakernel, NWAVES * 64, LDS_BYTES) != hipSuccess || per_cu < 1) { fprintf(stderr, "kernel_launch: occupancy query says %d blocks per CU\n", per_cu); per_cu = 1; }
        (void)hipGetLastError();
        grid = cus * 1;
    }
    if (grid < 0) return;
    Args a{};
    for (int i = 0; i < 17; ++i) a.in[i] = (const float*)d_in[i];
    a.out = (float*)d_out; a.ws = (unsigned char*)d_ws;
#if MK_N_LAUNCHES == 1
    a.ph_lo = 0; a.ph_hi = N_PHASES;
    void* kargs[] = {&a};
    hipError_t e = hipLaunchCooperativeKernel((const void*)fwd_megakernel, dim3(grid), dim3(NWAVES * 64), kargs, LDS_BYTES, stream);
    if (e != hipSuccess) fprintf(stderr, "kernel_launch: cooperative launch failed: %s (grid %d)\n", hipGetErrorString(e), grid);
#else
    for (int ph = 0; ph < N_PHASES; ++ph) {
        a.ph_lo = ph; a.ph_hi = ph + 1;
        hipLaunchKernelGGL(fwd_megakernel, dim3(grid), dim3(NWAVES * 64), LDS_BYTES, stream, a);
        const hipError_t le = hipPeekAtLastError();
        if (le != hipSuccess) { fprintf(stderr, "kernel_launch: launch %d failed: %s\n", ph, hipGetErrorName(le)); break; }
    }
#endif
}
```

```cpp
#include <hip/hip_runtime.h>
#include <hip/hip_cooperative_groups.h>
#include <cstdio>
#include <cstdint>
namespace cg = cooperative_groups;
#define MK_N_LAUNCHES 1
namespace pg8 {
#define PG8_LAS __attribute__((address_space(3)))
typedef unsigned short bf16_t;
typedef short bf16x8 __attribute__((ext_vector_type(8)));
typedef float f32x4 __attribute__((ext_vector_type(4)));
typedef unsigned u32x4 __attribute__((ext_vector_type(4)));
constexpr int BM = 256, BK = 64, HALF = 128, HTB = HALF * BK * 2  , STAGE_BYTES = 8 * HTB, NXCD = 8, WGM = 4;

__host__ __device__ __forceinline__ int lds_byte(int r, int c) { const int st = (r >> 4) * 2 + (c >> 5), rr = r & 15, cc = c & 31, ob = rr * 64 + cc * 2; return st * 1024 + (ob ^ (((ob >> 9) & 1) << 5)); }
__host__ __device__ __forceinline__ void stage_rc(int b, int& R, int& C) { const int st = b / 1024, sb = b % 1024, swz = sb ^ (((sb >> 9) & 1) << 5); R = (st >> 1) * 16 + swz / 64; C = (st & 1) * 32 + (swz % 64) / 2; }
__host__ __device__ __forceinline__ int perm32(int rho) { const int n = rho >> 4, i = rho & 15; return 8 * (i >> 2) + 4 * n + (i & 3); }

struct Unit { int pm, pn; };
struct Gemm { const bf16_t* A; const bf16_t* Bt; int M, N, K; };

struct StaticOrder {
    int nM, nN, nwg, G, c; bool rev = false;
    __host__ __device__ void init(int M, int N, int G_, int c_) { nM = M / BM; nN = N / BM; nwg = nM * nN; G = G_; c = c_; }
    __host__ __device__ bool next(int i, Unit& u) const {
        const long L = (long)i * G + c; if (L >= nwg) return false;
        int wgid = (int)L; { const int q = nwg / NXCD, r = nwg % NXCD, xcd = wgid % NXCD, off = wgid / NXCD; const int cnt = xcd < r ? q + 1 : q; wgid = (xcd < r ? xcd * (q + 1) : r * (q + 1) + (xcd - r) * q) + (rev ? cnt - 1 - off : off); }
        const int nig = WGM * nN, gid = wgid / nig, fm = gid * WGM, gsz = (nM - fm) < WGM ? (nM - fm) : WGM;
        u.pm = fm + ((wgid % nig) % gsz); u.pn = (wgid % nig) / gsz; return true;
    }
    __device__ __forceinline__ void a_ready(const Unit&) const {}
    __device__ __forceinline__ void done(const Unit&) const {}
};

__device__ __forceinline__ unsigned cvt_pk_bf16(float lo, float hi) { unsigned r; asm volatile("s_nop 0\n\tv_cvt_pk_bf16_f32 %0, %1, %2" : "=v"(r) : "v"(lo), "v"(hi)); return r; }
typedef float f32x2 __attribute__((ext_vector_type(2)));
typedef unsigned u32x2 __attribute__((ext_vector_type(2)));
__device__ __forceinline__ float bf_lo(unsigned w) { return __uint_as_float(w << 16); }
__device__ __forceinline__ float bf_hi(unsigned w) { return __uint_as_float(w & 0xffff0000u); }
__device__ __forceinline__ u32x4 pack8(const f32x4 v0, const f32x4 v1) { u32x4 w; w.x = cvt_pk_bf16(v0[0], v0[1]); w.y = cvt_pk_bf16(v0[2], v0[3]); w.z = cvt_pk_bf16(v1[0], v1[1]); w.w = cvt_pk_bf16(v1[2], v1[3]); return w; }
__device__ __forceinline__ float sigmoidf_(float x) { return __builtin_amdgcn_rcpf(1.0f + __builtin_amdgcn_exp2f(-1.44269504089f * x)); }
constexpr int QKV_LD = 4608, GATE_LD = 4096, DM = 2048, FFD = 8192, NHS = 36, NPROMPT_ROWS = 32768;

struct EpiProj {
    static constexpr bool PERM = true, AFTER_DRAIN = false, MID = false;
    bf16_t* QKV; bf16_t* GATES; float* SS;
    __device__ __forceinline__ void operator()(const f32x4 (&acc)[2][2][4][2], const Unit& u, int wr, int wc, int fr, int fq) const {
        const int row0 = u.pm * BM + wr * 64 + fr;
        asm volatile("s_nop 15\n\ts_nop 15" ::: "memory");
        if (u.pn < 18) {
            const int col0 = u.pn * BM + wc * 32 + 8 * fq;
#pragma unroll
            for (int ai = 0; ai < 2; ++ai)
#pragma unroll
                for (int m = 0; m < 4; ++m) { const int row = row0 + ai * HALF + m * 16; bf16_t* rowp = QKV + ((size_t)(u.pn * 2) * 40960 + (size_t)row) * 128 + wc * 32 + 8 * fq;
#pragma unroll
                    for (int bj = 0; bj < 2; ++bj) { const f32x4 v0 = acc[ai][bj][m][0], v1 = acc[ai][bj][m][1];
                        float s = (v0[0] * v0[0] + v0[1] * v0[1]) + (v0[2] * v0[2] + v0[3] * v0[3]) + (v1[0] * v1[0] + v1[1] * v1[1]) + (v1[2] * v1[2] + v1[3] * v1[3]);
                        s += __shfl_xor(s, 16); s += __shfl_xor(s, 32);
                        if (fq == 0) SS[((size_t)row * NHS + u.pn * 2 + bj) * 4 + wc] = s;
                        *(u32x4*)(rowp + (size_t)bj * 40960 * 128) = pack8(v0, v1); } }
        } else {
            const int col0 = (u.pn - 18) * BM + wc * 32 + 8 * fq;
#pragma unroll
            for (int ai = 0; ai < 2; ++ai)
#pragma unroll
                for (int m = 0; m < 4; ++m) { const int row = row0 + ai * HALF + m * 16; bf16_t* rowp = GATES + (size_t)row * GATE_LD + col0;
#pragma unroll
                    for (int bj = 0; bj < 2; ++bj) { f32x4 v0 = acc[ai][bj][m][0], v1 = acc[ai][bj][m][1];
#pragma unroll
                        for (int j = 0; j < 4; ++j) { v0[j] = sigmoidf_(v0[j]); v1[j] = sigmoidf_(v1[j]); }
                        *(u32x4*)(rowp + bj * HALF) = pack8(v0, v1); } }
        }
    }
};

struct EpiMerge {
    static constexpr bool PERM = true, AFTER_DRAIN = false, MID = true;
    const bf16_t* GATES; bf16_t* OUT;
    __device__ __forceinline__ void mid(f32x4 (&acc)[2][2][4][2], const Unit& u, int wr, int wc, int fr, int fq) const {
        const int row0 = u.pm * BM + wr * 64 + fr, col0 = u.pn * BM + wc * 32 + 8 * fq;
        const bf16_t* gp0 = GATES + (size_t)row0 * GATE_LD + col0;
        asm volatile("" : "+v"(gp0));
#pragma unroll
        for (int ai = 0; ai < 2; ++ai) { u32x4 ga[4][2], gb[4][2];
#pragma unroll
            for (int m = 0; m < 4; ++m)
#pragma unroll
                for (int bj = 0; bj < 2; ++bj) { const bf16_t* gp = gp0 + (size_t)(ai * HALF + m * 16) * GATE_LD + bj * HALF; ga[m][bj] = *(const u32x4*)gp; gb[m][bj] = *(const u32x4*)(gp + DM); }
#pragma unroll
            for (int m = 0; m < 4; ++m)
#pragma unroll
                for (int bj = 0; bj < 2; ++bj) { const u32x4 a = ga[m][bj], b = gb[m][bj]; f32x4& c0 = acc[ai][bj][m][0]; f32x4& c1 = acc[ai][bj][m][1];
                    c0[0] *= bf_lo(a.x) * __builtin_amdgcn_rcpf(bf_lo(b.x)); c0[1] *= bf_hi(a.x) * __builtin_amdgcn_rcpf(bf_hi(b.x));
                    c0[2] *= bf_lo(a.y) * __builtin_amdgcn_rcpf(bf_lo(b.y)); c0[3] *= bf_hi(a.y) * __builtin_amdgcn_rcpf(bf_hi(b.y));
                    c1[0] *= bf_lo(a.z) * __builtin_amdgcn_rcpf(bf_lo(b.z)); c1[1] *= bf_hi(a.z) * __builtin_amdgcn_rcpf(bf_hi(b.z));
                    c1[2] *= bf_lo(a.w) * __builtin_amdgcn_rcpf(bf_lo(b.w)); c1[3] *= bf_hi(a.w) * __builtin_amdgcn_rcpf(bf_hi(b.w)); }
            asm volatile("" ::: "memory"); }
    }
    __device__ __forceinline__ void operator()(const f32x4 (&acc)[2][2][4][2], const Unit& u, int wr, int wc, int fr, int fq) const {
        const int row0 = u.pm * BM + wr * 64 + fr, col0 = u.pn * BM + wc * 32 + 8 * fq;
        u32x4 gb[2][4][2];
#pragma unroll
        for (int ai = 0; ai < 2; ++ai)
#pragma unroll
            for (int m = 0; m < 4; ++m)
#pragma unroll
                for (int bj = 0; bj < 2; ++bj) gb[ai][m][bj] = *(const u32x4*)(GATES + (size_t)(row0 + ai * HALF + m * 16) * GATE_LD + DM + col0 + bj * HALF);
#pragma unroll
        for (int ai = 0; ai < 2; ++ai)
#pragma unroll
            for (int m = 0; m < 4; ++m) { bf16_t* op = OUT + (size_t)(row0 + ai * HALF + m * 16) * DM + col0;
#pragma unroll
                for (int bj = 0; bj < 2; ++bj) { const u32x4 b = gb[ai][m][bj];
                    f32x4 v0 = acc[ai][bj][m][0], v1 = acc[ai][bj][m][1];
                    v0[0] *= bf_lo(b.x); v0[1] *= bf_hi(b.x); v0[2] *= bf_lo(b.y); v0[3] *= bf_hi(b.y);
                    v1[0] *= bf_lo(b.z); v1[1] *= bf_hi(b.z); v1[2] *= bf_lo(b.w); v1[3] *= bf_hi(b.w);
                    *(u32x4*)(op + bj * HALF) = pack8(v0, v1); } }
    }
};

struct EpiOut1 {
    static constexpr bool PERM = true, AFTER_DRAIN = false, MID = false;
    const float* xp; const float* xs; float* OUT; bf16_t* X1B; float* SS2;
    __device__ __forceinline__ void operator()(const f32x4 (&acc)[2][2][4][2], const Unit& u, int wr, int wc, int fr, int fq) const {
        const int row0 = u.pm * BM + wr * 64 + fr, col0 = u.pn * BM + wc * 32 + 8 * fq;
        const float* xb = (u.pm * BM < NPROMPT_ROWS) ? xp : xs - (size_t)NPROMPT_ROWS * DM;
#pragma unroll
        for (int ai = 0; ai < 2; ++ai) { f32x4 xv[4][2][2];
#pragma unroll
            for (int m = 0; m < 4; ++m)
#pragma unroll
                for (int bj = 0; bj < 2; ++bj) { const float* xr = xb + (size_t)(row0 + ai * HALF + m * 16) * DM + col0 + bj * HALF; xv[m][bj][0] = *(const f32x4*)xr; xv[m][bj][1] = *(const f32x4*)(xr + 4); }
#pragma unroll
            for (int m = 0; m < 4; ++m) { const size_t row = (size_t)(row0 + ai * HALF + m * 16); bf16_t* bp = X1B + row * DM + col0;
                float s = 0.f;
#pragma unroll
                for (int bj = 0; bj < 2; ++bj) { const f32x4 v0 = acc[ai][bj][m][0] + xv[m][bj][0], v1 = acc[ai][bj][m][1] + xv[m][bj][1];
                    s += (v0[0] * v0[0] + v0[1] * v0[1]) + (v0[2] * v0[2] + v0[3] * v0[3]) + (v1[0] * v1[0] + v1[1] * v1[1]) + (v1[2] * v1[2] + v1[3] * v1[3]);
                    *(u32x4*)(bp + bj * HALF) = pack8(v0, v1); }
                s += __shfl_xor(s, 16); s += __shfl_xor(s, 32);
                if (fq == 0) SS2[row * 32 + u.pn * 4 + wc] = s; }
            asm volatile("" ::: "memory"); }
    }
};

struct EpiUp {
    static constexpr bool PERM = true, AFTER_DRAIN = false, MID = false;
    const PG8_LAS float* rsT; const PG8_LAS int* pmT; bf16_t* U;
    __device__ __forceinline__ void operator()(const f32x4 (&acc)[2][2][4][2], const Unit& u, int wr, int wc, int fr, int fq) const {
        const int row0 = u.pm * BM + wr * 64 + fr, col0 = u.pn * BM + wc * 32 + 8 * fq;
        int slot = 0;
#pragma unroll
        for (int k = 1; k < 8; ++k) slot = (pmT[k] == u.pm) ? k : slot;
        const PG8_LAS float* rsp = rsT + slot * BM + wr * 64 + fr;
#pragma unroll
        for (int ai = 0; ai < 2; ++ai)
#pragma unroll
            for (int m = 0; m < 4; ++m) { const size_t row = (size_t)(row0 + ai * HALF + m * 16); const float rs = rsp[ai * HALF + m * 16]; bf16_t* op = U + row * FFD + col0;
#pragma unroll
                for (int bj = 0; bj < 2; ++bj) { f32x4 v0 = acc[ai][bj][m][0] * rs, v1 = acc[ai][bj][m][1] * rs;
#pragma unroll
                    for (int j = 0; j < 4; ++j) { const float a = fmaxf(v0[j], 0.f), b = fmaxf(v1[j], 0.f); v0[j] = a * a; v1[j] = b * b; }
                    *(u32x4*)(op + bj * HALF) = pack8(v0, v1); } }
    }
};

struct EpiDown {
    static constexpr bool PERM = true, AFTER_DRAIN = false, MID = false;
    float* OUT; const bf16_t* X1B;
    __device__ __forceinline__ void operator()(const f32x4 (&acc)[2][2][4][2], const Unit& u, int wr, int wc, int fr, int fq) const {
        const int row0 = u.pm * BM + wr * 64 + fr, col0 = u.pn * BM + wc * 32 + 8 * fq;
        u32x4 xw[2][4][2];
#pragma unroll
        for (int ai = 0; ai < 2; ++ai)
#pragma unroll
            for (int m = 0; m < 4; ++m)
#pragma unroll
                for (int bj = 0; bj < 2; ++bj) xw[ai][m][bj] = *(const u32x4*)(X1B + (size_t)(row0 + ai * HALF + m * 16) * DM + col0 + bj * HALF);
#pragma unroll
        for (int ai = 0; ai < 2; ++ai)
#pragma unroll
            for (int m = 0; m < 4; ++m) { float* op = OUT + (size_t)(row0 + ai * HALF + m * 16) * DM + col0;
#pragma unroll
                for (int bj = 0; bj < 2; ++bj) { const u32x4 x = xw[ai][m][bj]; f32x4 v0 = acc[ai][bj][m][0], v1 = acc[ai][bj][m][1];
                    v0[0] += bf_lo(x.x); v0[1] += bf_hi(x.x); v0[2] += bf_lo(x.y); v0[3] += bf_hi(x.y); v1[0] += bf_lo(x.z); v1[1] += bf_hi(x.z); v1[2] += bf_lo(x.w); v1[3] += bf_hi(x.w);
                    *(f32x4*)(op + bj * HALF) = v0; *(f32x4*)(op + bj * HALF + 4) = v1; } }
    }
};

template <class Epi, class Sched, bool ALIGN_EPI = false, bool SP2 = false>
__device__ __forceinline__ void gemm_phase(PG8_LAS unsigned char* lds, const Gemm g, const Sched& S, const Epi& E) {
    const int tid = threadIdx.x, wid = __builtin_amdgcn_readfirstlane(tid >> 6), lane = tid & 63, wr = wid >> 2, wc = wid & 3, fr = lane & 15, fq = lane >> 4;
    const int K = g.K, nt = K / BK;
    unsigned voffA[2], voffB[2];
#pragma unroll
    for (int i = 0; i < 2; ++i) { int R, C; stage_rc(tid * 16 + i * 8192, R, C); const int Rb = Epi::PERM ? ((R & ~31) + perm32(R & 31)) : R;
        voffA[i] = (unsigned)(R * K + C) * 2u; voffB[i] = (unsigned)(Rb * K + C) * 2u; }
    const size_t kstep = (size_t)(BK * 2);
    const size_t hstep = (size_t)HALF * K * 2;
    const size_t tstep = 2 * hstep;
    const unsigned ldsw = (unsigned)wid * 1024u;
    const int aoff = lds_byte(wr * 64 + fr, fq * 8), boff = lds_byte(wc * 32 + fr, fq * 8);
#define PG8_SA(b, h) (((b) * 2 + (h)) * HTB)
#define PG8_SB(b, h) ((4 + (b) * 2 + (h)) * HTB)
#define PG8_STAGE(bufoff, gbase, voff) do { _Pragma("unroll") for (int _i = 0; _i < 2; ++_i) \
        __builtin_amdgcn_global_load_lds((const unsigned*)((const char*)(gbase) + (voff)[_i]), (PG8_LAS unsigned*)(lds + (bufoff) + ldsw + _i * 8192), 16, 0, 0); } while (0)
#define PG8_LDA(dst, b, h) do { _Pragma("unroll") for (int m = 0; m < 4; ++m) _Pragma("unroll") for (int k = 0; k < 2; ++k) dst[m][k] = *(const PG8_LAS bf16x8*)(lds + PG8_SA(b, h) + aoff + m * 2048 + k * 1024); } while (0)
#define PG8_LDB(dst, b, h) do { _Pragma("unroll") for (int n = 0; n < 2; ++n) _Pragma("unroll") for (int k = 0; k < 2; ++k) dst[n][k] = *(const PG8_LAS bf16x8*)(lds + PG8_SB(b, h) + boff + n * 2048 + k * 1024); } while (0)
#define PG8_MMA(ai, bj, At, Bt) do { __builtin_amdgcn_s_setprio(1); _Pragma("unroll") for (int m = 0; m < 4; ++m) _Pragma("unroll") for (int n = 0; n < 2; ++n) _Pragma("unroll") for (int k = 0; k < 2; ++k) \
        acc[ai][bj][m][n] = __builtin_amdgcn_mfma_f32_16x16x32_bf16(Bt[n][k], At[m][k], acc[ai][bj][m][n], 0, 0, 0); __builtin_amdgcn_s_setprio(0); } while (0)
#define PG8_WAIT_V(n) asm volatile("s_waitcnt vmcnt(" #n ")" ::: "memory")
#define PG8_WAIT_L(n) asm volatile("s_waitcnt lgkmcnt(" #n ")" ::: "memory")
#define PG8_BAR __builtin_amdgcn_s_barrier()
#define PG8_SCHED __builtin_amdgcn_sched_barrier(0)
    Unit cur, nxt; int ui = 0;
    if (!S.next(0, cur)) return;
    f32x4 acc[2][2][4][2];
#pragma unroll
    for (int a = 0; a < 2; ++a)
#pragma unroll
        for (int b = 0; b < 2; ++b)
#pragma unroll
            for (int m = 0; m < 4; ++m)
#pragma unroll
                for (int n = 0; n < 2; ++n) acc[a][b][m][n] = (f32x4){0.f, 0.f, 0.f, 0.f};
    bf16x8 At[4][2], B0[2][2], B1[2][2];
    const char* cA = (const char*)g.A + (size_t)cur.pm * tstep; const char* cB = (const char*)g.Bt + (size_t)cur.pn * tstep;
    S.a_ready(cur);
    if constexpr (SP2) {
        PG8_STAGE(PG8_SB(0, 0), cB, voffB); PG8_STAGE(PG8_SB(0, 1), cB + hstep, voffB); PG8_STAGE(PG8_SA(0, 0), cA, voffA); PG8_STAGE(PG8_SA(0, 1), cA + hstep, voffA);
        if (wr == 1) PG8_BAR;
        PG8_WAIT_V(2); PG8_BAR;
        PG8_STAGE(PG8_SB(1, 0), cB + kstep, voffB); PG8_STAGE(PG8_SA(1, 0), cA + kstep, voffA); PG8_STAGE(PG8_SB(1, 1), cB + hstep + kstep, voffB);
        PG8_WAIT_V(6); PG8_BAR;
    } else {
        PG8_STAGE(PG8_SB(0, 0), cB, voffB); PG8_STAGE(PG8_SA(0, 0), cA, voffA); PG8_STAGE(PG8_SB(0, 1), cB + hstep, voffB); PG8_STAGE(PG8_SA(0, 1), cA + hstep, voffA);
        if (wr == 1) PG8_BAR;
        PG8_WAIT_V(4); PG8_BAR;
        PG8_STAGE(PG8_SB(1, 0), cB + kstep, voffB); PG8_STAGE(PG8_SA(1, 0), cA + kstep, voffA); PG8_STAGE(PG8_SB(1, 1), cB + hstep + kstep, voffB);
        PG8_WAIT_V(6); PG8_BAR;
    }
    for (;;) {
        const bool has_next = S.next(ui + 1, nxt);
        const char* nA = has_next ? (const char*)g.A + (size_t)nxt.pm * tstep : cA; const char* nB = has_next ? (const char*)g.Bt + (size_t)nxt.pn * tstep : cB;
        constexpr int NSEG = Epi::MID ? 2 : 1; const int seglen = nt / NSEG;
        for (int seg = 0; seg < NSEG; ++seg) {
        if constexpr (Epi::MID) { if (seg == 1) E.mid(acc, cur, wr, wc, fr, fq); }
        for (int t = seg * seglen; t < (seg + 1) * seglen; t += 2) {
            const bool last = (t == nt - 2);
            const char* a1 = cA + (size_t)(t + 1) * kstep;
            const char* a2 = last ? nA : cA + (size_t)(t + 2) * kstep; const char* b2 = last ? nB : cB + (size_t)(t + 2) * kstep;
            const char* a3 = a2 + kstep; const char* b3 = b2 + kstep;
            if (last && has_next) S.a_ready(nxt);
            if constexpr (SP2) {
            PG8_LDB(B0, 0, 0); PG8_LDB(B1, 0, 1); PG8_SCHED; PG8_LDA(At, 0, 0); PG8_STAGE(PG8_SA(1, 1), a1 + hstep, voffA);
            PG8_WAIT_V(8); PG8_WAIT_L(0); PG8_BAR; PG8_MMA(0, 0, At, B0); PG8_MMA(0, 1, At, B1); PG8_BAR; PG8_SCHED;
            PG8_LDA(At, 0, 1); PG8_STAGE(PG8_SB(0, 0), b2, voffB); PG8_STAGE(PG8_SB(0, 1), b2 + hstep, voffB); PG8_STAGE(PG8_SA(0, 0), a2, voffA);
            PG8_WAIT_V(8); PG8_WAIT_L(0); PG8_BAR; PG8_MMA(1, 0, At, B0); PG8_MMA(1, 1, At, B1); PG8_BAR; PG8_SCHED;
            PG8_LDB(B0, 1, 0); PG8_LDB(B1, 1, 1); PG8_SCHED; PG8_LDA(At, 1, 0); PG8_STAGE(PG8_SA(0, 1), a2 + hstep, voffA);
            PG8_WAIT_V(8); PG8_WAIT_L(0); PG8_BAR; PG8_MMA(0, 0, At, B0); PG8_MMA(0, 1, At, B1); PG8_BAR; PG8_SCHED;
            PG8_LDA(At, 1, 1); PG8_STAGE(PG8_SB(1, 0), b3, voffB); PG8_STAGE(PG8_SB(1, 1), b3 + hstep, voffB); PG8_STAGE(PG8_SA(1, 0), a3, voffA);
            PG8_WAIT_V(8); PG8_WAIT_L(0); PG8_BAR; PG8_MMA(1, 0, At, B0); PG8_MMA(1, 1, At, B1); PG8_BAR; PG8_SCHED;
            } else {
            PG8_LDB(B0, 0, 0); PG8_SCHED; PG8_LDA(At, 0, 0); PG8_STAGE(PG8_SA(1, 1), a1 + hstep, voffA);
            PG8_WAIT_L(8); PG8_BAR; PG8_WAIT_L(0); PG8_MMA(0, 0, At, B0); PG8_BAR; PG8_SCHED;
            PG8_LDB(B1, 0, 1); PG8_STAGE(PG8_SB(0, 0), b2, voffB);
            PG8_BAR; PG8_WAIT_L(0); PG8_MMA(0, 1, At, B1); PG8_BAR;
            PG8_LDA(At, 0, 1); PG8_STAGE(PG8_SA(0, 0), a2, voffA);
            PG8_BAR; PG8_WAIT_L(0); PG8_MMA(1, 0, At, B0); PG8_BAR; PG8_SCHED;
            PG8_STAGE(PG8_SB(0, 1), b2 + hstep, voffB);
            PG8_WAIT_V(6); PG8_BAR; PG8_MMA(1, 1, At, B1); PG8_BAR;
            PG8_LDB(B0, 1, 0); PG8_SCHED; PG8_LDA(At, 1, 0); PG8_STAGE(PG8_SA(0, 1), a2 + hstep, voffA);
            PG8_WAIT_L(8); PG8_BAR; PG8_WAIT_L(0); PG8_MMA(0, 0, At, B0); PG8_BAR; PG8_SCHED;
            PG8_LDB(B1, 1, 1); PG8_STAGE(PG8_SB(1, 0), b3, voffB);
            PG8_BAR; PG8_WAIT_L(0); PG8_MMA(0, 1, At, B1); PG8_BAR;
            PG8_LDA(At, 1, 1); PG8_STAGE(PG8_SA(1, 0), a3, voffA);
            PG8_BAR; PG8_WAIT_L(0); PG8_MMA(1, 0, At, B0); PG8_BAR; PG8_SCHED;
            PG8_STAGE(PG8_SB(1, 1), b3 + hstep, voffB);
            PG8_WAIT_V(6); PG8_BAR; PG8_MMA(1, 1, At, B1); PG8_BAR;
            }
        }
        }
        if constexpr (ALIGN_EPI) { if (wr == 0) PG8_BAR; }
        if constexpr (!Epi::AFTER_DRAIN) { E(acc, cur, wr, wc, fr, fq); S.done(cur); }
        if (!has_next) break;
#pragma unroll
        for (int a = 0; a < 2; ++a)
#pragma unroll
            for (int b = 0; b < 2; ++b)
#pragma unroll
                for (int m = 0; m < 4; ++m)
#pragma unroll
                    for (int n = 0; n < 2; ++n) acc[a][b][m][n] = (f32x4){0.f, 0.f, 0.f, 0.f};
        cur = nxt; cA = nA; cB = nB; ++ui;
        if constexpr (ALIGN_EPI) { if (wr == 1) PG8_BAR; }
    }
    PG8_WAIT_V(0);
    if constexpr (!ALIGN_EPI) { if (wr == 0) PG8_BAR; }
    PG8_BAR;
    if constexpr (Epi::AFTER_DRAIN) { E.fused(acc, cur, wr, wc, fr, fq, lds, wid, lane); S.done(cur); }
#undef PG8_SA
#undef PG8_SB
#undef PG8_STAGE
#undef PG8_LDA
#undef PG8_LDB
#undef PG8_MMA
#undef PG8_WAIT_V
#undef PG8_WAIT_L
#undef PG8_BAR
#undef PG8_SCHED
}
}
#ifndef MK_N_LAUNCHES
#define MK_N_LAUNCHES 1
#endif
constexpr int NWAVES = 8;
constexpr int M_ROWS = 40960, NP_ROWS = 32768, D = 2048, FF = 8192, INW = 8704, QKVW = 4608, GW_ = 4096, HD = 128;
constexpr float EPS = 1e-6f;
constexpr size_t MiB = 1u << 20;
constexpr size_t WS_TAB = 0;
constexpr size_t WS_BAR = 128 * 1024;
constexpr size_t WS_RSTD2 = 1 * MiB;
constexpr size_t WS_SS2 = 2 * MiB;
constexpr size_t WS_SS = 8 * MiB;
constexpr size_t WS_WIN = 32 * MiB;
constexpr size_t WS_WBR = 66 * MiB;
constexpr size_t WS_WOUT = 74 * MiB;
constexpr size_t WS_WUP = 82 * MiB;
constexpr size_t WS_WDN = 114 * MiB;
constexpr size_t WS_BUFA = 146 * MiB;
constexpr size_t WS_QKV = 306 * MiB;
constexpr size_t WS_GATES = 666 * MiB;
constexpr size_t WS_END = 986 * MiB;
constexpr int LDS_BYTES = 147456;

#define LAS __attribute__((address_space(3)))
typedef unsigned short bf16;
typedef unsigned v4u __attribute__((ext_vector_type(4)));
typedef float f32x4 __attribute__((ext_vector_type(4)));
#define LDS_WAIT() asm volatile("s_waitcnt lgkmcnt(0)" ::: "memory")
__device__ __forceinline__ unsigned f2bf(float f) { unsigned u = __builtin_bit_cast(unsigned, f); return (u + 0x7fffu + ((u >> 16) & 1u)) >> 16; }
__device__ __forceinline__ unsigned pk2(float lo, float hi) { return f2bf(lo) | (f2bf(hi) << 16); }
__device__ __forceinline__ float bflo(unsigned w) { return __uint_as_float(w << 16); }
__device__ __forceinline__ float bfhi(unsigned w) { return __uint_as_float(w & 0xffff0000u); }
__device__ __forceinline__ float wave_sum(float v) {
#pragma unroll
    for (int o = 1; o < 64; o <<= 1) v += __shfl_xor(v, o);
    return v;
}
__device__ __forceinline__ float wave_max(float v) {
#pragma unroll
    for (int o = 1; o < 64; o <<= 1) v = fmaxf(v, __shfl_xor(v, o));
    return v;
}
__device__ __forceinline__ void wave_sync() { __builtin_amdgcn_fence(__ATOMIC_RELEASE, "wavefront"); __builtin_amdgcn_wave_barrier(); __builtin_amdgcn_fence(__ATOMIC_ACQUIRE, "wavefront"); }

__device__ __forceinline__ int t5_bucket_dev(int rel) {
    const int n = rel < 0 ? -rel : rel;
    const int b = n < 8 ? n : 8 + (n >= 12) + (n >= 16) + (n >= 23) + (n >= 32) + (n >= 46) + (n >= 64) + (n >= 91);
    return b + (rel > 0 ? 16 : 0);
}

struct Frame {
    unsigned char* lds; int tid, lane, wave, G, bid;
    const float *xp, *xs, *g1, *w_in, *gqa, *gka, *t5, *sink, *gqb, *gkb, *rpb, *wbra, *wbrb, *wout, *g2, *wup, *wdn;
    float* out; unsigned char* ws;
};
__device__ __forceinline__ const float* xrow_ptr(const Frame& F, int m) { return m < NP_ROWS ? F.xp + (size_t)m * D : F.xs + (size_t)(m - NP_ROWS) * D; }

__device__ __forceinline__ void p0_transpose_item(const float* W, int K, int N, bf16* WT, int ldk, int koff, const float* kscale, float* scr, int item, int lane) {
    const int nblk = N / 32, kb = item / nblk, nb = item % nblk, k0 = 64 * kb, n0 = 32 * nb;
    float wv[32];
#pragma unroll
    for (int i = 0; i < 32; ++i) { const int kk = 2 * i + (lane >> 5); wv[i] = W[(size_t)(k0 + kk) * N + n0 + (lane & 31)]; }
#pragma unroll
    for (int i = 0; i < 32; ++i) { const int kk = 2 * i + (lane >> 5); float w = wv[i]; if (kscale) w *= kscale[k0 + kk]; scr[kk * 33 + (lane & 31)] = w; }
    wave_sync();
    const int c = lane & 7;
#pragma unroll
    for (int j = 0; j < 4; ++j) { const int n = (lane >> 3) + 8 * j; const float* s = scr + (8 * c) * 33 + n;
        v4u o; o.x = pk2(s[0 * 33], s[1 * 33]); o.y = pk2(s[2 * 33], s[3 * 33]); o.z = pk2(s[4 * 33], s[5 * 33]); o.w = pk2(s[6 * 33], s[7 * 33]);
        *(v4u*)(WT + (size_t)(n0 + n) * ldk + koff + k0 + 8 * c) = o; }
    wave_sync();
}
__device__ __forceinline__ void p0_prologue(Frame& F) {
    float* scr = (float*)(F.lds + F.wave * 16384);
    const int gw = F.bid * NWAVES + F.wave, NGW = F.G * NWAVES;
    constexpr int I_IN = (D / 64) * (INW / 32), I_BR = (1024 / 64) * (D / 32), I_OUT = (D / 64) * (D / 32), I_UP = (D / 64) * (FF / 32), I_DN = (FF / 64) * (D / 32);
    constexpr int NITEMS = I_IN + 2 * I_BR + I_OUT + I_UP + I_DN;
    for (int it = gw; it < NITEMS; it += NGW) {
        int r = it;
        if (r < I_IN) { p0_transpose_item(F.w_in, D, INW, (bf16*)(F.ws + WS_WIN), D, 0, nullptr, scr, r, F.lane); continue; } r -= I_IN;
        if (r < I_BR) { p0_transpose_item(F.wbra, 1024, D, (bf16*)(F.ws + WS_WBR), D, 0, nullptr, scr, r, F.lane); continue; } r -= I_BR;
        if (r < I_BR) { p0_transpose_item(F.wbrb, 1024, D, (bf16*)(F.ws + WS_WBR), D, 1024, nullptr, scr, r, F.lane); continue; } r -= I_BR;
        if (r < I_OUT) { p0_transpose_item(F.wout, D, D, (bf16*)(F.ws + WS_WOUT), D, 0, nullptr, scr, r, F.lane); continue; } r -= I_OUT;
        if (r < I_UP) { p0_transpose_item(F.wup, D, FF, (bf16*)(F.ws + WS_WUP), D, 0, F.g2, scr, r, F.lane); continue; } r -= I_UP;
        p0_transpose_item(F.wdn, FF, D, (bf16*)(F.ws + WS_WDN), FF, 0, nullptr, scr, r, F.lane);
    }
    bf16* H = (bf16*)(F.ws + WS_BUFA);
    for (int m = gw; m < M_ROWS; m += NGW) {
        const f32x4* xr = (const f32x4*)xrow_ptr(F, m) + F.lane; f32x4 v[8]; float s = 0.f;
#pragma unroll
        for (int j = 0; j < 8; ++j) { v[j] = xr[64 * j]; s += (v[j].x * v[j].x + v[j].y * v[j].y) + (v[j].z * v[j].z + v[j].w * v[j].w); }
        const float rstd = 1.0f / sqrtf(wave_sum(s) * (1.f / D) + EPS);
        unsigned long long* o8 = (unsigned long long*)(H + (size_t)m * D) + F.lane; const f32x4* gp = (const f32x4*)F.g1 + F.lane;
#pragma unroll
        for (int j = 0; j < 8; ++j) { const f32x4 g = gp[64 * j]; o8[64 * j] = (unsigned long long)pk2(v[j].x * rstd * g.x, v[j].y * rstd * g.y) | ((unsigned long long)pk2(v[j].z * rstd * g.z, v[j].w * rstd * g.w) << 32); }
    }
}

__device__ __forceinline__ float rstd_ss(const float* SS, int row, int hs) { const f32x4 p = *(const f32x4*)(SS + ((size_t)row * 36 + hs) * 4); return 1.0f / sqrtf(((p.x + p.y) + (p.z + p.w)) * (1.f / HD) + EPS); }

namespace att {
#define ALAS __attribute__((address_space(3)))
typedef short bf16x8 __attribute__((ext_vector_type(8)));
typedef short v4i16_t __attribute__((ext_vector_type(4)));
constexpr int TAB_OFF = 131072;
constexpr float LOG2E = 1.4426950408889634f;
__device__ __forceinline__ size_t hm(int hs, int row) { return ((size_t)hs * M_ROWS + (size_t)row) * 128; }
__device__ __forceinline__ unsigned img_off(int row, int chunk) { return (unsigned)(row * 256 + (((chunk ^ row) & 15) << 4)); }
__device__ __forceinline__ v4i16_t vtr(const ALAS unsigned char* p) { return __builtin_amdgcn_ds_read_tr16_b64_v4i16((ALAS v4i16_t*)p); }
__device__ __forceinline__ unsigned tr_off(int row, int dt, int i16) { const int ch = 2 * dt + ((i16 & 3) >> 1); return (unsigned)(row * 256 + (((ch ^ row) & 15) << 4) + (i16 & 1) * 8); }
__device__ __forceinline__ void load_q(bf16x8 (&qf)[4], const bf16* QKV, int qrow, int qhs, const float* gq, const float* gk, int g) {
#pragma unroll
    for (int ks = 0; ks < 4; ++ks) { const int d0 = 32 * ks + 8 * g; const v4u w = *(const v4u*)(QKV + hm(qhs, qrow) + d0);
        const f32x4 a0 = *(const f32x4*)(gq + d0), a1 = *(const f32x4*)(gq + d0 + 4), b0 = *(const f32x4*)(gk + d0), b1 = *(const f32x4*)(gk + d0 + 4); const float c = 0.08838834764831845f;
        v4u o; o.x = pk2(bflo(w.x) * a0.x * b0.x * c, bfhi(w.x) * a0.y * b0.y * c); o.y = pk2(bflo(w.y) * a0.z * b0.z * c, bfhi(w.y) * a0.w * b0.w * c);
        o.z = pk2(bflo(w.z) * a1.x * b1.x * c, bfhi(w.z) * a1.y * b1.y * c); o.w = pk2(bflo(w.w) * a1.z * b1.z * c, bfhi(w.w) * a1.w * b1.w * c);
        qf[ks] = __builtin_bit_cast(bf16x8, o); }
}
__device__ __forceinline__ unsigned cvt2(float lo, float hi) { return pg8::cvt_pk_bf16(lo, hi); }
__device__ __forceinline__ bf16x8 pack_p(const f32x4 a, const f32x4 b) { v4u o; o.x = cvt2(a[0], a[1]); o.y = cvt2(a[2], a[3]); o.z = cvt2(b[0], b[1]); o.w = cvt2(b[2], b[3]); return __builtin_bit_cast(bf16x8, o); }

#define ATT_DMA(src, q) __builtin_amdgcn_global_load_lds((const unsigned*)(src), (ALAS unsigned*)(L + (q) * 1024), 16, 0, 0)
#define ATT_VMWAIT() asm volatile("s_waitcnt vmcnt(0)" ::: "memory")
struct UnitA { int base, n, Ls, h; };
__device__ __forceinline__ UnitA decode_a(int u, bool xmap) { UnitA x;
    if (xmap) { const int bid = u & 255, k = (u >> 8) * 8 + (bid & 7), j = bid >> 3;
        if (k < 64) { x.base = (k >> 3) * 4096; x.n = ((k >> 1) & 3) * 8 + (j >> 2); x.h = (k & 1) * 4 + (j & 3); x.Ls = 4096; }
        else { const int k2 = k - 64; x.base = NP_ROWS + (k2 >> 2) * 2048; x.n = ((k2 >> 1) & 1) * 8 + (j >> 2); x.h = (k2 & 1) * 4 + (j & 3); x.Ls = 2048; }
        return x; }
    x.h = u & 7; const int blk = u >> 3;
    if (blk < 256) { x.base = (blk >> 5) * 4096; x.n = blk & 31; x.Ls = 4096; } else { const int b2 = blk - 256; x.base = NP_ROWS + (b2 >> 4) * 2048; x.n = b2 & 15; x.Ls = 2048; } return x; }
__device__ __forceinline__ void stage_a(ALAS unsigned char* L, const bf16* QKV, const UnitA& x, int off, int w, int lane) {
    const int rl = lane >> 4, p = lane & 15, kpos0 = x.n * 128 - 128;
#pragma unroll
    for (int j = 0; j < 12; ++j) { const int q = w + 8 * j, row = 4 * q + rl; int kp = kpos0 + row; kp = kp < 0 ? 0 : (kp > x.Ls - 1 ? x.Ls - 1 : kp);
        ATT_DMA(QKV + hm(off, x.base + kp) + ((p ^ row) & 15) * 8, q); }
}
__device__ __forceinline__ void attn_a(const Frame& F, ALAS unsigned char* L) {
    ALAS float* rkT = (ALAS float*)(L + TAB_OFF); ALAS float* baT = (ALAS float*)(L + TAB_OFF + 2048);
    const bf16* QKV = (const bf16*)(F.ws + WS_QKV); const float* SS = (const float*)(F.ws + WS_SS); bf16* ATT = (bf16*)(F.ws + WS_BUFA);
    const int tid = F.tid, lane = F.lane, w = F.wave, g = lane >> 4, i16 = lane & 15;
    __syncthreads();
    const bool xmap = (F.G == 256);
    if (F.bid < 2560) { const UnitA x0 = decode_a(F.bid, xmap); stage_a(L, QKV, x0, 8 + (x0.h >> 2), w, lane); }
    for (int u = F.bid; u < 2560; u += F.G) {
        const UnitA x = decode_a(u, xmap); const int h = x.h, base = x.base, n = x.n, Ls = x.Ls;
        const int hk = h >> 2, voff = 10 + hk, qoff = h, kpos0 = n * 128 - 128;
        if (tid < 384) { int kp = kpos0 + tid; kp = kp < 0 ? 0 : (kp > Ls - 1 ? Ls - 1 : kp); rkT[tid] = rstd_ss(SS, base + kp, 8 + hk); }
        if (tid < 288) { const int rel = tid - 16 - 128; baT[tid] = (rel >= -128 && rel <= 128) ? F.t5[t5_bucket_dev(rel) * 8 + h] * LOG2E : 0.f; }
        const int qrow = base + n * 128 + 16 * w + i16; const float rq = rstd_ss(SS, qrow, h) * LOG2E;
        const float* gq_ = F.gqa; const float* gk_ = F.gka; asm volatile("" : "+s"(gq_), "+s"(gk_));
        bf16x8 qf[4]; load_q(qf, QKV, qrow, qoff, gq_, gk_, g);
        ATT_VMWAIT(); __syncthreads();
        f32x4 s[17];
        unsigned kb[4];
#pragma unroll
        for (int ks = 0; ks < 4; ++ks) kb[ks] = img_off(16 * w + i16, 4 * ks + g);
#pragma unroll
        for (int t = 0; t < 17; ++t) { f32x4 acc = {0.f, 0.f, 0.f, 0.f};
#pragma unroll
            for (int ks = 0; ks < 4; ++ks) { const bf16x8 kf = *(const ALAS bf16x8*)(L + kb[ks] + t * 4096); acc = __builtin_amdgcn_mfma_f32_16x16x32_bf16(kf, qf[ks], acc, 0, 0, 0); }
            s[t] = acc; }
        __syncthreads();
        stage_a(L, QKV, x, voff, w, lane);
        int bb = 4 * g - i16 + 16; asm volatile("" : "+v"(bb));
        const int nbk = Ls >> 7; float l = 0.f;
#pragma unroll
        for (int t = 0; t < 17; ++t) { const int blk3 = (w + t) >> 3; const bool tile_ok = blk3 == 0 ? (n > 0) : (blk3 == 2 ? (n < nbk - 1) : true);
            if (!tile_ok) { s[t] = (f32x4){0.f, 0.f, 0.f, 0.f}; }
            else { const f32x4 rk4 = *(const ALAS f32x4*)(rkT + 16 * (w + t) + 4 * g) * rq;
#pragma unroll
                for (int r = 0; r < 4; ++r) { const int idx = 16 * t + r + bb; float p = __builtin_amdgcn_exp2f(s[t][r] * rk4[r] + baT[idx]);
                    if (t == 0 || t == 16) p = (unsigned)(idx - 16) <= 256u ? p : 0.f;
                    s[t][r] = p; l += p; } } }
        l += __shfl_xor(l, 16); l += __shfl_xor(l, 32); l += __builtin_amdgcn_exp2f(F.sink[h] * LOG2E);
        bf16x8 pk[9];
#pragma unroll
        for (int kk = 0; kk < 8; ++kk) pk[kk] = pack_p(s[2 * kk], s[2 * kk + 1]);
        pk[8] = pack_p(s[16], (f32x4){0.f, 0.f, 0.f, 0.f});
        ATT_VMWAIT(); __syncthreads();
        f32x4 o[8];
#pragma unroll
        for (int dt = 0; dt < 8; ++dt) o[dt] = (f32x4){0.f, 0.f, 0.f, 0.f};
        unsigned tb[8];
#pragma unroll
        for (int dt = 0; dt < 8; ++dt) tb[dt] = tr_off(16 * w + 4 * g + (i16 >> 2), dt, i16);
        const unsigned t17off = (unsigned)((w == 7 ? 16 : 17) * 4096);
#pragma unroll
        for (int kk = 0; kk < 9; ++kk) { const unsigned offb = kk < 8 ? (unsigned)((2 * kk + 1) * 4096) : t17off;
#pragma unroll
            for (int dt = 0; dt < 8; ++dt) { const v4i16_t lo = vtr(L + tb[dt] + 2 * kk * 4096), hi = vtr(L + tb[dt] + offb);
                const bf16x8 vf = {lo[0], lo[1], lo[2], lo[3], hi[0], hi[1], hi[2], hi[3]};
                o[dt] = __builtin_amdgcn_mfma_f32_16x16x32_bf16(vf, pk[kk], o[dt], 0, 0, 0); } }
        __syncthreads();
        if (u + F.G < 2560) { const UnitA xn = decode_a(u + F.G, xmap); stage_a(L, QKV, xn, 8 + (xn.h >> 2), w, lane); }
        const float inv = 1.0f / l; bf16* op = ATT + (size_t)qrow * D + h * 128 + 4 * g;
#pragma unroll
        for (int dt = 0; dt < 8; ++dt) { const unsigned long long v = (unsigned long long)cvt2(o[dt][0] * inv, o[dt][1] * inv) | ((unsigned long long)cvt2(o[dt][2] * inv, o[dt][3] * inv) << 32); *(unsigned long long*)(op + 16 * dt) = v; }
    }
    ATT_VMWAIT();
}

struct UnitB { int base, r0, rows, kr0, h, half; };
__device__ __forceinline__ UnitB decode_b(int u, bool xmap) { UnitB x;
    if (xmap) { const int bid = u & 255, k = (u >> 8) * 8 + (bid & 7), j = bid >> 3;
        if (k < 64) { x.base = (k >> 3) * 4096; x.h = k & 7; x.half = j & 1; x.r0 = (j >> 1) * 4; x.rows = 64; }
        else { const int p = 2 * (k - 64) + (j >> 4), jj = j & 15; x.base = NP_ROWS + (p >> 3) * 2048; x.h = p & 7; x.half = jj & 1; x.r0 = (jj >> 1) * 4; x.rows = 32; } }
    else { x.h = u & 7; x.half = (u >> 3) & 1; const int rg = u >> 4;
    if (rg < 128) { x.base = (rg >> 4) * 4096; x.r0 = (rg & 15) * 4; x.rows = 64; } else { const int r2 = rg - 128; x.base = NP_ROWS + (r2 >> 3) * 2048; x.r0 = (r2 & 7) * 4; x.rows = 32; } }
    int k = x.r0 - 4; x.kr0 = k < 0 ? 0 : (k > x.rows - 11 ? x.rows - 11 : k); return x; }
__device__ __forceinline__ void stage_b(ALAS unsigned char* L, const bf16* QKV, const UnitB& x, int off, int w, int lane) {
    const int rl = lane >> 4, p = lane & 15, col0 = x.half ? 24 : 0;
#pragma unroll
    for (int j = 0; j < 14; ++j) { const int q = w + 8 * j;
        if (q < 110) { const int row = 4 * q + rl, kr = row / 40, kc = row - kr * 40;
            ATT_DMA(QKV + hm(off, x.base + (x.kr0 + kr) * 64 + col0 + kc) + ((p ^ row) & 15) * 8, q); } }
}
__device__ __forceinline__ void attn_b(const Frame& F, ALAS unsigned char* L) {
    ALAS float* rkT = (ALAS float*)(L + TAB_OFF); ALAS float* bT = (ALAS float*)(L + TAB_OFF + 2048);
    const bf16* QKV = (const bf16*)(F.ws + WS_QKV); const float* SS = (const float*)(F.ws + WS_SS); bf16* ATT = (bf16*)(F.ws + WS_BUFA);
    int tid = F.tid, w = F.wave; asm volatile("" : "+v"(tid), "+s"(w));
    const int lane = tid & 63, g = lane >> 4, i16 = lane & 15;
    __syncthreads();
    const bool xmap = (F.G == 256);
    if (F.bid < 2560) { const UnitB x0 = decode_b(F.bid, xmap); stage_b(L, QKV, x0, 20 + x0.h, w, lane); }
    for (int u = F.bid; u < 2560; u += F.G) {
        const UnitB x = decode_b(u, xmap); const int h = x.h, half = x.half, base = x.base, r0 = x.r0, rows = x.rows, kr0 = x.kr0;
        const int col0 = half ? 24 : 0, qoff = 12 + h, voff = 28 + h;
        const int r = r0 + (w >> 1), cb = 2 * half + (w & 1), c = 16 * cb + i16;
        int rs = r - 4; rs = rs < 0 ? 0 : (rs > rows - 8 ? rows - 8 : rs);
        int reg = 16 * cb - 8; reg = reg < 0 ? 0 : (reg > 32 ? 32 : reg); int cs = c - 8; cs = cs < 0 ? 0 : (cs > 48 ? 48 : cs);
        const int q0 = (rs - kr0) * 40 + (reg - col0);
        if (tid < 440) { const int kr = tid / 40, kc = tid - kr * 40; rkT[tid] = rstd_ss(SS, base + (kr0 + kr) * 64 + col0 + kc, 20 + h); }
        for (int i = tid; i < 640; i += 512) bT[i] = (i >= 64 && i < 64 + 465) ? F.rpb[h * 465 + i - 64] * LOG2E : 0.f;
        const int qrow = base + r * 64 + c; const float rq = rstd_ss(SS, qrow, 12 + h) * LOG2E;
        const float* gq_ = F.gqb; const float* gk_ = F.gkb; asm volatile("" : "+s"(gq_), "+s"(gk_));
        bf16x8 qf[4]; load_q(qf, QKV, qrow, qoff, gq_, gk_, g);
        ATT_VMWAIT(); __syncthreads();
        f32x4 s[16];
        unsigned kb[4];
#pragma unroll
        for (int ks = 0; ks < 4; ++ks) kb[ks] = img_off(q0 + i16, 4 * ks + g);
#pragma unroll
        for (int t = 0; t < 16; ++t) { f32x4 acc = {0.f, 0.f, 0.f, 0.f};
#pragma unroll
            for (int ks = 0; ks < 4; ++ks) { const bf16x8 kf = *(const ALAS bf16x8*)(L + (kb[ks] ^ (unsigned)(((t >> 1) & 1) << 7)) + (40 * (t >> 1) + 16 * (t & 1)) * 256); acc = __builtin_amdgcn_mfma_f32_16x16x32_bf16(kf, qf[ks], acc, 0, 0, 0); }
            s[t] = acc; }
        __syncthreads();
        stage_b(L, QKV, x, voff, w, lane);
        float l = 0.f;
#pragma unroll
        for (int t = 0; t < 16; ++t) { const int i = t >> 1, R0 = q0 + 40 * i + 16 * (t & 1) + 4 * g; const f32x4 rk4 = *(const ALAS f32x4*)(rkT + R0) * rq; const int kc0 = reg + 16 * (t & 1) + 4 * g, brow = (rs + i - r + 7) * 31 + 15 - c + 64;
#pragma unroll
            for (int rr = 0; rr < 4; ++rr) { const int kc = kc0 + rr; float p = __builtin_amdgcn_exp2f(s[t][rr] * rk4[rr] + bT[brow + kc]);
                p = (kc >= cs && kc < cs + 16) ? p : 0.f; s[t][rr] = p; l += p; } }
        l += __shfl_xor(l, 16); l += __shfl_xor(l, 32);
        bf16x8 pk[8];
#pragma unroll
        for (int kk = 0; kk < 8; ++kk) pk[kk] = pack_p(s[2 * kk], s[2 * kk + 1]);
        ATT_VMWAIT(); __syncthreads();
        f32x4 o[8];
#pragma unroll
        for (int d = 0; d < 8; ++d) o[d] = (f32x4){0.f, 0.f, 0.f, 0.f};
        unsigned tb[8];
#pragma unroll
        for (int d = 0; d < 8; ++d) tb[d] = tr_off(q0 + 4 * g + (i16 >> 2), d, i16);
#pragma unroll
        for (int kk = 0; kk < 8; ++kk) {
#pragma unroll
            for (int d = 0; d < 8; ++d) { const unsigned a = (tb[d] ^ (unsigned)((kk & 1) << 7)) + kk * 40 * 256; const v4i16_t lo = vtr(L + a), hi = vtr(L + a + 4096);
                const bf16x8 vf = {lo[0], lo[1], lo[2], lo[3], hi[0], hi[1], hi[2], hi[3]};
                o[d] = __builtin_amdgcn_mfma_f32_16x16x32_bf16(vf, pk[kk], o[d], 0, 0, 0); } }
        __syncthreads();
        if (u + F.G < 2560) { const UnitB xn = decode_b(u + F.G, xmap); stage_b(L, QKV, xn, 20 + xn.h, w, lane); }
        const float inv = 1.0f / l; bf16* op = ATT + (size_t)qrow * D + 1024 + h * 128 + 4 * g;
#pragma unroll
        for (int d = 0; d < 8; ++d) { const unsigned long long v = (unsigned long long)cvt2(o[d][0] * inv, o[d][1] * inv) | ((unsigned long long)cvt2(o[d][2] * inv, o[d][3] * inv) << 32); *(unsigned long long*)(op + 16 * d) = v; }
    }
    ATT_VMWAIT();
}
}

#define XB_TMO      128
#define XB_XCNT(j)  (256  + 64 * (j))
#define XB_XSUB(j)  (1280 + 64 * (j))
#define XB_XGEN(j)  (2304 + 64 * (j))
#define XB_TOP      3328
#define XB_TOPGEN   3392
#define XCD_BAR_WORDS 3456
#define XB_SPIN_CAP (1u << 18)

__device__ __forceinline__ unsigned xb_ld(unsigned* p)              { return __hip_atomic_load(p, __ATOMIC_RELAXED, __HIP_MEMORY_SCOPE_AGENT); }
__device__ __forceinline__ unsigned xb_add(unsigned* p, unsigned v) { return __hip_atomic_fetch_add(p, v, __ATOMIC_RELAXED, __HIP_MEMORY_SCOPE_AGENT); }
__device__ __forceinline__ unsigned xb_xcc_id() { return (unsigned)__builtin_amdgcn_s_getreg((3 << 11) | 20) & 0xFu; }
#define XB_SPIN(cond, bar) do { unsigned _sp = 0; while (cond) { __builtin_amdgcn_s_sleep(1); \
    if ((++_sp & 255u) == 0u) { if (xb_ld(&(bar)[XB_TMO])) break; if (_sp > XB_SPIN_CAP) { atomicAdd(&(bar)[XB_TMO], 1u); break; } } } } while (0)

struct XcdBarrier {
    unsigned* bar; unsigned x;
    volatile LAS unsigned* st;
};

__device__ __forceinline__ XcdBarrier xcd_barrier_post(unsigned* bar, volatile LAS unsigned* st) {
    XcdBarrier b; b.bar = bar; b.x = xb_xcc_id(); b.st = st;
    if (threadIdx.x == 0) (void)xb_add(&bar[XB_XCNT(b.x)], 1u);
    return b;
}
__device__ __forceinline__ void xcd_barrier_complete(unsigned* bar, unsigned x, unsigned& nloc, unsigned& nx) {
    const unsigned G = gridDim.x * gridDim.y * gridDim.z;
    unsigned sum, cnt, mine, sp = 0u;
    for (;;) {
        sum = 0u; cnt = 0u; mine = 0u;
#pragma unroll
        for (unsigned j = 0; j < 16; ++j) { const unsigned c = xb_ld(&bar[XB_XCNT(j)]); sum += c; cnt += (c > 0u) ? 1u : 0u; mine = (j == x) ? c : mine; }
        if (sum == G) break;
        __builtin_amdgcn_s_sleep(1);
        if ((++sp & 255u) == 0u) { if (xb_ld(&bar[XB_TMO])) break; if (sp > XB_SPIN_CAP) { atomicAdd(&bar[XB_TMO], 1u); break; } }
    }
    nloc = mine > 0u ? mine : 1u; nx = cnt > 0u ? cnt : 1u;
}

__device__ __forceinline__ void xcd_barrier(const XcdBarrier& b) {
    asm volatile("s_waitcnt vmcnt(0)" ::: "memory");
    __syncthreads();
    if (threadIdx.x == 0) {
        unsigned* bar = b.bar;
        __builtin_amdgcn_s_waitcnt(0);
        unsigned nloc = b.st[0], nx = b.st[1];
        if (nloc == 0u) { xcd_barrier_complete(bar, b.x, nloc, nx); b.st[0] = nloc; b.st[1] = nx; }
        const unsigned old = xb_add(&bar[XB_XSUB(b.x)], 1u);
        const unsigned gen = old / nloc;
        if (old + 1u == (gen + 1u) * nloc) {
            __builtin_amdgcn_fence(__ATOMIC_RELEASE, "agent");
            asm volatile("s_waitcnt vmcnt(0)" ::: "memory");
            const unsigned og = xb_add(&bar[XB_TOP], 1u);
            const unsigned tg = og / nx;
            if (og + 1u == (tg + 1u) * nx) xb_add(&bar[XB_TOPGEN], 1u);
            else XB_SPIN(xb_ld(&bar[XB_TOPGEN]) == tg, bar);
            __builtin_amdgcn_fence(__ATOMIC_ACQUIRE, "agent");
            xb_add(&bar[XB_XGEN(b.x)], 1u);
            asm volatile("s_waitcnt vmcnt(0)" ::: "memory");
        } else {
            XB_SPIN(xb_ld(&bar[XB_XGEN(b.x)]) == gen, bar);
            __builtin_amdgcn_fence(__ATOMIC_ACQUIRE, "agent");
            asm volatile("s_waitcnt vmcnt(0)" ::: "memory");
        }
    }
    __syncthreads();
}

struct Args { const float* in[17]; float* out; unsigned char* ws; int ph_lo, ph_hi; };
constexpr int N_PHASES = 8;
__global__ void __launch_bounds__(NWAVES * 64, 2) fwd_megakernel(Args args) {
    extern __shared__ __attribute__((aligned(16))) unsigned char lds[];
    cg::grid_group grid = cg::this_grid();
    Frame F;
    F.lds = lds; F.tid = threadIdx.x; F.lane = F.tid & 63; F.wave = __builtin_amdgcn_readfirstlane(F.tid >> 6); F.G = gridDim.x; F.bid = blockIdx.x;
    F.xp = args.in[0]; F.xs = args.in[1]; F.g1 = args.in[2]; F.w_in = args.in[3]; F.gqa = args.in[4]; F.gka = args.in[5]; F.t5 = args.in[6]; F.sink = args.in[7];
    F.gqb = args.in[8]; F.gkb = args.in[9]; F.rpb = args.in[10]; F.wbra = args.in[11]; F.wbrb = args.in[12]; F.wout = args.in[13]; F.g2 = args.in[14]; F.wup = args.in[15]; F.wdn = args.in[16];
    F.out = args.out; F.ws = args.ws;
    unsigned char* ws = args.ws;
    PG8_LAS unsigned char* ldsl = (PG8_LAS unsigned char*)lds;
    const int lo = args.ph_lo, hi = args.ph_hi;
#ifndef PHASE_MASK
#define PHASE_MASK 0xff
#endif
#define IN(k) (((PHASE_MASK >> (k)) & 1) && lo <= (k) && (k) < hi)
#define STAMP() do {} while (0)
#define SEAM(k) do { if (IN(k) && IN((k) + 1)) { if ((k) == 0) grid.sync(); else xcd_barrier(xbar); } STAMP(); } while (0)
    bf16* BUFA = (bf16*)(ws + WS_BUFA); bf16* QKV = (bf16*)(ws + WS_QKV); bf16* GATES = (bf16*)(ws + WS_GATES);
    float* SS = (float*)(ws + WS_SS); float* SS2 = (float*)(ws + WS_SS2); float* RSTD2 = (float*)(ws + WS_RSTD2);

    STAMP();
    { volatile LAS unsigned* st_ = (volatile LAS unsigned*)((LAS unsigned char*)lds + 139264 + 256); if (F.tid < 2) st_[F.tid] = 0u; __syncthreads(); }
    XcdBarrier xbar; xbar.bar = (unsigned*)(ws + WS_BAR); xbar.x = 0u; xbar.st = (volatile LAS unsigned*)((LAS unsigned char*)lds + 139264 + 256);
    if (IN(0)) { if (F.bid == 0) for (int i = F.tid; i < XCD_BAR_WORDS; i += NWAVES * 64) ((unsigned*)(ws + WS_BAR))[i] = 0u;
        p0_prologue(F); __syncthreads(); }
    SEAM(0);
    xbar = xcd_barrier_post((unsigned*)(ws + WS_BAR), (volatile LAS unsigned*)((LAS unsigned char*)lds + 139264 + 256));
    if (IN(1)) {
        pg8::Gemm g{BUFA, (const bf16*)(ws + WS_WIN), M_ROWS, INW, D}; pg8::StaticOrder S; S.init(M_ROWS, INW, F.G, F.bid);
        pg8::EpiProj E{QKV, GATES, SS};
        pg8::gemm_phase<pg8::EpiProj, pg8::StaticOrder, true, true>(ldsl, g, S, E);
    }
    SEAM(1);
    if (IN(2)) { att::attn_a(F, (ALAS unsigned char*)lds); att::attn_b(F, (ALAS unsigned char*)lds); __syncthreads(); }
    SEAM(2);
    if (IN(3)) {
        pg8::Gemm g{BUFA, (const bf16*)(ws + WS_WBR), M_ROWS, D, D}; pg8::StaticOrder S; S.init(M_ROWS, D, F.G, F.bid);
        pg8::EpiMerge E{GATES, QKV};
        pg8::gemm_phase<pg8::EpiMerge, pg8::StaticOrder, true, true>(ldsl, g, S, E);
    }
    SEAM(3);
    if (IN(4)) {
        pg8::Gemm g{QKV, (const bf16*)(ws + WS_WOUT), M_ROWS, D, D}; pg8::StaticOrder S; S.init(M_ROWS, D, F.G, F.bid);
        pg8::EpiOut1 E{F.xp, F.xs, F.out, BUFA, SS2};
        pg8::gemm_phase<pg8::EpiOut1, pg8::StaticOrder, true, true>(ldsl, g, S, E);
    }
    SEAM(4);
    if (IN(6)) {
        pg8::Gemm g{BUFA, (const bf16*)(ws + WS_WUP), M_ROWS, FF, D}; pg8::StaticOrder S; S.init(M_ROWS, FF, F.G, F.bid);
        PG8_LAS float* rsT = (PG8_LAS float*)(ldsl + 131072); PG8_LAS int* pmT = (PG8_LAS int*)(ldsl + 131072 + 8 * 256 * 4);
        { if (F.tid < 8) pmT[F.tid] = -1;
          __syncthreads();
          int nslot = 0, last = -1; pg8::Unit uu;
          for (int i = 0; S.next(i, uu); ++i) if (uu.pm != last) { last = uu.pm;
              if (nslot < 8) { if (F.tid < 256) { const f32x4* p = (const f32x4*)(SS2 + (size_t)(uu.pm * 256 + F.tid) * 32); float sq = 0.f;
#pragma unroll
                      for (int j = 0; j < 8; ++j) { const f32x4 v = p[j]; sq += (v.x + v.y) + (v.z + v.w); }
                      rsT[nslot * 256 + F.tid] = 1.0f / sqrtf(sq * (1.f / D) + EPS); }
                  if (F.tid == 0) pmT[nslot] = uu.pm; }
              ++nslot; }
          __syncthreads(); }
        pg8::EpiUp E{rsT, pmT, QKV};
        pg8::gemm_phase<pg8::EpiUp, pg8::StaticOrder, true, true>(ldsl, g, S, E);
    }
    SEAM(6);
    if (IN(7)) {
        pg8::Gemm g{QKV, (const bf16*)(ws + WS_WDN), M_ROWS, D, FF}; pg8::StaticOrder S; S.init(M_ROWS, D, F.G, F.bid); S.rev = true;
        pg8::EpiDown E{F.out, BUFA};
        pg8::gemm_phase<pg8::EpiDown, pg8::StaticOrder, true, true>(ldsl, g, S, E);
    }
#undef IN
#undef SEAM
}


extern "C" void kernel_launch(void* const* d_in, const int* in_sizes, int n_in, void* d_out, int out_size, void* d_ws, size_t ws_size, hipStream_t stream) {
    static int grid = 0;
    if (grid == 0) {
        if (n_in != 17 || in_sizes[0] != NP_ROWS * D || in_sizes[1] != (M_ROWS - NP_ROWS) * D || out_size != M_ROWS * D || ws_size < WS_END) {
            fprintf(stderr, "kernel_launch: shape/workspace mismatch (n_in %d, in0 %d, out %d, ws %zu < %zu); nothing launched\n", n_in, n_in > 0 ? in_sizes[0] : -1, out_size, ws_size, (size_t)WS_END); grid = -1; return; }
        int dev = 0, cus = 0, per_cu = 0;
        if (hipGetDevice(&dev) != hipSuccess || hipDeviceGetAttribute(&cus, hipDeviceAttributeMultiprocessorCount, dev) != hipSuccess) { fprintf(stderr, "kernel_launch: device query failed\n"); grid = -1; return; }
        if (hipFuncSetAttribute((const void*)fwd_megakernel, hipFuncAttributeMaxDynamicSharedMemorySize, LDS_BYTES) != hipSuccess) { fprintf(stderr, "kernel_launch: hipFuncSetAttribute failed\n"); grid = -1; return; }
        if (hipOccupancyMaxActiveBlocksPerMultiprocessor(&per_cu, (const void*)fwd_megakernel, NWAVES * 64, LDS_BYTES) != hipSuccess || per_cu < 1) { fprintf(stderr, "kernel_launch: occupancy query says %d blocks per CU\n", per_cu); per_cu = 1; }
        (void)hipGetLastError();
        grid = cus * 1;
    }
    if (grid < 0) return;
    Args a{};
    for (int i = 0; i < 17; ++i) a.in[i] = (const float*)d_in[i];
    a.out = (float*)d_out; a.ws = (unsigned char*)d_ws;
#if MK_N_LAUNCHES == 1
    a.ph_lo = 0; a.ph_hi = N_PHASES;
    void* kargs[] = {&a};
    hipError_t e = hipLaunchCooperativeKernel((const void*)fwd_megakernel, dim3(grid), dim3(NWAVES * 64), kargs, LDS_BYTES, stream);
    if (e != hipSuccess) fprintf(stderr, "kernel_launch: cooperative launch failed: %s (grid %d)\n", hipGetErrorString(e), grid);
#else
    for (int ph = 0; ph < N_PHASES; ++ph) {
        a.ph_lo = ph; a.ph_hi = ph + 1;
        hipLaunchKernelGGL(fwd_megakernel, dim3(grid), dim3(NWAVES * 64), LDS_BYTES, stream, a);
        const hipError_t le = hipPeekAtLastError();
        if (le != hipSuccess) { fprintf(stderr, "kernel_launch: launch %d failed: %s\n", ph, hipGetErrorName(le)); break; }
    }
#endif
}
```

```cpp
#include <hip/hip_runtime.h>
#include <hip/hip_cooperative_groups.h>
#include <cstdio>
#include <cstdint>
namespace cg = cooperative_groups;
#define MK_N_LAUNCHES 1
namespace pg8 {
#define PG8_LAS __attribute__((address_space(3)))
typedef unsigned short bf16_t;
typedef short bf16x8 __attribute__((ext_vector_type(8)));
typedef float f32x4 __attribute__((ext_vector_type(4)));
typedef unsigned u32x4 __attribute__((ext_vector_type(4)));
constexpr int BM = 256, BK = 64, HALF = 128, HTB = HALF * BK * 2  , STAGE_BYTES = 8 * HTB, NXCD = 8, WGM = 4;

__host__ __device__ __forceinline__ int lds_byte(int r, int c) { const int st = (r >> 4) * 2 + (c >> 5), rr = r & 15, cc = c & 31, ob = rr * 64 + cc * 2; return st * 1024 + (ob ^ (((ob >> 9) & 1) << 5)); }
__host__ __device__ __forceinline__ void stage_rc(int b, int& R, int& C) { const int st = b / 1024, sb = b % 1024, swz = sb ^ (((sb >> 9) & 1) << 5); R = (st >> 1) * 16 + swz / 64; C = (st & 1) * 32 + (swz % 64) / 2; }
__host__ __device__ __forceinline__ int perm32(int rho) { const int n = rho >> 4, i = rho & 15; return 8 * (i >> 2) + 4 * n + (i & 3); }

struct Unit { int pm, pn; };
struct Gemm { const bf16_t* A; const bf16_t* Bt; int M, N, K; };

struct StaticOrder {
    int nM, nN, nwg, G, c; bool rev = false;
    __host__ __device__ void init(int M, int N, int G_, int c_) { nM = M / BM; nN = N / BM; nwg = nM * nN; G = G_; c = c_; }
    __host__ __device__ bool next(int i, Unit& u) const {
        const long L = (long)i * G + c; if (L >= nwg) return false;
        int wgid = (int)L; { const int q = nwg / NXCD, r = nwg % NXCD, xcd = wgid % NXCD, off = wgid / NXCD; const int cnt = xcd < r ? q + 1 : q; wgid = (xcd < r ? xcd * (q + 1) : r * (q + 1) + (xcd - r) * q) + (rev ? cnt - 1 - off : off); }
        const int nig = WGM * nN, gid = wgid / nig, fm = gid * WGM, gsz = (nM - fm) < WGM ? (nM - fm) : WGM;
        u.pm = fm + ((wgid % nig) % gsz); u.pn = (wgid % nig) / gsz; return true;
    }
    __device__ __forceinline__ void a_ready(const Unit&) const {}
    __device__ __forceinline__ void done(const Unit&) const {}
};

__device__ __forceinline__ unsigned cvt_pk_bf16(float lo, float hi) { unsigned r; asm volatile("s_nop 0\n\tv_cvt_pk_bf16_f32 %0, %1, %2" : "=v"(r) : "v"(lo), "v"(hi)); return r; }
typedef float f32x2 __attribute__((ext_vector_type(2)));
typedef unsigned u32x2 __attribute__((ext_vector_type(2)));
__device__ __forceinline__ float bf_lo(unsigned w) { return __uint_as_float(w << 16); }
__device__ __forceinline__ float bf_hi(unsigned w) { return __uint_as_float(w & 0xffff0000u); }
__device__ __forceinline__ u32x4 pack8(const f32x4 v0, const f32x4 v1) { u32x4 w; w.x = cvt_pk_bf16(v0[0], v0[1]); w.y = cvt_pk_bf16(v0[2], v0[3]); w.z = cvt_pk_bf16(v1[0], v1[1]); w.w = cvt_pk_bf16(v1[2], v1[3]); return w; }
__device__ __forceinline__ float sigmoidf_(float x) { return __builtin_amdgcn_rcpf(1.0f + __builtin_amdgcn_exp2f(-1.44269504089f * x)); }
constexpr int QKV_LD = 4608, GATE_LD = 4096, DM = 2048, FFD = 8192, NHS = 36, NPROMPT_ROWS = 32768;

struct EpiProj {
    static constexpr bool PERM = true, AFTER_DRAIN = false, MID = false;
    bf16_t* QKV; bf16_t* GATES; float* SS;
    __device__ __forceinline__ void operator()(const f32x4 (&acc)[2][2][4][2], const Unit& u, int wr, int wc, int fr, int fq) const {
        const int row0 = u.pm * BM + wr * 64 + fr;
        asm volatile("s_nop 15\n\ts_nop 15" ::: "memory");
        if (u.pn < 18) {
            const int col0 = u.pn * BM + wc * 32 + 8 * fq;
#pragma unroll
            for (int ai = 0; ai < 2; ++ai)
#pragma unroll
                for (int m = 0; m < 4; ++m) { const int row = row0 + ai * HALF + m * 16; bf16_t* rowp = QKV + ((size_t)(u.pn * 2) * 40960 + (size_t)row) * 128 + wc * 32 + 8 * fq;
#pragma unroll
                    for (int bj = 0; bj < 2; ++bj) { const f32x4 v0 = acc[ai][bj][m][0], v1 = acc[ai][bj][m][1];
                        float s = (v0[0] * v0[0] + v0[1] * v0[1]) + (v0[2] * v0[2] + v0[3] * v0[3]) + (v1[0] * v1[0] + v1[1] * v1[1]) + (v1[2] * v1[2] + v1[3] * v1[3]);
                        s += __shfl_xor(s, 16); s += __shfl_xor(s, 32);
                        if (fq == 0) SS[((size_t)row * NHS + u.pn * 2 + bj) * 4 + wc] = s;
                        *(u32x4*)(rowp + (size_t)bj * 40960 * 128) = pack8(v0, v1); } }
        } else {
            const int col0 = (u.pn - 18) * BM + wc * 32 + 8 * fq;
#pragma unroll
            for (int ai = 0; ai < 2; ++ai)
#pragma unroll
                for (int m = 0; m < 4; ++m) { const int row = row0 + ai * HALF + m * 16; bf16_t* rowp = GATES + (size_t)row * GATE_LD + col0;
#pragma unroll
                    for (int bj = 0; bj < 2; ++bj) { f32x4 v0 = acc[ai][bj][m][0], v1 = acc[ai][bj][m][1];
#pragma unroll
                        for (int j = 0; j < 4; ++j) { v0[j] = sigmoidf_(v0[j]); v1[j] = sigmoidf_(v1[j]); }
                        *(u32x4*)(rowp + bj * HALF) = pack8(v0, v1); } }
        }
    }
};

struct EpiMerge {
    static constexpr bool PERM = true, AFTER_DRAIN = false, MID = true;
    const bf16_t* GATES; bf16_t* OUT;
    __device__ __forceinline__ void mid(f32x4 (&acc)[2][2][4][2], const Unit& u, int wr, int wc, int fr, int fq) const {
        const int row0 = u.pm * BM + wr * 64 + fr, col0 = u.pn * BM + wc * 32 + 8 * fq;
        const bf16_t* gp0 = GATES + (size_t)row0 * GATE_LD + col0;
        asm volatile("" : "+v"(gp0));
#pragma unroll
        for (int ai = 0; ai < 2; ++ai) { u32x4 ga[4][2], gb[4][2];
#pragma unroll
            for (int m = 0; m < 4; ++m)
#pragma unroll
                for (int bj = 0; bj < 2; ++bj) { const bf16_t* gp = gp0 + (size_t)(ai * HALF + m * 16) * GATE_LD + bj * HALF; ga[m][bj] = *(const u32x4*)gp; gb[m][bj] = *(const u32x4*)(gp + DM); }
#pragma unroll
            for (int m = 0; m < 4; ++m)
#pragma unroll
                for (int bj = 0; bj < 2; ++bj) { const u32x4 a = ga[m][bj], b = gb[m][bj]; f32x4& c0 = acc[ai][bj][m][0]; f32x4& c1 = acc[ai][bj][m][1];
                    c0[0] *= bf_lo(a.x) * __builtin_amdgcn_rcpf(bf_lo(b.x)); c0[1] *= bf_hi(a.x) * __builtin_amdgcn_rcpf(bf_hi(b.x));
                    c0[2] *= bf_lo(a.y) * __builtin_amdgcn_rcpf(bf_lo(b.y)); c0[3] *= bf_hi(a.y) * __builtin_amdgcn_rcpf(bf_hi(b.y));
                    c1[0] *= bf_lo(a.z) * __builtin_amdgcn_rcpf(bf_lo(b.z)); c1[1] *= bf_hi(a.z) * __builtin_amdgcn_rcpf(bf_hi(b.z));
                    c1[2] *= bf_lo(a.w) * __builtin_amdgcn_rcpf(bf_lo(b.w)); c1[3] *= bf_hi(a.w) * __builtin_amdgcn_rcpf(bf_hi(b.w)); }
            asm volatile("" ::: "memory"); }
    }
    __device__ __forceinline__ void operator()(const f32x4 (&acc)[2][2][4][2], const Unit& u, int wr, int wc, int fr, int fq) const {
        const int row0 = u.pm * BM + wr * 64 + fr, col0 = u.pn * BM + wc * 32 + 8 * fq;
        u32x4 gb[2][4][2];
#pragma unroll
        for (int ai = 0; ai < 2; ++ai)
#pragma unroll
            for (int m = 0; m < 4; ++m)
#pragma unroll
                for (int bj = 0; bj < 2; ++bj) gb[ai][m][bj] = *(const u32x4*)(GATES + (size_t)(row0 + ai * HALF + m * 16) * GATE_LD + DM + col0 + bj * HALF);
#pragma unroll
        for (int ai = 0; ai < 2; ++ai)
#pragma unroll
            for (int m = 0; m < 4; ++m) { bf16_t* op = OUT + (size_t)(row0 + ai * HALF + m * 16) * DM + col0;
#pragma unroll
                for (int bj = 0; bj < 2; ++bj) { const u32x4 b = gb[ai][m][bj];
                    f32x4 v0 = acc[ai][bj][m][0], v1 = acc[ai][bj][m][1];
                    v0[0] *= bf_lo(b.x); v0[1] *= bf_hi(b.x); v0[2] *= bf_lo(b.y); v0[3] *= bf_hi(b.y);
                    v1[0] *= bf_lo(b.z); v1[1] *= bf_hi(b.z); v1[2] *= bf_lo(b.w); v1[3] *= bf_hi(b.w);
                    *(u32x4*)(op + bj * HALF) = pack8(v0, v1); } }
    }
};

struct EpiOut1 {
    static constexpr bool PERM = true, AFTER_DRAIN = false, MID = false;
    const float* xp; const float* xs; float* OUT; bf16_t* X1B; float* SS2;
    __device__ __forceinline__ void operator()(const f32x4 (&acc)[2][2][4][2], const Unit& u, int wr, int wc, int fr, int fq) const {
        const int row0 = u.pm * BM + wr * 64 + fr, col0 = u.pn * BM + wc * 32 + 8 * fq;
        const float* xb = (u.pm * BM < NPROMPT_ROWS) ? xp : xs - (size_t)NPROMPT_ROWS * DM;
#pragma unroll
        for (int ai = 0; ai < 2; ++ai) { f32x4 xv[4][2][2];
#pragma unroll
            for (int m = 0; m < 4; ++m)
#pragma unroll
                for (int bj = 0; bj < 2; ++bj) { const float* xr = xb + (size_t)(row0 + ai * HALF + m * 16) * DM + col0 + bj * HALF; xv[m][bj][0] = *(const f32x4*)xr; xv[m][bj][1] = *(const f32x4*)(xr + 4); }
#pragma unroll
            for (int m = 0; m < 4; ++m) { const size_t row = (size_t)(row0 + ai * HALF + m * 16); bf16_t* bp = X1B + row * DM + col0;
                float s = 0.f;
#pragma unroll
                for (int bj = 0; bj < 2; ++bj) { const f32x4 v0 = acc[ai][bj][m][0] + xv[m][bj][0], v1 = acc[ai][bj][m][1] + xv[m][bj][1];
                    s += (v0[0] * v0[0] + v0[1] * v0[1]) + (v0[2] * v0[2] + v0[3] * v0[3]) + (v1[0] * v1[0] + v1[1] * v1[1]) + (v1[2] * v1[2] + v1[3] * v1[3]);
                    *(u32x4*)(bp + bj * HALF) = pack8(v0, v1); }
                s += __shfl_xor(s, 16); s += __shfl_xor(s, 32);
                if (fq == 0) SS2[row * 32 + u.pn * 4 + wc] = s; }
            asm volatile("" ::: "memory"); }
    }
};

struct EpiUp {
    static constexpr bool PERM = true, AFTER_DRAIN = false, MID = false;
    const PG8_LAS float* rsT; const PG8_LAS int* pmT; bf16_t* U;
    __device__ __forceinline__ void operator()(const f32x4 (&acc)[2][2][4][2], const Unit& u, int wr, int wc, int fr, int fq) const {
        const int row0 = u.pm * BM + wr * 64 + fr, col0 = u.pn * BM + wc * 32 + 8 * fq;
        int slot = 0;
#pragma unroll
        for (int k = 1; k < 8; ++k) slot = (pmT[k] == u.pm) ? k : slot;
        const PG8_LAS float* rsp = rsT + slot * BM + wr * 64 + fr;
#pragma unroll
        for (int ai = 0; ai < 2; ++ai)
#pragma unroll
            for (int m = 0; m < 4; ++m) { const size_t row = (size_t)(row0 + ai * HALF + m * 16); const float rs = rsp[ai * HALF + m * 16]; bf16_t* op = U + row * FFD + col0;
#pragma unroll
                for (int bj = 0; bj < 2; ++bj) { f32x4 v0 = acc[ai][bj][m][0] * rs, v1 = acc[ai][bj][m][1] * rs;
#pragma unroll
                    for (int j = 0; j < 4; ++j) { const float a = fmaxf(v0[j], 0.f), b = fmaxf(v1[j], 0.f); v0[j] = a * a; v1[j] = b * b; }
                    *(u32x4*)(op + bj * HALF) = pack8(v0, v1); } }
    }
};

struct EpiDown {
    static constexpr bool PERM = true, AFTER_DRAIN = false, MID = false;
    float* OUT; const bf16_t* X1B;
    __device__ __forceinline__ void operator()(const f32x4 (&acc)[2][2][4][2], const Unit& u, int wr, int wc, int fr, int fq) const {
        const int row0 = u.pm * BM + wr * 64 + fr, col0 = u.pn * BM + wc * 32 + 8 * fq;
        u32x4 xw[2][4][2];
#pragma unroll
        for (int ai = 0; ai < 2; ++ai)
#pragma unroll
            for (int m = 0; m < 4; ++m)
#pragma unroll
                for (int bj = 0; bj < 2; ++bj) xw[ai][m][bj] = *(const u32x4*)(X1B + (size_t)(row0 + ai * HALF + m * 16) * DM + col0 + bj * HALF);
#pragma unroll
        for (int ai = 0; ai < 2; ++ai)
#pragma unroll
            for (int m = 0; m < 4; ++m) { float* op = OUT + (size_t)(row0 + ai * HALF + m * 16) * DM + col0;
#pragma unroll
                for (int bj = 0; bj < 2; ++bj) { const u32x4 x = xw[ai][m][bj]; f32x4 v0 = acc[ai][bj][m][0], v1 = acc[ai][bj][m][1];
                    v0[0] += bf_lo(x.x); v0[1] += bf_hi(x.x); v0[2] += bf_lo(x.y); v0[3] += bf_hi(x.y); v1[0] += bf_lo(x.z); v1[1] += bf_hi(x.z); v1[2] += bf_lo(x.w); v1[3] += bf_hi(x.w);
                    *(f32x4*)(op + bj * HALF) = v0; *(f32x4*)(op + bj * HALF + 4) = v1; } }
    }
};

template <class Epi, class Sched, bool ALIGN_EPI = false, bool SP2 = false>
__device__ __forceinline__ void gemm_phase(PG8_LAS unsigned char* lds, const Gemm g, const Sched& S, const Epi& E) {
    const int tid = threadIdx.x, wid = __builtin_amdgcn_readfirstlane(tid >> 6), lane = tid & 63, wr = wid >> 2, wc = wid & 3, fr = lane & 15, fq = lane >> 4;
    const int K = g.K, nt = K / BK;
    unsigned voffA[2], voffB[2];
#pragma unroll
    for (int i = 0; i < 2; ++i) { int R, C; stage_rc(tid * 16 + i * 8192, R, C); const int Rb = Epi::PERM ? ((R & ~31) + perm32(R & 31)) : R;
        voffA[i] = (unsigned)(R * K + C) * 2u; voffB[i] = (unsigned)(Rb * K + C) * 2u; }
    const size_t kstep = (size_t)(BK * 2);
    const size_t hstep = (size_t)HALF * K * 2;
    const size_t tstep = 2 * hstep;
    const unsigned ldsw = (unsigned)wid * 1024u;
    const int aoff = lds_byte(wr * 64 + fr, fq * 8), boff = lds_byte(wc * 32 + fr, fq * 8);
#define PG8_SA(b, h) (((b) * 2 + (h)) * HTB)
#define PG8_SB(b, h) ((4 + (b) * 2 + (h)) * HTB)
#define PG8_STAGE(bufoff, gbase, voff) do { _Pragma("unroll") for (int _i = 0; _i < 2; ++_i) \
        __builtin_amdgcn_global_load_lds((const unsigned*)((const char*)(gbase) + (voff)[_i]), (PG8_LAS unsigned*)(lds + (bufoff) + ldsw + _i * 8192), 16, 0, 0); } while (0)
#define PG8_LDA(dst, b, h) do { _Pragma("unroll") for (int m = 0; m < 4; ++m) _Pragma("unroll") for (int k = 0; k < 2; ++k) dst[m][k] = *(const PG8_LAS bf16x8*)(lds + PG8_SA(b, h) + aoff + m * 2048 + k * 1024); } while (0)
#define PG8_LDB(dst, b, h) do { _Pragma("unroll") for (int n = 0; n < 2; ++n) _Pragma("unroll") for (int k = 0; k < 2; ++k) dst[n][k] = *(const PG8_LAS bf16x8*)(lds + PG8_SB(b, h) + boff + n * 2048 + k * 1024); } while (0)
#define PG8_MMA(ai, bj, At, Bt) do { __builtin_amdgcn_s_setprio(1); _Pragma("unroll") for (int m = 0; m < 4; ++m) _Pragma("unroll") for (int n = 0; n < 2; ++n) _Pragma("unroll") for (int k = 0; k < 2; ++k) \
        acc[ai][bj][m][n] = __builtin_amdgcn_mfma_f32_16x16x32_bf16(Bt[n][k], At[m][k], acc[ai][bj][m][n], 0, 0, 0); __builtin_amdgcn_s_setprio(0); } while (0)
#define PG8_WAIT_V(n) asm volatile("s_waitcnt vmcnt(" #n ")" ::: "memory")
#define PG8_WAIT_L(n) asm volatile("s_waitcnt lgkmcnt(" #n ")" ::: "memory")
#define PG8_BAR __builtin_amdgcn_s_barrier()
#define PG8_SCHED __builtin_amdgcn_sched_barrier(0)
    Unit cur, nxt; int ui = 0;
    if (!S.next(0, cur)) return;
    f32x4 acc[2][2][4][2];
#pragma unroll
    for (int a = 0; a < 2; ++a)
#pragma unroll
        for (int b = 0; b < 2; ++b)
#pragma unroll
            for (int m = 0; m < 4; ++m)
#pragma unroll
                for (int n = 0; n < 2; ++n) acc[a][b][m][n] = (f32x4){0.f, 0.f, 0.f, 0.f};
    bf16x8 At[4][2], B0[2][2], B1[2][2];
    const char* cA = (const char*)g.A + (size_t)cur.pm * tstep; const char* cB = (const char*)g.Bt + (size_t)cur.pn * tstep;
    S.a_ready(cur);
    if constexpr (SP2) {
        PG8_STAGE(PG8_SB(0, 0), cB, voffB); PG8_STAGE(PG8_SB(0, 1), cB + hstep, voffB); PG8_STAGE(PG8_SA(0, 0), cA, voffA); PG8_STAGE(PG8_SA(0, 1), cA + hstep, voffA);
        if (wr == 1) PG8_BAR;
        PG8_WAIT_V(2); PG8_BAR;
        PG8_STAGE(PG8_SB(1, 0), cB + kstep, voffB); PG8_STAGE(PG8_SA(1, 0), cA + kstep, voffA); PG8_STAGE(PG8_SB(1, 1), cB + hstep + kstep, voffB);
        PG8_WAIT_V(6); PG8_BAR;
    } else {
        PG8_STAGE(PG8_SB(0, 0), cB, voffB); PG8_STAGE(PG8_SA(0, 0), cA, voffA); PG8_STAGE(PG8_SB(0, 1), cB + hstep, voffB); PG8_STAGE(PG8_SA(0, 1), cA + hstep, voffA);
        if (wr == 1) PG8_BAR;
        PG8_WAIT_V(4); PG8_BAR;
        PG8_STAGE(PG8_SB(1, 0), cB + kstep, voffB); PG8_STAGE(PG8_SA(1, 0), cA + kstep, voffA); PG8_STAGE(PG8_SB(1, 1), cB + hstep + kstep, voffB);
        PG8_WAIT_V(6); PG8_BAR;
    }
    for (;;) {
        const bool has_next = S.next(ui + 1, nxt);
        const char* nA = has_next ? (const char*)g.A + (size_t)nxt.pm * tstep : cA; const char* nB = has_next ? (const char*)g.Bt + (size_t)nxt.pn * tstep : cB;
        constexpr int NSEG = Epi::MID ? 2 : 1; const int seglen = nt / NSEG;
        for (int seg = 0; seg < NSEG; ++seg) {
        if constexpr (Epi::MID) { if (seg == 1) E.mid(acc, cur, wr, wc, fr, fq); }
        for (int t = seg * seglen; t < (seg + 1) * seglen; t += 2) {
            const bool last = (t == nt - 2);
            const char* a1 = cA + (size_t)(t + 1) * kstep;
            const char* a2 = last ? nA : cA + (size_t)(t + 2) * kstep; const char* b2 = last ? nB : cB + (size_t)(t + 2) * kstep;
            const char* a3 = a2 + kstep; const char* b3 = b2 + kstep;
            if (last && has_next) S.a_ready(nxt);
            if constexpr (SP2) {
            PG8_LDB(B0, 0, 0); PG8_LDB(B1, 0, 1); PG8_SCHED; PG8_LDA(At, 0, 0); PG8_STAGE(PG8_SA(1, 1), a1 + hstep, voffA);
            PG8_WAIT_V(8); PG8_WAIT_L(0); PG8_BAR; PG8_MMA(0, 0, At, B0); PG8_MMA(0, 1, At, B1); PG8_BAR; PG8_SCHED;
            PG8_LDA(At, 0, 1); PG8_STAGE(PG8_SB(0, 0), b2, voffB); PG8_STAGE(PG8_SB(0, 1), b2 + hstep, voffB); PG8_STAGE(PG8_SA(0, 0), a2, voffA);
            PG8_WAIT_V(8); PG8_WAIT_L(0); PG8_BAR; PG8_MMA(1, 0, At, B0); PG8_MMA(1, 1, At, B1); PG8_BAR; PG8_SCHED;
            PG8_LDB(B0, 1, 0); PG8_LDB(B1, 1, 1); PG8_SCHED; PG8_LDA(At, 1, 0); PG8_STAGE(PG8_SA(0, 1), a2 + hstep, voffA);
            PG8_WAIT_V(8); PG8_WAIT_L(0); PG8_BAR; PG8_MMA(0, 0, At, B0); PG8_MMA(0, 1, At, B1); PG8_BAR; PG8_SCHED;
            PG8_LDA(At, 1, 1); PG8_STAGE(PG8_SB(1, 0), b3, voffB); PG8_STAGE(PG8_SB(1, 1), b3 + hstep, voffB); PG8_STAGE(PG8_SA(1, 0), a3, voffA);
            PG8_WAIT_V(8); PG8_WAIT_L(0); PG8_BAR; PG8_MMA(1, 0, At, B0); PG8_MMA(1, 1, At, B1); PG8_BAR; PG8_SCHED;
            } else {
            PG8_LDB(B0, 0, 0); PG8_SCHED; PG8_LDA(At, 0, 0); PG8_STAGE(PG8_SA(1, 1), a1 + hstep, voffA);
            PG8_WAIT_L(8); PG8_BAR; PG8_WAIT_L(0); PG8_MMA(0, 0, At, B0); PG8_BAR; PG8_SCHED;
            PG8_LDB(B1, 0, 1); PG8_STAGE(PG8_SB(0, 0), b2, voffB);
            PG8_BAR; PG8_WAIT_L(0); PG8_MMA(0, 1, At, B1); PG8_BAR;
            PG8_LDA(At, 0, 1); PG8_STAGE(PG8_SA(0, 0), a2, voffA);
            PG8_BAR; PG8_WAIT_L(0); PG8_MMA(1, 0, At, B0); PG8_BAR; PG8_SCHED;
            PG8_STAGE(PG8_SB(0, 1), b2 + hstep, voffB);
            PG8_WAIT_V(6); PG8_BAR; PG8_MMA(1, 1, At, B1); PG8_BAR;
            PG8_LDB(B0, 1, 0); PG8_SCHED; PG8_LDA(At, 1, 0); PG8_STAGE(PG8_SA(0, 1), a2 + hstep, voffA);
            PG8_WAIT_L(8); PG8_BAR; PG8_WAIT_L(0); PG8_MMA(0, 0, At, B0); PG8_BAR; PG8_SCHED;
            PG8_LDB(B1, 1, 1); PG8_STAGE(PG8_SB(1, 0), b3, voffB);
            PG8_BAR; PG8_WAIT_L(0); PG8_MMA(0, 1, At, B1); PG8_BAR;
            PG8_LDA(At, 1, 1); PG8_STAGE(PG8_SA(1, 0), a3, voffA);
            PG8_BAR; PG8_WAIT_L(0); PG8_MMA(1, 0, At, B0); PG8_BAR; PG8_SCHED;
            PG8_STAGE(PG8_SB(1, 1), b3 + hstep, voffB);
            PG8_WAIT_V(6); PG8_BAR; PG8_MMA(1, 1, At, B1); PG8_BAR;
            }
        }
        }
        if constexpr (ALIGN_EPI) { if (wr == 0) PG8_BAR; }
        if constexpr (!Epi::AFTER_DRAIN) { E(acc, cur, wr, wc, fr, fq); S.done(cur); }
        if (!has_next) break;
#pragma unroll
        for (int a = 0; a < 2; ++a)
#pragma unroll
            for (int b = 0; b < 2; ++b)
#pragma unroll
                for (int m = 0; m < 4; ++m)
#pragma unroll
                    for (int n = 0; n < 2; ++n) acc[a][b][m][n] = (f32x4){0.f, 0.f, 0.f, 0.f};
        cur = nxt; cA = nA; cB = nB; ++ui;
        if constexpr (ALIGN_EPI) { if (wr == 1) PG8_BAR; }
    }
    PG8_WAIT_V(0);
    if constexpr (!ALIGN_EPI) { if (wr == 0) PG8_BAR; }
    PG8_BAR;
    if constexpr (Epi::AFTER_DRAIN) { E.fused(acc, cur, wr, wc, fr, fq, lds, wid, lane); S.done(cur); }
#undef PG8_SA
#undef PG8_SB
#undef PG8_STAGE
#undef PG8_LDA
#undef PG8_LDB
#undef PG8_MMA
#undef PG8_WAIT_V
#undef PG8_WAIT_L
#undef PG8_BAR
#undef PG8_SCHED
}
}
#ifndef MK_N_LAUNCHES
#define MK_N_LAUNCHES 1
#endif
constexpr int NWAVES = 8;
constexpr int M_ROWS = 40960, NP_ROWS = 32768, D = 2048, FF = 8192, INW = 8704, QKVW = 4608, GW_ = 4096, HD = 128;
constexpr float EPS = 1e-6f;
constexpr size_t MiB = 1u << 20;
constexpr size_t WS_TAB = 0;
constexpr size_t WS_BAR = 128 * 1024;
constexpr size_t WS_RSTD2 = 1 * MiB;
constexpr size_t WS_SS2 = 2 * MiB;
constexpr size_t WS_SS = 8 * MiB;
constexpr size_t WS_WIN = 32 * MiB;
constexpr size_t WS_WBR = 66 * MiB;
constexpr size_t WS_WOUT = 74 * MiB;
constexpr size_t WS_WUP = 82 * MiB;
constexpr size_t WS_WDN = 114 * MiB;
constexpr size_t WS_BUFA = 146 * MiB;
constexpr size_t WS_QKV = 306 * MiB;
constexpr size_t WS_GATES = 666 * MiB;
constexpr size_t WS_END = 986 * MiB;
constexpr int LDS_BYTES = 147456;

#define LAS __attribute__((address_space(3)))
typedef unsigned short bf16;
typedef unsigned v4u __attribute__((ext_vector_type(4)));
typedef float f32x4 __attribute__((ext_vector_type(4)));
#define LDS_WAIT() asm volatile("s_waitcnt lgkmcnt(0)" ::: "memory")
__device__ __forceinline__ unsigned f2bf(float f) { unsigned u = __builtin_bit_cast(unsigned, f); return (u + 0x7fffu + ((u >> 16) & 1u)) >> 16; }
__device__ __forceinline__ unsigned pk2(float lo, float hi) { return f2bf(lo) | (f2bf(hi) << 16); }
__device__ __forceinline__ float bflo(unsigned w) { return __uint_as_float(w << 16); }
__device__ __forceinline__ float bfhi(unsigned w) { return __uint_as_float(w & 0xffff0000u); }
__device__ __forceinline__ float wave_sum(float v) {
#pragma unroll
    for (int o = 1; o < 64; o <<= 1) v += __shfl_xor(v, o);
    return v;
}
__device__ __forceinline__ float wave_max(float v) {
#pragma unroll
    for (int o = 1; o < 64; o <<= 1) v = fmaxf(v, __shfl_xor(v, o));
    return v;
}
__device__ __forceinline__ void wave_sync() { __builtin_amdgcn_fence(__ATOMIC_RELEASE, "wavefront"); __builtin_amdgcn_wave_barrier(); __builtin_amdgcn_fence(__ATOMIC_ACQUIRE, "wavefront"); }

__device__ __forceinline__ int t5_bucket_dev(int rel) {
    const int n = rel < 0 ? -rel : rel;
    const int b = n < 8 ? n : 8 + (n >= 12) + (n >= 16) + (n >= 23) + (n >= 32) + (n >= 46) + (n >= 64) + (n >= 91);
    return b + (rel > 0 ? 16 : 0);
}

struct Frame {
    unsigned char* lds; int tid, lane, wave, G, bid;
    const float *xp, *xs, *g1, *w_in, *gqa, *gka, *t5, *sink, *gqb, *gkb, *rpb, *wbra, *wbrb, *wout, *g2, *wup, *wdn;
    float* out; unsigned char* ws;
};
__device__ __forceinline__ const float* xrow_ptr(const Frame& F, int m) { return m < NP_ROWS ? F.xp + (size_t)m * D : F.xs + (size_t)(m - NP_ROWS) * D; }

__device__ __forceinline__ void p0_transpose_item(const float* W, int K, int N, bf16* WT, int ldk, int koff, const float* kscale, float* scr, int item, int lane) {
    const int nblk = N / 32, kb = item / nblk, nb = item % nblk, k0 = 64 * kb, n0 = 32 * nb;
    float wv[32];
#pragma unroll
    for (int i = 0; i < 32; ++i) { const int kk = 2 * i + (lane >> 5); wv[i] = W[(size_t)(k0 + kk) * N + n0 + (lane & 31)]; }
#pragma unroll
    for (int i = 0; i < 32; ++i) { const int kk = 2 * i + (lane >> 5); float w = wv[i]; if (kscale) w *= kscale[k0 + kk]; scr[kk * 33 + (lane & 31)] = w; }
    wave_sync();
    const int c = lane & 7;
#pragma unroll
    for (int j = 0; j < 4; ++j) { const int n = (lane >> 3) + 8 * j; const float* s = scr + (8 * c) * 33 + n;
        v4u o; o.x = pk2(s[0 * 33], s[1 * 33]); o.y = pk2(s[2 * 33], s[3 * 33]); o.z = pk2(s[4 * 33], s[5 * 33]); o.w = pk2(s[6 * 33], s[7 * 33]);
        *(v4u*)(WT + (size_t)(n0 + n) * ldk + koff + k0 + 8 * c) = o; }
    wave_sync();
}
__device__ __forceinline__ void p0_weights(Frame& F, int it_lo, int it_hi, int gw, int NGW) {
    float* scr = (float*)(F.lds + F.wave * 16384);
    constexpr int I_IN = (D / 64) * (INW / 32), I_BR = (1024 / 64) * (D / 32), I_OUT = (D / 64) * (D / 32), I_UP = (D / 64) * (FF / 32), I_DN = (FF / 64) * (D / 32);
    for (int it = it_lo + gw; it < it_hi; it += NGW) {
        int r = it;
        if (r < I_IN) { p0_transpose_item(F.w_in, D, INW, (bf16*)(F.ws + WS_WIN), D, 0, nullptr, scr, r, F.lane); continue; } r -= I_IN;
        if (r < I_BR) { p0_transpose_item(F.wbra, 1024, D, (bf16*)(F.ws + WS_WBR), D, 0, nullptr, scr, r, F.lane); continue; } r -= I_BR;
        if (r < I_BR) { p0_transpose_item(F.wbrb, 1024, D, (bf16*)(F.ws + WS_WBR), D, 1024, nullptr, scr, r, F.lane); continue; } r -= I_BR;
        if (r < I_OUT) { p0_transpose_item(F.wout, D, D, (bf16*)(F.ws + WS_WOUT), D, 0, nullptr, scr, r, F.lane); continue; } r -= I_OUT;
        if (r < I_UP) { p0_transpose_item(F.wup, D, FF, (bf16*)(F.ws + WS_WUP), D, 0, F.g2, scr, r, F.lane); continue; } r -= I_UP;
        p0_transpose_item(F.wdn, FF, D, (bf16*)(F.ws + WS_WDN), FF, 0, nullptr, scr, r, F.lane);
    }
}
constexpr int P0_I_IN = (D / 64) * (INW / 32), P0_NITEMS = P0_I_IN + 2 * (1024 / 64) * (D / 32) + (D / 64) * (D / 32) + (D / 64) * (FF / 32) + (FF / 64) * (D / 32);
__device__ __forceinline__ void p0_prologue(Frame& F, bool defer) {
    const int gw = F.bid * NWAVES + F.wave, NGW = F.G * NWAVES;
    p0_weights(F, 0, defer ? P0_I_IN : P0_NITEMS, gw, NGW);
    bf16* H = (bf16*)(F.ws + WS_BUFA);
    for (int m = gw; m < M_ROWS; m += NGW) {
        const f32x4* xr = (const f32x4*)xrow_ptr(F, m) + F.lane; f32x4 v[8]; float s = 0.f;
#pragma unroll
        for (int j = 0; j < 8; ++j) { v[j] = xr[64 * j]; s += (v[j].x * v[j].x + v[j].y * v[j].y) + (v[j].z * v[j].z + v[j].w * v[j].w); }
        const float rstd = 1.0f / sqrtf(wave_sum(s) * (1.f / D) + EPS);
        unsigned long long* o8 = (unsigned long long*)(H + (size_t)m * D) + F.lane; const f32x4* gp = (const f32x4*)F.g1 + F.lane;
#pragma unroll
        for (int j = 0; j < 8; ++j) { const f32x4 g = gp[64 * j]; o8[64 * j] = (unsigned long long)pk2(v[j].x * rstd * g.x, v[j].y * rstd * g.y) | ((unsigned long long)pk2(v[j].z * rstd * g.z, v[j].w * rstd * g.w) << 32); }
    }
}

__device__ __forceinline__ float rstd_ss(const float* SS, int row, int hs) { const f32x4 p = *(const f32x4*)(SS + ((size_t)row * 36 + hs) * 4); return 1.0f / sqrtf(((p.x + p.y) + (p.z + p.w)) * (1.f / HD) + EPS); }

namespace att {
#define ALAS __attribute__((address_space(3)))
typedef short bf16x8 __attribute__((ext_vector_type(8)));
typedef short v4i16_t __attribute__((ext_vector_type(4)));
constexpr int TAB_OFF = 131072;
constexpr float LOG2E = 1.4426950408889634f;
__device__ __forceinline__ size_t hm(int hs, int row) { return ((size_t)hs * M_ROWS + (size_t)row) * 128; }
__device__ __forceinline__ unsigned img_off(int row, int chunk) { return (unsigned)(row * 256 + (((chunk ^ row) & 15) << 4)); }
__device__ __forceinline__ v4i16_t vtr(const ALAS unsigned char* p) { return __builtin_amdgcn_ds_read_tr16_b64_v4i16((ALAS v4i16_t*)p); }
__device__ __forceinline__ unsigned tr_off(int row, int dt, int i16) { const int ch = 2 * dt + ((i16 & 3) >> 1); return (unsigned)(row * 256 + (((ch ^ row) & 15) << 4) + (i16 & 1) * 8); }
__device__ __forceinline__ void load_q(bf16x8 (&qf)[4], const bf16* QKV, int qrow, int qhs, const float* gq, const float* gk, int g) {
#pragma unroll
    for (int ks = 0; ks < 4; ++ks) { const int d0 = 32 * ks + 8 * g; const v4u w = *(const v4u*)(QKV + hm(qhs, qrow) + d0);
        const f32x4 a0 = *(const f32x4*)(gq + d0), a1 = *(const f32x4*)(gq + d0 + 4), b0 = *(const f32x4*)(gk + d0), b1 = *(const f32x4*)(gk + d0 + 4); const float c = 0.08838834764831845f;
        v4u o; o.x = pk2(bflo(w.x) * a0.x * b0.x * c, bfhi(w.x) * a0.y * b0.y * c); o.y = pk2(bflo(w.y) * a0.z * b0.z * c, bfhi(w.y) * a0.w * b0.w * c);
        o.z = pk2(bflo(w.z) * a1.x * b1.x * c, bfhi(w.z) * a1.y * b1.y * c); o.w = pk2(bflo(w.w) * a1.z * b1.z * c, bfhi(w.w) * a1.w * b1.w * c);
        qf[ks] = __builtin_bit_cast(bf16x8, o); }
}
__device__ __forceinline__ unsigned cvt2(float lo, float hi) { return pg8::cvt_pk_bf16(lo, hi); }
__device__ __forceinline__ bf16x8 pack_p(const f32x4 a, const f32x4 b) { v4u o; o.x = cvt2(a[0], a[1]); o.y = cvt2(a[2], a[3]); o.z = cvt2(b[0], b[1]); o.w = cvt2(b[2], b[3]); return __builtin_bit_cast(bf16x8, o); }

#define ATT_DMA(src, q) __builtin_amdgcn_global_load_lds((const unsigned*)(src), (ALAS unsigned*)(L + (q) * 1024), 16, 0, 0)
#define ATT_VMWAIT() asm volatile("s_waitcnt vmcnt(0)" ::: "memory")
struct UnitA { int base, n, Ls, h; };
__device__ __forceinline__ UnitA decode_a(int u, bool xmap) { UnitA x;
    if (xmap) { const int bid = u & 255, k = (u >> 8) * 8 + (bid & 7), j = bid >> 3;
        if (k < 64) { x.base = (k >> 3) * 4096; x.n = ((k >> 1) & 3) * 8 + (j >> 2); x.h = (k & 1) * 4 + (j & 3); x.Ls = 4096; }
        else { const int k2 = k - 64; x.base = NP_ROWS + (k2 >> 2) * 2048; x.n = ((k2 >> 1) & 1) * 8 + (j >> 2); x.h = (k2 & 1) * 4 + (j & 3); x.Ls = 2048; }
        return x; }
    x.h = u & 7; const int blk = u >> 3;
    if (blk < 256) { x.base = (blk >> 5) * 4096; x.n = blk & 31; x.Ls = 4096; } else { const int b2 = blk - 256; x.base = NP_ROWS + (b2 >> 4) * 2048; x.n = b2 & 15; x.Ls = 2048; } return x; }
__device__ __forceinline__ void stage_a(ALAS unsigned char* L, const bf16* QKV, const UnitA& x, int off, int w, int lane) {
    const int rl = lane >> 4, p = lane & 15, kpos0 = x.n * 128 - 128;
#pragma unroll
    for (int j = 0; j < 12; ++j) { const int q = w + 8 * j, row = 4 * q + rl; int kp = kpos0 + row; kp = kp < 0 ? 0 : (kp > x.Ls - 1 ? x.Ls - 1 : kp);
        ATT_DMA(QKV + hm(off, x.base + kp) + ((p ^ row) & 15) * 8, q); }
}
__device__ __forceinline__ void attn_a(const Frame& F, ALAS unsigned char* L) {
    ALAS float* rkT = (ALAS float*)(L + TAB_OFF); ALAS float* baT = (ALAS float*)(L + TAB_OFF + 2048);
    const bf16* QKV = (const bf16*)(F.ws + WS_QKV); const float* SS = (const float*)(F.ws + WS_SS); bf16* ATT = (bf16*)(F.ws + WS_BUFA);
    const int tid = F.tid, lane = F.lane, w = F.wave, g = lane >> 4, i16 = lane & 15;
    __syncthreads();
    const bool xmap = (F.G == 256);
    if (F.bid < 2560) { const UnitA x0 = decode_a(F.bid, xmap); stage_a(L, QKV, x0, 8 + (x0.h >> 2), w, lane); }
    for (int u = F.bid; u < 2560; u += F.G) {
        const UnitA x = decode_a(u, xmap); const int h = x.h, base = x.base, n = x.n, Ls = x.Ls;
        const int hk = h >> 2, voff = 10 + hk, qoff = h, kpos0 = n * 128 - 128;
        if (tid < 384) { int kp = kpos0 + tid; kp = kp < 0 ? 0 : (kp > Ls - 1 ? Ls - 1 : kp); rkT[tid] = rstd_ss(SS, base + kp, 8 + hk); }
        if (tid < 288) { const int rel = tid - 16 - 128; baT[tid] = (rel >= -128 && rel <= 128) ? F.t5[t5_bucket_dev(rel) * 8 + h] * LOG2E : 0.f; }
        const int qrow = base + n * 128 + 16 * w + i16; const float rq = rstd_ss(SS, qrow, h) * LOG2E;
        const float* gq_ = F.gqa; const float* gk_ = F.gka; asm volatile("" : "+s"(gq_), "+s"(gk_));
        bf16x8 qf[4]; load_q(qf, QKV, qrow, qoff, gq_, gk_, g);
        ATT_VMWAIT(); __syncthreads();
        f32x4 s[17];
        unsigned kb[4];
#pragma unroll
        for (int ks = 0; ks < 4; ++ks) kb[ks] = img_off(16 * w + i16, 4 * ks + g);
#pragma unroll
        for (int t = 0; t < 17; ++t) { f32x4 acc = {0.f, 0.f, 0.f, 0.f};
#pragma unroll
            for (int ks = 0; ks < 4; ++ks) { const bf16x8 kf = *(const ALAS bf16x8*)(L + kb[ks] + t * 4096); acc = __builtin_amdgcn_mfma_f32_16x16x32_bf16(kf, qf[ks], acc, 0, 0, 0); }
            s[t] = acc; }
        __syncthreads();
        stage_a(L, QKV, x, voff, w, lane);
        int bb = 4 * g - i16 + 16; asm volatile("" : "+v"(bb));
        const int nbk = Ls >> 7; float l = 0.f;
#pragma unroll
        for (int t = 0; t < 17; ++t) { const int blk3 = (w + t) >> 3; const bool tile_ok = blk3 == 0 ? (n > 0) : (blk3 == 2 ? (n < nbk - 1) : true);
            if (!tile_ok) { s[t] = (f32x4){0.f, 0.f, 0.f, 0.f}; }
            else { const f32x4 rk4 = *(const ALAS f32x4*)(rkT + 16 * (w + t) + 4 * g) * rq;
#pragma unroll
                for (int r = 0; r < 4; ++r) { const int idx = 16 * t + r + bb; float p = __builtin_amdgcn_exp2f(s[t][r] * rk4[r] + baT[idx]);
                    if (t == 0 || t == 16) p = (unsigned)(idx - 16) <= 256u ? p : 0.f;
                    s[t][r] = p; l += p; } } }
        l += __shfl_xor(l, 16); l += __shfl_xor(l, 32); l += __builtin_amdgcn_exp2f(F.sink[h] * LOG2E);
        bf16x8 pk[9];
#pragma unroll
        for (int kk = 0; kk < 8; ++kk) pk[kk] = pack_p(s[2 * kk], s[2 * kk + 1]);
        pk[8] = pack_p(s[16], (f32x4){0.f, 0.f, 0.f, 0.f});
        ATT_VMWAIT(); __syncthreads();
        f32x4 o[8];
#pragma unroll
        for (int dt = 0; dt < 8; ++dt) o[dt] = (f32x4){0.f, 0.f, 0.f, 0.f};
        unsigned tb[8];
#pragma unroll
        for (int dt = 0; dt < 8; ++dt) tb[dt] = tr_off(16 * w + 4 * g + (i16 >> 2), dt, i16);
        const unsigned t17off = (unsigned)((w == 7 ? 16 : 17) * 4096);
#pragma unroll
        for (int kk = 0; kk < 9; ++kk) { const unsigned offb = kk < 8 ? (unsigned)((2 * kk + 1) * 4096) : t17off;
#pragma unroll
            for (int dt = 0; dt < 8; ++dt) { const v4i16_t lo = vtr(L + tb[dt] + 2 * kk * 4096), hi = vtr(L + tb[dt] + offb);
                const bf16x8 vf = {lo[0], lo[1], lo[2], lo[3], hi[0], hi[1], hi[2], hi[3]};
                o[dt] = __builtin_amdgcn_mfma_f32_16x16x32_bf16(vf, pk[kk], o[dt], 0, 0, 0); } }
        __syncthreads();
        if (u + F.G < 2560) { const UnitA xn = decode_a(u + F.G, xmap); stage_a(L, QKV, xn, 8 + (xn.h >> 2), w, lane); }
        const float inv = 1.0f / l; bf16* op = ATT + (size_t)qrow * D + h * 128 + 4 * g;
#pragma unroll
        for (int dt = 0; dt < 8; ++dt) { const unsigned long long v = (unsigned long long)cvt2(o[dt][0] * inv, o[dt][1] * inv) | ((unsigned long long)cvt2(o[dt][2] * inv, o[dt][3] * inv) << 32); *(unsigned long long*)(op + 16 * dt) = v; }
    }
    ATT_VMWAIT();
}

struct UnitB { int base, r0, rows, kr0, h, half; };
__device__ __forceinline__ UnitB decode_b(int u, bool xmap) { UnitB x;
    if (xmap) { const int bid = u & 255, k = (u >> 8) * 8 + (bid & 7), j = bid >> 3;
        if (k < 64) { x.base = (k >> 3) * 4096; x.h = k & 7; x.half = j & 1; x.r0 = (j >> 1) * 4; x.rows = 64; }
        else { const int p = 2 * (k - 64) + (j >> 4), jj = j & 15; x.base = NP_ROWS + (p >> 3) * 2048; x.h = p & 7; x.half = jj & 1; x.r0 = (jj >> 1) * 4; x.rows = 32; } }
    else { x.h = u & 7; x.half = (u >> 3) & 1; const int rg = u >> 4;
    if (rg < 128) { x.base = (rg >> 4) * 4096; x.r0 = (rg & 15) * 4; x.rows = 64; } else { const int r2 = rg - 128; x.base = NP_ROWS + (r2 >> 3) * 2048; x.r0 = (r2 & 7) * 4; x.rows = 32; } }
    int k = x.r0 - 4; x.kr0 = k < 0 ? 0 : (k > x.rows - 11 ? x.rows - 11 : k); return x; }
__device__ __forceinline__ void stage_b(ALAS unsigned char* L, const bf16* QKV, const UnitB& x, int off, int w, int lane) {
    const int rl = lane >> 4, p = lane & 15, col0 = x.half ? 24 : 0;
#pragma unroll
    for (int j = 0; j < 14; ++j) { const int q = w + 8 * j;
        if (q < 110) { const int row = 4 * q + rl, kr = row / 40, kc = row - kr * 40;
            ATT_DMA(QKV + hm(off, x.base + (x.kr0 + kr) * 64 + col0 + kc) + ((p ^ row) & 15) * 8, q); } }
}
__device__ __forceinline__ void attn_b(const Frame& F, ALAS unsigned char* L) {
    ALAS float* rkT = (ALAS float*)(L + TAB_OFF); ALAS float* bT = (ALAS float*)(L + TAB_OFF + 2048);
    const bf16* QKV = (const bf16*)(F.ws + WS_QKV); const float* SS = (const float*)(F.ws + WS_SS); bf16* ATT = (bf16*)(F.ws + WS_BUFA);
    int tid = F.tid, w = F.wave; asm volatile("" : "+v"(tid), "+s"(w));
    const int lane = tid & 63, g = lane >> 4, i16 = lane & 15;
    __syncthreads();
    const bool xmap = (F.G == 256);
    if (F.bid < 2560) { const UnitB x0 = decode_b(F.bid, xmap); stage_b(L, QKV, x0, 20 + x0.h, w, lane); }
    for (int u = F.bid; u < 2560; u += F.G) {
        const UnitB x = decode_b(u, xmap); const int h = x.h, half = x.half, base = x.base, r0 = x.r0, rows = x.rows, kr0 = x.kr0;
        const int col0 = half ? 24 : 0, qoff = 12 + h, voff = 28 + h;
        const int r = r0 + (w >> 1), cb = 2 * half + (w & 1), c = 16 * cb + i16;
        int rs = r - 4; rs = rs < 0 ? 0 : (rs > rows - 8 ? rows - 8 : rs);
        int reg = 16 * cb - 8; reg = reg < 0 ? 0 : (reg > 32 ? 32 : reg); int cs = c - 8; cs = cs < 0 ? 0 : (cs > 48 ? 48 : cs);
        const int q0 = (rs - kr0) * 40 + (reg - col0);
        if (tid < 440) { const int kr = tid / 40, kc = tid - kr * 40; rkT[tid] = rstd_ss(SS, base + (kr0 + kr) * 64 + col0 + kc, 20 + h); }
        for (int i = tid; i < 640; i += 512) bT[i] = (i >= 64 && i < 64 + 465) ? F.rpb[h * 465 + i - 64] * LOG2E : 0.f;
        const int qrow = base + r * 64 + c; const float rq = rstd_ss(SS, qrow, 12 + h) * LOG2E;
        const float* gq_ = F.gqb; const float* gk_ = F.gkb; asm volatile("" : "+s"(gq_), "+s"(gk_));
        bf16x8 qf[4]; load_q(qf, QKV, qrow, qoff, gq_, gk_, g);
        ATT_VMWAIT(); __syncthreads();
        f32x4 s[16];
        unsigned kb[4];
#pragma unroll
        for (int ks = 0; ks < 4; ++ks) kb[ks] = img_off(q0 + i16, 4 * ks + g);
#pragma unroll
        for (int t = 0; t < 16; ++t) { f32x4 acc = {0.f, 0.f, 0.f, 0.f};
#pragma unroll
            for (int ks = 0; ks < 4; ++ks) { const bf16x8 kf = *(const ALAS bf16x8*)(L + (kb[ks] ^ (unsigned)(((t >> 1) & 1) << 7)) + (40 * (t >> 1) + 16 * (t & 1)) * 256); acc = __builtin_amdgcn_mfma_f32_16x16x32_bf16(kf, qf[ks], acc, 0, 0, 0); }
            s[t] = acc; }
        __syncthreads();
        stage_b(L, QKV, x, voff, w, lane);
        float l = 0.f;
#pragma unroll
        for (int t = 0; t < 16; ++t) { const int i = t >> 1, R0 = q0 + 40 * i + 16 * (t & 1) + 4 * g; const f32x4 rk4 = *(const ALAS f32x4*)(rkT + R0) * rq; const int kc0 = reg + 16 * (t & 1) + 4 * g, brow = (rs + i - r + 7) * 31 + 15 - c + 64;
#pragma unroll
            for (int rr = 0; rr < 4; ++rr) { const int kc = kc0 + rr; float p = __builtin_amdgcn_exp2f(s[t][rr] * rk4[rr] + bT[brow + kc]);
                p = (kc >= cs && kc < cs + 16) ? p : 0.f; s[t][rr] = p; l += p; } }
        l += __shfl_xor(l, 16); l += __shfl_xor(l, 32);
        bf16x8 pk[8];
#pragma unroll
        for (int kk = 0; kk < 8; ++kk) pk[kk] = pack_p(s[2 * kk], s[2 * kk + 1]);
        ATT_VMWAIT(); __syncthreads();
        f32x4 o[8];
#pragma unroll
        for (int d = 0; d < 8; ++d) o[d] = (f32x4){0.f, 0.f, 0.f, 0.f};
        unsigned tb[8];
#pragma unroll
        for (int d = 0; d < 8; ++d) tb[d] = tr_off(q0 + 4 * g + (i16 >> 2), d, i16);
#pragma unroll
        for (int kk = 0; kk < 8; ++kk) {
#pragma unroll
            for (int d = 0; d < 8; ++d) { const unsigned a = (tb[d] ^ (unsigned)((kk & 1) << 7)) + kk * 40 * 256; const v4i16_t lo = vtr(L + a), hi = vtr(L + a + 4096);
                const bf16x8 vf = {lo[0], lo[1], lo[2], lo[3], hi[0], hi[1], hi[2], hi[3]};
                o[d] = __builtin_amdgcn_mfma_f32_16x16x32_bf16(vf, pk[kk], o[d], 0, 0, 0); } }
        __syncthreads();
        if (u + F.G < 2560) { const UnitB xn = decode_b(u + F.G, xmap); stage_b(L, QKV, xn, 20 + xn.h, w, lane); }
        const float inv = 1.0f / l; bf16* op = ATT + (size_t)qrow * D + 1024 + h * 128 + 4 * g;
#pragma unroll
        for (int d = 0; d < 8; ++d) { const unsigned long long v = (unsigned long long)cvt2(o[d][0] * inv, o[d][1] * inv) | ((unsigned long long)cvt2(o[d][2] * inv, o[d][3] * inv) << 32); *(unsigned long long*)(op + 16 * d) = v; }
    }
    ATT_VMWAIT();
}
}

#define XB_TMO      128
#define XB_XCNT(j)  (256  + 64 * (j))
#define XB_XSUB(j)  (1280 + 64 * (j))
#define XB_XGEN(j)  (2304 + 64 * (j))
#define XB_TOP      3328
#define XB_TOPGEN   3392
#define XCD_BAR_WORDS 3456
#define XB_SPIN_CAP (1u << 18)

__device__ __forceinline__ unsigned xb_ld(unsigned* p)              { return __hip_atomic_load(p, __ATOMIC_RELAXED, __HIP_MEMORY_SCOPE_AGENT); }
__device__ __forceinline__ unsigned xb_add(unsigned* p, unsigned v) { return __hip_atomic_fetch_add(p, v, __ATOMIC_RELAXED, __HIP_MEMORY_SCOPE_AGENT); }
__device__ __forceinline__ unsigned xb_xcc_id() { return (unsigned)__builtin_amdgcn_s_getreg((3 << 11) | 20) & 0xFu; }
#define XB_SPIN(cond, bar) do { unsigned _sp = 0; while (cond) { __builtin_amdgcn_s_sleep(1); \
    if ((++_sp & 255u) == 0u) { if (xb_ld(&(bar)[XB_TMO])) break; if (_sp > XB_SPIN_CAP) { atomicAdd(&(bar)[XB_TMO], 1u); break; } } } } while (0)

struct XcdBarrier {
    unsigned* bar; unsigned x;
    volatile LAS unsigned* st;
};

__device__ __forceinline__ XcdBarrier xcd_barrier_post(unsigned* bar, volatile LAS unsigned* st) {
    XcdBarrier b; b.bar = bar; b.x = xb_xcc_id(); b.st = st;
    if (threadIdx.x == 0) (void)xb_add(&bar[XB_XCNT(b.x)], 1u);
    return b;
}
__device__ __forceinline__ void xcd_barrier_complete(unsigned* bar, unsigned x, unsigned& nloc, unsigned& nx) {
    const unsigned G = gridDim.x * gridDim.y * gridDim.z;
    unsigned sum, cnt, mine, sp = 0u;
    for (;;) {
        sum = 0u; cnt = 0u; mine = 0u;
#pragma unroll
        for (unsigned j = 0; j < 16; ++j) { const unsigned c = xb_ld(&bar[XB_XCNT(j)]); sum += c; cnt += (c > 0u) ? 1u : 0u; mine = (j == x) ? c : mine; }
        if (sum == G) break;
        __builtin_amdgcn_s_sleep(1);
        if ((++sp & 255u) == 0u) { if (xb_ld(&bar[XB_TMO])) break; if (sp > XB_SPIN_CAP) { atomicAdd(&bar[XB_TMO], 1u); break; } }
    }
    nloc = mine > 0u ? mine : 1u; nx = cnt > 0u ? cnt : 1u;
}

__device__ __forceinline__ void xcd_barrier(const XcdBarrier& b) {
    asm volatile("s_waitcnt vmcnt(0)" ::: "memory");
    __syncthreads();
    if (threadIdx.x == 0) {
        unsigned* bar = b.bar;
        __builtin_amdgcn_s_waitcnt(0);
        unsigned nloc = b.st[0], nx = b.st[1];
        if (nloc == 0u) { xcd_barrier_complete(bar, b.x, nloc, nx); b.st[0] = nloc; b.st[1] = nx; }
        const unsigned old = xb_add(&bar[XB_XSUB(b.x)], 1u);
        const unsigned gen = old / nloc;
        if (old + 1u == (gen + 1u) * nloc) {
            __builtin_amdgcn_fence(__ATOMIC_RELEASE, "agent");
            asm volatile("s_waitcnt vmcnt(0)" ::: "memory");
            const unsigned og = xb_add(&bar[XB_TOP], 1u);
            const unsigned tg = og / nx;
            if (og + 1u == (tg + 1u) * nx) xb_add(&bar[XB_TOPGEN], 1u);
            else XB_SPIN(xb_ld(&bar[XB_TOPGEN]) == tg, bar);
            __builtin_amdgcn_fence(__ATOMIC_ACQUIRE, "agent");
            xb_add(&bar[XB_XGEN(b.x)], 1u);
            asm volatile("s_waitcnt vmcnt(0)" ::: "memory");
        } else {
            XB_SPIN(xb_ld(&bar[XB_XGEN(b.x)]) == gen, bar);
            __builtin_amdgcn_fence(__ATOMIC_ACQUIRE, "agent");
            asm volatile("s_waitcnt vmcnt(0)" ::: "memory");
        }
    }
    __syncthreads();
}

struct Args { const float* in[17]; float* out; unsigned char* ws; int ph_lo, ph_hi; };
constexpr int N_PHASES = 8;
__global__ void __launch_bounds__(NWAVES * 64, 2) fwd_megakernel(Args args) {
    extern __shared__ __attribute__((aligned(16))) unsigned char lds[];
    cg::grid_group grid = cg::this_grid();
    Frame F;
    F.lds = lds; F.tid = threadIdx.x; F.lane = F.tid & 63; F.wave = __builtin_amdgcn_readfirstlane(F.tid >> 6); F.G = gridDim.x; F.bid = blockIdx.x;
    F.xp = args.in[0]; F.xs = args.in[1]; F.g1 = args.in[2]; F.w_in = args.in[3]; F.gqa = args.in[4]; F.gka = args.in[5]; F.t5 = args.in[6]; F.sink = args.in[7];
    F.gqb = args.in[8]; F.gkb = args.in[9]; F.rpb = args.in[10]; F.wbra = args.in[11]; F.wbrb = args.in[12]; F.wout = args.in[13]; F.g2 = args.in[14]; F.wup = args.in[15]; F.wdn = args.in[16];
    F.out = args.out; F.ws = args.ws;
    unsigned char* ws = args.ws;
    PG8_LAS unsigned char* ldsl = (PG8_LAS unsigned char*)lds;
    const int lo = args.ph_lo, hi = args.ph_hi;
#ifndef PHASE_MASK
#define PHASE_MASK 0xff
#endif
#define IN(k) (((PHASE_MASK >> (k)) & 1) && lo <= (k) && (k) < hi)
#define STAMP() do {} while (0)
#define SEAM(k) do { if (IN(k) && IN((k) + 1)) { if ((k) == 0) grid.sync(); else xcd_barrier(xbar); } STAMP(); } while (0)
    bf16* BUFA = (bf16*)(ws + WS_BUFA); bf16* QKV = (bf16*)(ws + WS_QKV); bf16* GATES = (bf16*)(ws + WS_GATES);
    float* SS = (float*)(ws + WS_SS); float* SS2 = (float*)(ws + WS_SS2); float* RSTD2 = (float*)(ws + WS_RSTD2);

    STAMP();
    { volatile LAS unsigned* st_ = (volatile LAS unsigned*)((LAS unsigned char*)lds + 139264 + 256); if (F.tid < 2) st_[F.tid] = 0u; __syncthreads(); }
    XcdBarrier xbar; xbar.bar = (unsigned*)(ws + WS_BAR); xbar.x = 0u; xbar.st = (volatile LAS unsigned*)((LAS unsigned char*)lds + 139264 + 256);
    const int p1_rem = (int)(((long)(M_ROWS / 256) * (INW / 256)) % F.G); const bool defer_w = IN(0) && IN(1) && p1_rem != 0 && p1_rem <= F.G / 2;
    if (IN(0)) { if (F.bid == 0) for (int i = F.tid; i < XCD_BAR_WORDS; i += NWAVES * 64) ((unsigned*)(ws + WS_BAR))[i] = 0u;
        p0_prologue(F, defer_w); __syncthreads(); }
    SEAM(0);
    xbar = xcd_barrier_post((unsigned*)(ws + WS_BAR), (volatile LAS unsigned*)((LAS unsigned char*)lds + 139264 + 256));
    if (IN(1)) {
        pg8::Gemm g{BUFA, (const bf16*)(ws + WS_WIN), M_ROWS, INW, D}; pg8::StaticOrder S; S.init(M_ROWS, INW, F.G, F.bid);
        pg8::EpiProj E{QKV, GATES, SS};
        pg8::gemm_phase<pg8::EpiProj, pg8::StaticOrder, true, true>(ldsl, g, S, E);
        if (defer_w && F.bid >= p1_rem) { __syncthreads(); p0_weights(F, P0_I_IN, P0_NITEMS, (F.bid - p1_rem) * NWAVES + F.wave, (F.G - p1_rem) * NWAVES); __syncthreads(); }
    }
    SEAM(1);
    if (IN(2)) { att::attn_a(F, (ALAS unsigned char*)lds); att::attn_b(F, (ALAS unsigned char*)lds); __syncthreads(); }
    SEAM(2);
    if (IN(3)) {
        pg8::Gemm g{BUFA, (const bf16*)(ws + WS_WBR), M_ROWS, D, D}; pg8::StaticOrder S; S.init(M_ROWS, D, F.G, F.bid);
        pg8::EpiMerge E{GATES, QKV};
        pg8::gemm_phase<pg8::EpiMerge, pg8::StaticOrder, true, true>(ldsl, g, S, E);
    }
    SEAM(3);
    if (IN(4)) {
        pg8::Gemm g{QKV, (const bf16*)(ws + WS_WOUT), M_ROWS, D, D}; pg8::StaticOrder S; S.init(M_ROWS, D, F.G, F.bid);
        pg8::EpiOut1 E{F.xp, F.xs, F.out, BUFA, SS2};
        pg8::gemm_phase<pg8::EpiOut1, pg8::StaticOrder, true, true>(ldsl, g, S, E);
    }
    SEAM(4);
    if (IN(6)) {
        pg8::Gemm g{BUFA, (const bf16*)(ws + WS_WUP), M_ROWS, FF, D}; pg8::StaticOrder S; S.init(M_ROWS, FF, F.G, F.bid);
        PG8_LAS float* rsT = (PG8_LAS float*)(ldsl + 131072); PG8_LAS int* pmT = (PG8_LAS int*)(ldsl + 131072 + 8 * 256 * 4);
        { if (F.tid < 8) pmT[F.tid] = -1;
          __syncthreads();
          int nslot = 0, last = -1; pg8::Unit uu;
          for (int i = 0; S.next(i, uu); ++i) if (uu.pm != last) { last = uu.pm;
              if (nslot < 8) { if (F.tid < 256) { const f32x4* p = (const f32x4*)(SS2 + (size_t)(uu.pm * 256 + F.tid) * 32); float sq = 0.f;
#pragma unroll
                      for (int j = 0; j < 8; ++j) { const f32x4 v = p[j]; sq += (v.x + v.y) + (v.z + v.w); }
                      rsT[nslot * 256 + F.tid] = 1.0f / sqrtf(sq * (1.f / D) + EPS); }
                  if (F.tid == 0) pmT[nslot] = uu.pm; }
              ++nslot; }
          __syncthreads(); }
        pg8::EpiUp E{rsT, pmT, QKV};
        pg8::gemm_phase<pg8::EpiUp, pg8::StaticOrder, true, true>(ldsl, g, S, E);
    }
    SEAM(6);
    if (IN(7)) {
        pg8::Gemm g{QKV, (const bf16*)(ws + WS_WDN), M_ROWS, D, FF}; pg8::StaticOrder S; S.init(M_ROWS, D, F.G, F.bid);
        pg8::EpiDown E{F.out, BUFA};
        pg8::gemm_phase<pg8::EpiDown, pg8::StaticOrder, true, true>(ldsl, g, S, E);
    }
#undef IN
#undef SEAM
}


extern "C" void kernel_launch(void* const* d_in, const int* in_sizes, int n_in, void* d_out, int out_size, void* d_ws, size_t ws_size, hipStream_t stream) {
    static int grid = 0;
    if (grid == 0) {
        if (n_in != 17 || in_sizes[0] != NP_ROWS * D || in_sizes[1] != (M_ROWS - NP_ROWS) * D || out_size != M_ROWS * D || ws_size < WS_END) {
            fprintf(stderr, "kernel_launch: shape/workspace mismatch (n_in %d, in0 %d, out %d, ws %zu < %zu); nothing launched\n", n_in, n_in > 0 ? in_sizes[0] : -1, out_size, ws_size, (size_t)WS_END); grid = -1; return; }
        int dev = 0, cus = 0, per_cu = 0;
        if (hipGetDevice(&dev) != hipSuccess || hipDeviceGetAttribute(&cus, hipDeviceAttributeMultiprocessorCount, dev) != hipSuccess) { fprintf(stderr, "kernel_launch: device query failed\n"); grid = -1; return; }
        if (hipFuncSetAttribute((const void*)fwd_megakernel, hipFuncAttributeMaxDynamicSharedMemorySize, LDS_BYTES) != hipSuccess) { fprintf(stderr, "kernel_launch: hipFuncSetAttribute failed\n"); grid = -1; return; }
        if (hipOccupancyMaxActiveBlocksPerMultiprocessor(&per_cu, (const void*)fwd_megakernel, NWAVES * 64, LDS_BYTES) != hipSuccess || per_cu < 1) { fprintf(stderr, "kernel_launch: occupancy query says %d blocks per CU\n", per_cu); per_cu = 1; }
        (void)hipGetLastError();
        grid = cus * 1;
    }
    if (grid < 0) return;
    Args a{};
    for (int i = 0; i < 17; ++i) a.in[i] = (const float*)d_in[i];
    a.out = (float*)d_out; a.ws = (unsigned char*)d_ws;
#if MK_N_LAUNCHES == 1
    a.ph_lo = 0; a.ph_hi = N_PHASES;
    void* kargs[] = {&a};
    hipError_t e = hipLaunchCooperativeKernel((const void*)fwd_megakernel, dim3(grid), dim3(NWAVES * 64), kargs, LDS_BYTES, stream);
    if (e != hipSuccess) fprintf(stderr, "kernel_launch: cooperative launch failed: %s (grid %d)\n", hipGetErrorString(e), grid);
#else
    for (int ph = 0; ph < N_PHASES; ++ph) {
        a.ph_lo = ph; a.ph_hi = ph + 1;
        hipLaunchKernelGGL(fwd_megakernel, dim3(grid), dim3(NWAVES * 64), LDS_BYTES, stream, a);
        const hipError_t le = hipPeekAtLastError();
        if (le != hipSuccess) { fprintf(stderr, "kernel_launch: launch %d failed: %s\n", ph, hipGetErrorName(le)); break; }
    }
#endif
}
```
